# Optimizing an MI355X kernel written in HIP

```python
import math
import jax, jax.numpy as jnp
from jax import lax
import numpy as np

D_MODEL = 2048
BATCH = 8
SEQ = 2048
DEPTH = 1
DEC_BATCH = 128
DEC_SEQ = 4
PAST_LEN = 2048
PAGE_SIZE = 128

M_HEADS = 4
M_DK = D_MODEL // 8
M_DV = D_MODEL // 8
M_WIDTH = M_HEADS * M_DV
CONV_W = 4
M_CHUNK = 64
A_HEADS = 8
A_HEAD_DIM = D_MODEL // 16
A_WIDTH = A_HEADS * A_HEAD_DIM
A_KV_HEADS = 2
IDX_HEADS = 8
IDX_DIM = 64
TOPK_MAX = 256
Q_BLOCK = 128
N_BUCKETS = 32
MAX_DISTANCE = 128
D_FF = 5632
N_MOD = 9
EPS = 1e-6
NEG = -1e30
PROJ_WIDTH = 4 * M_WIDTH + 2 * M_HEADS + A_WIDTH + 2 * A_KV_HEADS * A_HEAD_DIM + IDX_HEADS * IDX_DIM + IDX_DIM + IDX_HEADS

kernel_name = 'hymba_mlstm_dsa_macaron_step'


def proj_offsets():
    sizes = [M_WIDTH, M_WIDTH, M_WIDTH, M_WIDTH, M_HEADS, M_HEADS,
             A_WIDTH, A_KV_HEADS * A_HEAD_DIM, A_KV_HEADS * A_HEAD_DIM,
             IDX_HEADS * IDX_DIM, IDX_DIM, IDX_HEADS]
    return np.cumsum(sizes)[:-1].tolist()


def rms_norm(x, g):
    x32 = x.astype(jnp.float32)
    y = x32 * lax.rsqrt(jnp.mean(x32 * x32, axis=-1, keepdims=True) + EPS)
    return (y * g.astype(jnp.float32)).astype(x.dtype)


def swiglu(h, w_gate, w_up, w_down):
    return (jax.nn.silu(h @ w_gate) * (h @ w_up)) @ w_down


def t5_bucket(dist):
    max_exact = N_BUCKETS // 2
    d = jnp.maximum(dist, 0)
    ratio = jnp.log(jnp.maximum(d, 1).astype(jnp.float32) / max_exact) / math.log(MAX_DISTANCE / max_exact)
    large = max_exact + (ratio * (N_BUCKETS - max_exact)).astype(jnp.int32)
    large = jnp.minimum(large, N_BUCKETS - 1)
    return jnp.where(d < max_exact, d, large)


def causal_conv(x_new, buf, w):
    t = x_new.shape[1]
    xp = jnp.concatenate([buf.astype(x_new.dtype), x_new], axis=1)
    y = xp[:, 0:t] * w[0]
    for j in range(1, CONV_W):
        y = y + xp[:, j:j + t] * w[j]
    return y, xp[:, xp.shape[1] - (CONV_W - 1):]


def mlstm_inputs(q_raw, k_raw, v_raw, i_raw, f_raw, conv_buf, conv_w, gate_b):
    b, t, _ = q_raw.shape
    qk, new_buf = causal_conv(jnp.concatenate([q_raw, k_raw], axis=-1), conv_buf, conv_w)
    qk = jax.nn.silu(qk.astype(jnp.float32))

    def heads(a):
        return a.reshape(b, t, M_HEADS, -1).transpose(0, 2, 1, 3)

    q = heads(qk[..., :M_WIDTH])
    k = heads(qk[..., M_WIDTH:]) * (M_DK ** -0.5)
    v = heads(v_raw.astype(jnp.float32))
    gates = (jnp.concatenate([i_raw, f_raw], axis=-1) + gate_b).astype(jnp.float32).transpose(0, 2, 1)
    ig = gates[:, :M_HEADS]
    lf = jax.nn.log_sigmoid(gates[:, M_HEADS:])
    return q, k, v, ig, lf, new_buf


def mlstm_chunk(carry, inp):
    c0, n0, m0 = carry
    q, k, v, ig, lf = inp
    l = q.shape[2]
    bcum = jnp.cumsum(lf, axis=-1)
    causal = jnp.tril(jnp.ones((l, l), bool))
    d_log = jnp.where(causal, bcum[..., :, None] - bcum[..., None, :] + ig[..., None, :], -jnp.inf)
    s_log = bcum + m0[..., None]
    m = jnp.maximum(s_log, jnp.max(d_log, axis=-1))
    dw = jnp.exp(d_log - m[..., None])
    sw = jnp.exp(s_log - m)
    scores = jnp.einsum('bhld,bhsd->bhls', q, k) * dw
    num = jnp.einsum('bhls,bhse->bhle', scores, v) + sw[..., None] * jnp.einsum('bhld,bhde->bhle', q, c0)
    den = jnp.sum(scores, axis=-1) + sw * jnp.einsum('bhld,bhd->bhl', q, n0)
    h = num / jnp.maximum(jnp.abs(den), jnp.exp(-m))[..., None]
    m_new = m[..., -1]
    wl = jnp.exp(bcum[..., -1:] - bcum + ig - m_new[..., None])
    decay = jnp.exp(bcum[..., -1] + m0 - m_new)
    c_new = decay[..., None, None] * c0 + jnp.einsum('bhl,bhld,bhle->bhde', wl, k, v)
    n_new = decay[..., None] * n0 + jnp.einsum('bhl,bhld->bhd', wl, k)
    return (c_new, n_new, m_new), h


def mlstm_scan(state, q, k, v, ig, lf):
    b, hh, t, _ = q.shape
    l = M_CHUNK if t % M_CHUNK == 0 else t
    nc = t // l

    def chunks(a):
        return jnp.moveaxis(a.reshape(a.shape[:2] + (nc, l) + a.shape[3:]), 2, 0)

    state, h = lax.scan(mlstm_chunk, state, (chunks(q), chunks(k), chunks(v), chunks(ig), chunks(lf)))
    h = jnp.moveaxis(h, 0, 2).reshape(b, hh, t, -1)
    return state, h


def mlstm_out(h, o_raw, g):
    b, hh, t, dv = h.shape
    hn = h * lax.rsqrt(jnp.mean(h * h, axis=-1, keepdims=True) + EPS)
    hn = jnp.swapaxes(hn, 1, 2) * g.reshape(hh, dv).astype(jnp.float32)
    return (hn.reshape(b, t, hh * dv) * jax.nn.sigmoid(o_raw.astype(jnp.float32))).astype(o_raw.dtype)


def dsa_heads(q_raw, k_raw, v_raw, qi_raw, ki_raw, w_raw, qn_g, kn_g):
    b, t, _ = q_raw.shape
    q = rms_norm(q_raw.reshape(b, t, A_HEADS, A_HEAD_DIM), qn_g)
    k = rms_norm(k_raw.reshape(b, t, A_KV_HEADS, A_HEAD_DIM), kn_g)
    v = v_raw.reshape(b, t, A_KV_HEADS, A_HEAD_DIM)
    qi = qi_raw.reshape(b, t, IDX_HEADS, IDX_DIM)
    wi = w_raw * (IDX_HEADS ** -0.5)
    return q, k, v, qi, ki_raw, wi


def indexer_scores(qi, wi, ki, q_pos, k_pos):
    s = jnp.einsum('btjd,bsd->btjs', qi.astype(jnp.float32), ki.astype(jnp.float32)) * (IDX_DIM ** -0.5)
    score = jnp.einsum('btj,btjs->bts', wi.astype(jnp.float32), jax.nn.relu(s))
    return jnp.where(k_pos[None, None, :] <= q_pos[None, :, None], score, NEG)


def sparse_attend(q, kg, vg, sel_pos, q_pos, t5_bias):
    b, t, _, hd = q.shape
    g, r = A_KV_HEADS, A_HEADS // A_KV_HEADS
    n = sel_pos.shape[-1]
    qg = q.reshape(b, t, g, r, hd).astype(jnp.float32)
    logits = jnp.einsum('btgrd,btngd->btgrn', qg, kg.astype(jnp.float32)) * (hd ** -0.5)
    dist = q_pos[None, :, None] - sel_pos
    bias = t5_bias[t5_bucket(dist)].astype(jnp.float32)
    bias = bias.reshape(b, t, n, g, r).transpose(0, 1, 3, 4, 2)
    logits = jnp.where((dist >= 0)[:, :, None, None, :], logits + bias, NEG)
    p = jax.nn.softmax(logits, axis=-1)
    o = jnp.einsum('btgrn,btngd->btgrd', p, vg.astype(jnp.float32))
    return o.reshape(b, t, A_HEADS * hd).astype(q.dtype)


def dsa_prompt(q, k, v, qi, ki, wi, t5_bias):
    b, t = q.shape[:2]
    k_sel = min(TOPK_MAX, t // 4)
    nb = t // Q_BLOCK
    pos = jnp.arange(t, dtype=jnp.int32)

    def to_blocks(a):
        return jnp.swapaxes(a.reshape((a.shape[0], nb, Q_BLOCK) + a.shape[2:]), 0, 1)

    def gather_rows(rows, idx):
        return jax.vmap(lambda rb, ib: rb[ib])(rows, idx)

    def block(args):
        qb, qib, wb, pb = args
        score = indexer_scores(qib, wb, ki, pb, pos)
        _, idx = lax.top_k(score, k_sel)
        return sparse_attend(qb, gather_rows(k, idx), gather_rows(v, idx), idx, pb, t5_bias)

    out = lax.map(block, (to_blocks(q), to_blocks(qi), to_blocks(wi), pos.reshape(nb, Q_BLOCK)))
    return jnp.swapaxes(out, 0, 1).reshape(b, t, A_WIDTH)


def dsa_sample(q, k, v, qi, ki, wi, cache_k, cache_v, cache_idx_k, page_table, t5_bias):
    b, t = q.shape[:2]
    n_pages = page_table.shape[1]
    past = n_pages * PAGE_SIZE
    total = past + t
    k_sel = min(TOPK_MAX, total // 4)
    q_pos = past + jnp.arange(t, dtype=jnp.int32)
    k_pos = jnp.arange(total, dtype=jnp.int32)
    ki_past = cache_idx_k[page_table].reshape(b, past, IDX_DIM)
    ki_all = jnp.concatenate([ki_past.astype(ki.dtype), ki], axis=1)
    score = indexer_scores(qi, wi, ki_all, q_pos, k_pos)
    _, idx = lax.top_k(score, k_sel)
    in_past = idx < past
    pidx = jnp.minimum(idx, past - 1)
    phys = page_table[jnp.arange(b)[:, None, None], pidx // PAGE_SIZE] * PAGE_SIZE + pidx % PAGE_SIZE
    nidx = jnp.clip(idx - past, 0, t - 1)

    def gather(pool, rows):
        from_past = pool.reshape(-1, A_KV_HEADS, A_HEAD_DIM)[phys]
        from_new = jax.vmap(lambda rb, ib: rb[ib])(rows, nidx)
        return jnp.where(in_past[..., None, None], from_past.astype(rows.dtype), from_new)

    return sparse_attend(q, gather(cache_k, k), gather(cache_v, v), idx, q_pos, t5_bias)


def decoder_layer(x, c, rec_state, past, t5_bias, ffn1_norm_g, ffn1_w_gate, ffn1_w_up, ffn1_w_down,
                  mix_norm_g, w_in, mlstm_conv_w, mlstm_gate_b, mlstm_out_g, q_norm_g, k_norm_g, w_out,
                  ffn2_norm_g, ffn2_w_gate, ffn2_w_up, ffn2_w_down, w_ada, b_ada):
    mods = (c @ w_ada + b_ada)[:, None, :]
    sh1, sc1, g1, sh2, sc2, g2, sh3, sc3, g3 = jnp.split(mods, N_MOD, axis=-1)
    h = rms_norm(x, ffn1_norm_g) * (1 + sc1) + sh1
    x = x + 0.5 * g1 * swiglu(h, ffn1_w_gate, ffn1_w_up, ffn1_w_down)
    h = rms_norm(x, mix_norm_g) * (1 + sc2) + sh2
    (q_m, k_m, v_m, o_m, i_m, f_m, q_a, k_a, v_a, qi_a, ki_a, wi_a) = jnp.split(h @ w_in, proj_offsets(), axis=-1)
    c0, n0, m0, conv_buf = rec_state
    q, k, v, ig, lf, conv_new = mlstm_inputs(q_m, k_m, v_m, i_m, f_m, conv_buf, mlstm_conv_w, mlstm_gate_b)
    (c_new, n_new, m_new), hm = mlstm_scan((c0, n0, m0), q, k, v, ig, lf)
    mo = mlstm_out(hm, o_m, mlstm_out_g)
    qa, ka, va, qi, ki, wi = dsa_heads(q_a, k_a, v_a, qi_a, ki_a, wi_a, q_norm_g, k_norm_g)
    if past is None:
        ao = dsa_prompt(qa, ka, va, qi, ki, wi, t5_bias)
    else:
        ao = dsa_sample(qa, ka, va, qi, ki, wi, past[0], past[1], past[2], past[3], t5_bias)
    x = x + g2 * (jnp.concatenate([mo, ao], axis=-1) @ w_out)
    h = rms_norm(x, ffn2_norm_g) * (1 + sc3) + sh3
    x = x + 0.5 * g3 * swiglu(h, ffn2_w_gate, ffn2_w_up, ffn2_w_down)
    new_state = (ka, va, ki, c_new.astype(x.dtype), n_new.astype(x.dtype), m_new.astype(x.dtype), conv_new)
    return x, new_state


def setup_inputs(seed: int = 0) -> dict:
    key = jax.random.key(seed)
    ks = iter(jax.random.split(key, 40))

    def nrm(shape, scale=1.0):
        return scale * jax.random.normal(next(ks), shape, jnp.float32)

    def gain(shape):
        return 1.0 + nrm(shape, 0.05)

    d = D_MODEL
    n_pages = PAST_LEN // PAGE_SIZE
    n_used = DEC_BATCH * n_pages
    n_pool = n_used + max(1, n_used // 4)
    page_table = jax.random.permutation(next(ks), n_pool)[:n_used].reshape(DEC_BATCH, n_pages).astype(jnp.int32)
    return {
        'x_prompt': nrm((BATCH, SEQ, d)),
        'x_sample': nrm((DEC_BATCH, DEC_SEQ, d)),
        'c_prompt': nrm((BATCH, d)),
        'c_sample': nrm((DEC_BATCH, d)),
        'cache_k': nrm((DEPTH, n_pool, PAGE_SIZE, A_KV_HEADS, A_HEAD_DIM)),
        'cache_v': nrm((DEPTH, n_pool, PAGE_SIZE, A_KV_HEADS, A_HEAD_DIM)),
        'cache_idx_k': nrm((DEPTH, n_pool, PAGE_SIZE, IDX_DIM)),
        'page_table': page_table,
        'state_C': nrm((DEPTH, DEC_BATCH, M_HEADS, M_DK, M_DV), 0.1),
        'state_n': nrm((DEPTH, DEC_BATCH, M_HEADS, M_DK), 0.1),
        'state_m': nrm((DEPTH, DEC_BATCH, M_HEADS)),
        'state_conv': nrm((DEPTH, DEC_BATCH, CONV_W - 1, 2 * M_WIDTH)),
        'ffn1_norm_g': gain((DEPTH, d)),
        'ffn1_w_gate': nrm((DEPTH, d, D_FF), d ** -0.5),
        'ffn1_w_up': nrm((DEPTH, d, D_FF), d ** -0.5),
        'ffn1_w_down': nrm((DEPTH, D_FF, d), D_FF ** -0.5),
        'mix_norm_g': gain((DEPTH, d)),
        'w_in': nrm((DEPTH, d, PROJ_WIDTH), d ** -0.5),
        'mlstm_conv_w': nrm((DEPTH, CONV_W, 2 * M_WIDTH), CONV_W ** -0.5),
        'mlstm_gate_b': jnp.concatenate([nrm((DEPTH, M_HEADS), 0.1), 3.0 + nrm((DEPTH, M_HEADS), 0.5)], axis=-1),
        'mlstm_out_g': gain((DEPTH, M_WIDTH)),
        'q_norm_g': gain((DEPTH, A_HEAD_DIM)),
        'k_norm_g': gain((DEPTH, A_HEAD_DIM)),
        't5_bias': nrm((N_BUCKETS, A_HEADS), 0.5),
        'w_out': nrm((DEPTH, M_WIDTH + A_WIDTH, d), (M_WIDTH + A_WIDTH) ** -0.5),
        'ffn2_norm_g': gain((DEPTH, d)),
        'ffn2_w_gate': nrm((DEPTH, d, D_FF), d ** -0.5),
        'ffn2_w_up': nrm((DEPTH, d, D_FF), d ** -0.5),
        'ffn2_w_down': nrm((DEPTH, D_FF, d), D_FF ** -0.5),
        'w_ada': nrm((DEPTH, d, N_MOD * d), 0.5 * d ** -0.5),
        'b_ada': nrm((DEPTH, N_MOD * d), 0.02),
    }


def reference(x_prompt, x_sample, c_prompt, c_sample, cache_k, cache_v, cache_idx_k, page_table,
              state_C, state_n, state_m, state_conv, ffn1_norm_g, ffn1_w_gate, ffn1_w_up, ffn1_w_down,
              mix_norm_g, w_in, mlstm_conv_w, mlstm_gate_b, mlstm_out_g, q_norm_g, k_norm_g, t5_bias,
              w_out, ffn2_norm_g, ffn2_w_gate, ffn2_w_up, ffn2_w_down, w_ada, b_ada):
    xp, xs = x_prompt, x_sample
    bp = xp.shape[0]
    st_p, st_s = [], []
    for l in range(DEPTH):
        lw = (ffn1_norm_g[l], ffn1_w_gate[l], ffn1_w_up[l], ffn1_w_down[l], mix_norm_g[l], w_in[l],
              mlstm_conv_w[l], mlstm_gate_b[l], mlstm_out_g[l], q_norm_g[l], k_norm_g[l], w_out[l],
              ffn2_norm_g[l], ffn2_w_gate[l], ffn2_w_up[l], ffn2_w_down[l], w_ada[l], b_ada[l])
        init_p = (jnp.zeros((bp, M_HEADS, M_DK, M_DV), jnp.float32),
                  jnp.zeros((bp, M_HEADS, M_DK), jnp.float32),
                  jnp.zeros((bp, M_HEADS), jnp.float32),
                  jnp.zeros((bp, CONV_W - 1, 2 * M_WIDTH), xp.dtype))
        xp, sp = decoder_layer(xp, c_prompt, init_p, None, t5_bias, *lw)
        init_s = (state_C[l].astype(jnp.float32), state_n[l].astype(jnp.float32),
                  state_m[l].astype(jnp.float32), state_conv[l])
        past_s = (cache_k[l], cache_v[l], cache_idx_k[l], page_table)
        xs, ss = decoder_layer(xs, c_sample, init_s, past_s, t5_bias, *lw)
        st_p.append(sp)
        st_s.append(ss)
    return (xp, xs,
            jnp.stack([s[0] for s in st_p]), jnp.stack([s[1] for s in st_p]), jnp.stack([s[2] for s in st_p]),
            jnp.stack([s[3] for s in st_p]), jnp.stack([s[4] for s in st_p]), jnp.stack([s[5] for s in st_p]),
            jnp.stack([s[6] for s in st_p]),
            jnp.stack([s[0] for s in st_s]), jnp.stack([s[1] for s in st_s]), jnp.stack([s[2] for s in st_s]),
            jnp.stack([s[3] for s in st_s]), jnp.stack([s[4] for s in st_s]), jnp.stack([s[5] for s in st_s]),
            jnp.stack([s[6] for s in st_s]))
```

```cpp
#include <hip/hip_runtime.h>
#include <stdint.h>
#include <stdio.h>

typedef unsigned short bf16_t;
typedef float f32x4 __attribute__((ext_vector_type(4)));
typedef unsigned u32x2 __attribute__((ext_vector_type(2)));
typedef unsigned u32x4 __attribute__((ext_vector_type(4)));
typedef unsigned long long u64;

constexpr int D = 2048, BP = 8, TP = 2048, BS = 128, TS = 4;
constexpr int MP = BP * TP, MS = BS * TS, M = MP + MS;
constexpr int FF = 5632, NMOD = 9 * D, NB = BP + BS;
constexpr int PW = 6224;
constexpr int PROJ_LD = 6144, SMALL_LD = 128;
constexpr int SCS_LD = 2112;
constexpr float EPS = 1e-6f;
constexpr int PC_QM = 0, PC_KM = 1024, PC_VM = 2048, PC_OM = 3072, PC_QA = 4096, PC_KA = 5120, PC_VA = 5376, PC_QI = 5632;

constexpr size_t O_Y = 0;
constexpr size_t O_KP = O_Y + (size_t)M * D;
constexpr size_t O_VP = O_KP + (size_t)MP * 256;
constexpr size_t O_IKP = O_VP + (size_t)MP * 256;
constexpr size_t O_CP = O_IKP + (size_t)MP * 64;
constexpr size_t O_NP = O_CP + (size_t)BP * 4 * 65536;
constexpr size_t O_MP = O_NP + (size_t)BP * 4 * 256;
constexpr size_t O_CVP = O_MP + (size_t)BP * 4;
constexpr size_t O_KS = O_CVP + (size_t)BP * 3 * 2048;
constexpr size_t O_VS = O_KS + (size_t)MS * 256;
constexpr size_t O_IKS = O_VS + (size_t)MS * 256;
constexpr size_t O_CS = O_IKS + (size_t)MS * 64;
constexpr size_t O_NS = O_CS + (size_t)BS * 4 * 65536;
constexpr size_t O_MS = O_NS + (size_t)BS * 4 * 256;
constexpr size_t O_CVS = O_MS + (size_t)BS * 4;
constexpr size_t O_END = O_CVS + (size_t)BS * 3 * 2048;
static_assert(O_END == 80962080, "output size");

constexpr size_t al256(size_t x) { return (x + 255) & ~(size_t)255; }
constexpr size_t WS_CTL = 0;
constexpr size_t WS_MODS = 1u << 20;
constexpr size_t WS_H = al256(WS_MODS + (size_t)NB * NMOD * 4);
constexpr size_t WS_ACT = al256(WS_H + (size_t)M * D * 2);
constexpr size_t WS_PROJ = al256(WS_ACT + (size_t)M * FF * 2);
constexpr size_t WS_SMALL = al256(WS_PROJ + (size_t)M * PROJ_LD * 2);
constexpr size_t WS_QA = al256(WS_SMALL + (size_t)M * SMALL_LD * 4);
constexpr size_t WS_KA = al256(WS_QA + (size_t)M * 1024 * 2);
constexpr size_t WS_QM = al256(WS_KA + (size_t)M * 256 * 2);
constexpr size_t WS_KM = al256(WS_QM + (size_t)M * 1024 * 2);
constexpr size_t WS_HM = al256(WS_KM + (size_t)M * 1024 * 2);
constexpr size_t WS_CAT = al256(WS_HM + (size_t)M * 1024 * 4);
constexpr size_t WS_BC = al256(WS_CAT + (size_t)M * D * 2);
constexpr size_t WS_IG = al256(WS_BC + (size_t)32 * 2048 * 4);
constexpr size_t WS_MM = al256(WS_IG + (size_t)32 * 2048 * 4);
constexpr size_t WS_SC = al256(WS_MM + (size_t)32 * 2048 * 4);
constexpr size_t WS_SCS = al256(WS_SC + (size_t)MP * 2048 * 4);
constexpr size_t WS_MASK = al256(WS_SCS + (size_t)MS * SCS_LD * 4);
constexpr size_t WS_MASKS = al256(WS_MASK + (size_t)MP * 32 * 8);
constexpr size_t WS_KI = al256(WS_MASKS + (size_t)MS * 33 * 8);
constexpr size_t WS_SLAB = al256(WS_KI + (size_t)M * 64 * 2);
constexpr size_t WS_XB = al256(WS_SLAB + (size_t)11 * MS * D * 4);
constexpr size_t WS_H8 = al256(WS_XB + (size_t)M * D * 2);
constexpr size_t WS_SA = al256(WS_H8 + (size_t)M * D);
constexpr size_t WS_W1GU8 = al256(WS_SA + (size_t)M * 4);
constexpr size_t WS_W2GU8 = al256(WS_W1GU8 + (size_t)2 * FF * D);
constexpr size_t WS_ACT8 = al256(WS_W2GU8 + (size_t)2 * FF * D);
constexpr size_t WS_SA2 = al256(WS_ACT8 + (size_t)M * FF);
constexpr size_t WS_RMAXP = al256(WS_SA2 + (size_t)M * 4);
constexpr size_t WS_W1D8 = al256(WS_RMAXP + (size_t)M * 176 * 4);
constexpr size_t WS_W2D8 = al256(WS_W1D8 + (size_t)D * FF);
constexpr size_t WS_W1GU = al256(WS_W2D8 + (size_t)D * FF);
constexpr size_t WS_W1D = al256(WS_W1GU + (size_t)2 * FF * D * 2);
constexpr size_t WS_WIN = al256(WS_W1D + (size_t)D * FF * 2);
constexpr size_t WS_WOUT = al256(WS_WIN + (size_t)6400 * D * 2);
constexpr size_t WS_W2GU = al256(WS_WOUT + (size_t)D * D * 2);
constexpr size_t WS_W2D = al256(WS_W2GU + (size_t)2 * FF * D * 2);
constexpr size_t WS_END = al256(WS_W2D + (size_t)D * FF * 2);

struct Ptrs {
    const float *x_p, *x_s, *c_p, *c_s, *cache_k, *cache_v, *cache_ik; const int* page_table;
    const float *state_C, *state_n, *state_m, *state_conv;
    const float *f1_g, *f1_wg, *f1_wu, *f1_wd, *mix_g, *w_in, *conv_w, *gate_b, *out_g, *qn_g, *kn_g, *t5, *w_out, *f2_g, *f2_wg, *f2_wu, *f2_wd, *w_ada, *b_ada;
    float* out; unsigned char* ws_;
    __device__ __forceinline__ unsigned char* WS() const { const unsigned long long w = (unsigned long long)ws_; unsigned w0 = (unsigned)w, w1 = (unsigned)(w >> 32); asm volatile("" : "+v"(w0), "+v"(w1));
        return (unsigned char*)(__attribute__((address_space(1))) unsigned char*)(((unsigned long long)(unsigned)__builtin_amdgcn_readfirstlane(w1) << 32) | (unsigned)__builtin_amdgcn_readfirstlane(w0)); }
};

__device__ __forceinline__ float bf2f(bf16_t v) { return __uint_as_float(((unsigned)v) << 16); }
__device__ __forceinline__ bf16_t f2bf(float f) { unsigned u = __float_as_uint(f); u += 0x7fffu + ((u >> 16) & 1u); return (bf16_t)(u >> 16); }
__device__ __forceinline__ unsigned pk2(float lo, float hi) { return (unsigned)f2bf(lo) | ((unsigned)f2bf(hi) << 16); }
__device__ __forceinline__ float bflo(unsigned w) { return __uint_as_float(w << 16); }
__device__ __forceinline__ float bfhi(unsigned w) { return __uint_as_float(w & 0xffff0000u); }
__device__ __forceinline__ float wave_sum(float v) {
#pragma unroll
    for (int o = 1; o < 64; o <<= 1) v += __shfl_xor(v, o);
    return v;
}
__device__ __forceinline__ float wave_max(float v) {
#pragma unroll
    for (int o = 1; o < 64; o <<= 1) v = fmaxf(v, __shfl_xor(v, o));
    return v;
}
__device__ __forceinline__ float x16_max(float x) { const auto r = __builtin_amdgcn_permlane16_swap(__float_as_uint(x), __float_as_uint(x), false, false); return fmaxf(__uint_as_float(r[0]), __uint_as_float(r[1])); }
__device__ __forceinline__ float x32_max(float x) { const auto r = __builtin_amdgcn_permlane32_swap(__float_as_uint(x), __float_as_uint(x), false, false); return fmaxf(__uint_as_float(r[0]), __uint_as_float(r[1])); }
__device__ __forceinline__ float x16_sum(float x) { const auto r = __builtin_amdgcn_permlane16_swap(__float_as_uint(x), __float_as_uint(x), false, false); return __uint_as_float(r[0]) + __uint_as_float(r[1]); }
__device__ __forceinline__ float x32_sum(float x) { const auto r = __builtin_amdgcn_permlane32_swap(__float_as_uint(x), __float_as_uint(x), false, false); return __uint_as_float(r[0]) + __uint_as_float(r[1]); }
__device__ __forceinline__ float silu_f(float x) { return x / (1.0f + __expf(-x)); }
__device__ __forceinline__ int row_bm(int row) { return row < MP ? (row >> 11) : BP + ((row - MP) >> 2); }
__device__ __forceinline__ int t5_bucket(int dist) {
    if (dist < 16) return dist;
    const float ratio = logf((float)dist / 16.0f) / 2.0794415416798357f;
    int large = 16 + (int)(ratio * 16.0f);
    return large < 31 ? large : 31;
}

__device__ __forceinline__ void normmod_vals(const f32x4 (&v)[8], const float* g, const float* sc, const float* sh, bf16_t* hr, int lane);
__device__ __forceinline__ void normmod_row(const float* xr, const float* g, const float* sc, const float* sh, bf16_t* hr, int lane) {
    f32x4 v[8];
#pragma unroll
    for (int j = 0; j < 8; ++j) v[j] = ((const f32x4*)xr)[64 * j + lane];
    normmod_vals(v, g, sc, sh, hr, lane);
}
template <int NS> __device__ __forceinline__ void normmod_fix_row(const float* base, const float* slab, const float* gate, const float scale, float* xo, const float* g, const float* sc, const float* sh, bf16_t* hr, int lane) {
    f32x4 v[8];
#pragma unroll
    for (int j = 0; j < 8; ++j) { f32x4 a = (f32x4){0.f, 0.f, 0.f, 0.f};
#pragma unroll
        for (int k = 0; k < NS; ++k) a += ((const f32x4*)(slab + (size_t)k * MS * D))[64 * j + lane];
        v[j] = ((const f32x4*)base)[64 * j + lane] + (((const f32x4*)gate)[64 * j + lane] * scale) * a; ((f32x4*)xo)[64 * j + lane] = v[j]; }
    if (hr) normmod_vals(v, g, sc, sh, hr, lane);
}
__device__ __forceinline__ void normmod_vals(const f32x4 (&v)[8], const float* g, const float* sc, const float* sh, bf16_t* hr, int lane) {
    float ss = 0.f;
#pragma unroll
    for (int j = 0; j < 8; ++j) ss += (v[j][0] * v[j][0] + v[j][1] * v[j][1]) + (v[j][2] * v[j][2] + v[j][3] * v[j][3]);
    ss = wave_sum(ss);
    const float r = 1.0f / sqrtf(ss * (1.0f / D) + EPS);
#pragma unroll
    for (int j = 0; j < 8; ++j) {
        const int col = 256 * j + 4 * lane;
        const f32x4 gg = *(const f32x4*)(g + col), s = *(const f32x4*)(sc + col), h = *(const f32x4*)(sh + col);
        const f32x4 o = v[j] * r * gg * (1.0f + s) + h;
        u32x2 w; w[0] = pk2(o[0], o[1]); w[1] = pk2(o[2], o[3]);
        *(u32x2*)(hr + col) = w;
    }
}

__device__ __forceinline__ void row_load(f32x4 (&v)[8], const float* xr, int lane) {
#pragma unroll
    for (int j = 0; j < 8; ++j) v[j] = ((const f32x4*)xr)[64 * j + lane];
}
__device__ __forceinline__ void row_load_b(f32x4 (&v)[8], const bf16_t* xr, int lane) {
#pragma unroll
    for (int j = 0; j < 8; ++j) { const u32x2 w = *(const u32x2*)(xr + 256 * j + 4 * lane); v[j][0] = bflo(w.x); v[j][1] = bfhi(w.x); v[j][2] = bflo(w.y); v[j][3] = bfhi(w.y); }
}
__device__ __forceinline__ void row_store_b(const f32x4 (&v)[8], bf16_t* xr, int lane) {
#pragma unroll
    for (int j = 0; j < 8; ++j) { u32x2 w; w.x = pk2(v[j][0], v[j][1]); w.y = pk2(v[j][2], v[j][3]); *(u32x2*)(xr + 256 * j + 4 * lane) = w; }
}
template <int NS> __device__ __forceinline__ void fix_add(f32x4 (&v)[8], const float* slab, const float* gate, const float scale, int lane) {
#pragma unroll
    for (int j = 0; j < 8; j += 2) { f32x4 a = (f32x4){0.f, 0.f, 0.f, 0.f}, b = a;
#pragma unroll
        for (int k = 0; k < NS; ++k) { a += ((const f32x4*)(slab + (size_t)k * MS * D))[64 * j + lane]; b += ((const f32x4*)(slab + (size_t)k * MS * D))[64 * (j + 1) + lane]; }
        v[j] += (((const f32x4*)gate)[64 * j + lane] * scale) * a; v[j + 1] += (((const f32x4*)gate)[64 * (j + 1) + lane] * scale) * b;
        asm volatile("" : "+v"(v[j]), "+v"(v[j + 1]) :: "memory"); }
}
__device__ __forceinline__ int fix_rows_n(int gw, int NGW) { return NGW == 2048 ? (gw < 512 ? 6 : 9) : (M - gw + NGW - 1) / NGW; }
__device__ __forceinline__ int fix_row_at(int gw, int NGW, int it) {
    if (NGW != 2048) return gw + it * NGW;
    if (gw < 512) return it == 0 ? MP + gw : gw + (it - 1) * 2048;
    return it < 8 ? gw + it * 2048 : ((gw - 512) & 511) + (5 + ((gw - 512) >> 9)) * 2048;
}
__device__ __forceinline__ unsigned q8x4(float a, float b, float c, float d, float inv) {
    const int qa = (int)rintf(fminf(fmaxf(a * inv, -127.f), 127.f)), qb = (int)rintf(fminf(fmaxf(b * inv, -127.f), 127.f)), qc = (int)rintf(fminf(fmaxf(c * inv, -127.f), 127.f)), qd = (int)rintf(fminf(fmaxf(d * inv, -127.f), 127.f));
    return (unsigned)(qa & 0xff) | ((unsigned)(qb & 0xff) << 8) | ((unsigned)(qc & 0xff) << 16) | ((unsigned)(qd & 0xff) << 24);
}
template <int KW> __device__ __forceinline__ void quant_wrow(const bf16_t* wrow, unsigned char* orow, unsigned* cm, int lane) {
    const float mx = fmaxf(__uint_as_float(*cm), 1e-30f), inv = 127.0f / mx;
#pragma unroll
    for (int j = 0; j < KW / 512; ++j) { const u32x4 w = *(const u32x4*)(wrow + 8 * lane + 512 * j); u32x2 o;
        o.x = q8x4(bflo(w.x), bfhi(w.x), bflo(w.y), bfhi(w.y), inv); o.y = q8x4(bflo(w.z), bfhi(w.z), bflo(w.w), bfhi(w.w), inv);
        *(u32x2*)(orow + 8 * lane + 512 * j) = o; }
    if (lane == 0) *(float*)cm = mx * (1.0f / 127.0f);
}
__device__ __forceinline__ void requant_act_row(unsigned char* arow, const float* rmp, float* sa2, int lane) {
    float mx = fmaxf(rmp[lane], rmp[64 + lane]); if (lane < 48) mx = fmaxf(mx, rmp[128 + lane]);
    mx = fmaxf(wave_max(mx), 1e-30f); const float rinv = 1.0f / mx;
    u32x2 w[11]; float f[11];
#pragma unroll
    for (int j = 0; j < 11; ++j) { w[j] = *(const u32x2*)(arow + 8 * lane + 512 * j); f[j] = rmp[16 * j + (lane >> 2)] * rinv; }
#pragma unroll
    for (int j = 0; j < 11; ++j) { unsigned b[8];
#pragma unroll
        for (int e = 0; e < 4; ++e) { b[e] = __float_as_uint(__builtin_fmaf((float)((w[j].x >> (8 * e)) & 255u) - 128.0f, f[j], 12582912.0f)); b[4 + e] = __float_as_uint(__builtin_fmaf((float)((w[j].y >> (8 * e)) & 255u) - 128.0f, f[j], 12582912.0f)); }
        u32x2 o; o.x = __builtin_amdgcn_perm(b[1], b[0], 0x0c0c0400u) | __builtin_amdgcn_perm(b[3], b[2], 0x04000c0cu); o.y = __builtin_amdgcn_perm(b[5], b[4], 0x0c0c0400u) | __builtin_amdgcn_perm(b[7], b[6], 0x04000c0cu);
        *(u32x2*)(arow + 8 * lane + 512 * j) = o; }
    if (lane == 0) *sa2 = mx * (1.0f / 127.0f);
}
__device__ __forceinline__ void normmod_q8_vals(f32x4 (&v)[8], const float* g, const float* sc, const float* sh, unsigned char* hr, float* sa, int lane) {
    float ss = 0.f;
#pragma unroll
    for (int j = 0; j < 8; ++j) ss += (v[j][0] * v[j][0] + v[j][1] * v[j][1]) + (v[j][2] * v[j][2] + v[j][3] * v[j][3]);
    ss = wave_sum(ss);
    const float r = 1.0f / sqrtf(ss * (1.0f / D) + EPS); float amax = 0.f;
#pragma unroll
    for (int j = 0; j < 8; ++j) { const int col = 256 * j + 4 * lane; const f32x4 gg = *(const f32x4*)(g + col), s = *(const f32x4*)(sc + col), h = *(const f32x4*)(sh + col);
        v[j] = v[j] * r * gg * (1.0f + s) + h; amax = fmaxf(amax, fmaxf(fmaxf(fabsf(v[j][0]), fabsf(v[j][1])), fmaxf(fabsf(v[j][2]), fabsf(v[j][3])))); }
    amax = fmaxf(wave_max(amax), 1e-30f); const float inv = 127.0f / amax;
#pragma unroll
    for (int j = 0; j < 8; ++j) *(unsigned*)(hr + 256 * j + 4 * lane) = q8x4(v[j][0], v[j][1], v[j][2], v[j][3], inv);
    if (lane == 0) *sa = amax * (1.0f / 127.0f);
}
__device__ __forceinline__ void normmod_q8(const float* xr, const float* g, const float* sc, const float* sh, unsigned char* hr, float* sa, int lane) {
    f32x4 v[8];
#pragma unroll
    for (int j = 0; j < 8; ++j) v[j] = ((const f32x4*)xr)[64 * j + lane];
    normmod_q8_vals(v, g, sc, sh, hr, sa, lane);
}
template <int NS> __device__ __forceinline__ void fix_row_vals(f32x4 (&v)[8], const float* base, const float* slab, const float* gate, const float scale, float* xo, int lane) {
#pragma unroll
    for (int j = 0; j < 8; ++j) { f32x4 a = (f32x4){0.f, 0.f, 0.f, 0.f};
#pragma unroll
        for (int k = 0; k < NS; ++k) a += ((const f32x4*)(slab + (size_t)k * MS * D))[64 * j + lane];
        v[j] = ((const f32x4*)base)[64 * j + lane] + (((const f32x4*)gate)[64 * j + lane] * scale) * a; ((f32x4*)xo)[64 * j + lane] = v[j]; }
}

__device__ __forceinline__ void post_row(const Ptrs& p, int row, int lane) {
    const bf16_t* PROJ = (const bf16_t*)(p.WS() + WS_PROJ); const float* SMALL = (const float*)(p.WS() + WS_SMALL);
    const bf16_t* pr = PROJ + (size_t)row * PROJ_LD; const float* sm = SMALL + (size_t)row * SMALL_LD;
    const bool prompt = row < MP; const int b = prompt ? row >> 11 : (row - MP) >> 2, t = prompt ? row & 2047 : (row - MP) & 3;
    const int rrel = prompt ? row : row - MP;
    {
        const u32x4 w0 = *(const u32x4*)(pr + PC_QA + 16 * lane), w1 = *(const u32x4*)(pr + PC_QA + 16 * lane + 8);
        float q[16];
#pragma unroll
        for (int i = 0; i < 4; ++i) { q[2 * i] = bflo(w0[i]); q[2 * i + 1] = bfhi(w0[i]); q[8 + 2 * i] = bflo(w1[i]); q[8 + 2 * i + 1] = bfhi(w1[i]); }
        float ss = 0.f;
#pragma unroll
        for (int i = 0; i < 16; ++i) ss += q[i] * q[i];
        ss += __shfl_xor(ss, 1); ss += __shfl_xor(ss, 2); ss += __shfl_xor(ss, 4);
        const float r = (1.0f / sqrtf(ss * (1.0f / 128.0f) + EPS)) * 0.08838834764831845f;
        const float* gq = p.qn_g + ((16 * lane) & 127);
        u32x4 o0, o1;
#pragma unroll
        for (int i = 0; i < 4; ++i) { o0[i] = pk2(q[2 * i] * r * gq[2 * i], q[2 * i + 1] * r * gq[2 * i + 1]); o1[i] = pk2(q[8 + 2 * i] * r * gq[8 + 2 * i], q[8 + 2 * i + 1] * r * gq[8 + 2 * i + 1]); }
        bf16_t* qa = (bf16_t*)(p.WS() + WS_QA) + (size_t)row * 1024 + 16 * lane;
        *(u32x4*)qa = o0; *(u32x4*)(qa + 8) = o1;
    }
    {
        const u32x2 w = *(const u32x2*)(pr + PC_KA + 4 * lane);
        float k[4] = {bflo(w[0]), bfhi(w[0]), bflo(w[1]), bfhi(w[1])};
        float ss = (k[0] * k[0] + k[1] * k[1]) + (k[2] * k[2] + k[3] * k[3]);
        ss += __shfl_xor(ss, 1); ss += __shfl_xor(ss, 2); ss += __shfl_xor(ss, 4); ss += __shfl_xor(ss, 8); ss += __shfl_xor(ss, 16);
        const float r = 1.0f / sqrtf(ss * (1.0f / 128.0f) + EPS);
        const f32x4 gk = *(const f32x4*)(p.kn_g + ((4 * lane) & 127));
        f32x4 o; o[0] = k[0] * r * gk[0]; o[1] = k[1] * r * gk[1]; o[2] = k[2] * r * gk[2]; o[3] = k[3] * r * gk[3];
        *(f32x4*)(p.out + (prompt ? O_KP : O_KS) + (size_t)rrel * 256 + 4 * lane) = o;
        u32x2 ob; ob[0] = pk2(o[0], o[1]); ob[1] = pk2(o[2], o[3]);
        *(u32x2*)((bf16_t*)(p.WS() + WS_KA) + (size_t)row * 256 + 4 * lane) = ob;
        const u32x2 wv = *(const u32x2*)(pr + PC_VA + 4 * lane);
        f32x4 ov; ov[0] = bflo(wv[0]); ov[1] = bfhi(wv[0]); ov[2] = bflo(wv[1]); ov[3] = bfhi(wv[1]);
        *(f32x4*)(p.out + (prompt ? O_VP : O_VS) + (size_t)rrel * 256 + 4 * lane) = ov;
    }
    { const float kv = sm[lane]; p.out[(prompt ? O_IKP : O_IKS) + (size_t)rrel * 64 + lane] = kv; ((bf16_t*)(p.WS() + WS_KI))[(size_t)row * 64 + lane] = f2bf(kv); }
    if (!prompt) {
        bf16_t* QM = (bf16_t*)(p.WS() + WS_QM); bf16_t* KM = (bf16_t*)(p.WS() + WS_KM);
#pragma unroll
        for (int j = 0; j < 4; ++j) {
            const int c = 8 * lane + 512 * j;
            float xs[4][8];
#pragma unroll
            for (int k = 0; k < 4; ++k) {
                if (t - k >= 0) { const u32x4 w = *(const u32x4*)(pr - (size_t)k * PROJ_LD + c);
#pragma unroll
                    for (int i = 0; i < 4; ++i) { xs[k][2 * i] = bflo(w[i]); xs[k][2 * i + 1] = bfhi(w[i]); } }
                else if (prompt) {
#pragma unroll
                    for (int i = 0; i < 8; ++i) xs[k][i] = 0.f; }
                else { const float* sb = p.state_conv + ((size_t)b * 3 + (3 + t - k)) * 2048 + c; const f32x4 a0 = *(const f32x4*)sb, a1 = *(const f32x4*)(sb + 4);
#pragma unroll
                    for (int i = 0; i < 4; ++i) { xs[k][i] = a0[i]; xs[k][4 + i] = a1[i]; } }
            }
            float y[8];
#pragma unroll
            for (int i = 0; i < 8; ++i) y[i] = 0.f;
#pragma unroll
            for (int k = 0; k < 4; ++k) { const float* wk = p.conv_w + (size_t)(3 - k) * 2048 + c; const f32x4 a0 = *(const f32x4*)wk, a1 = *(const f32x4*)(wk + 4);
#pragma unroll
                for (int i = 0; i < 4; ++i) { y[i] += a0[i] * xs[k][i]; y[4 + i] += a1[i] * xs[k][4 + i]; } }
            const float scl = c < 1024 ? 1.0f : 0.0625f;
            u32x4 o;
#pragma unroll
            for (int i = 0; i < 4; ++i) o[i] = pk2(silu_f(y[2 * i]) * scl, silu_f(y[2 * i + 1]) * scl);
            if (c < 1024) *(u32x4*)(QM + (size_t)row * 1024 + c) = o; else *(u32x4*)(KM + (size_t)row * 1024 + (c - 1024)) = o;
            const int slot = prompt ? t - (TP - 3) : t - 1;
            if (slot >= 0) { float* cv = p.out + (prompt ? O_CVP : O_CVS) + ((size_t)b * 3 + slot) * 2048 + c;
                f32x4 a0, a1;
#pragma unroll
                for (int i = 0; i < 4; ++i) { a0[i] = xs[0][i]; a1[i] = xs[0][4 + i]; }
                *(f32x4*)cv = a0; *(f32x4*)(cv + 4) = a1; }
        }
    }
}
__device__ __forceinline__ void conv_load(u32x2 (&xr)[11], const Ptrs& p, const int unit, const int lane) {
    const bf16_t* PROJ = (const bf16_t*)(p.WS() + WS_PROJ);
    const int rg = unit >> 3, slab = unit & 7, row0 = 8 * rg, t0 = row0 & 2047, c = 256 * slab + 4 * lane;
#pragma unroll
    for (int i = 0; i < 11; ++i) { if (t0 + i - 3 >= 0) xr[i] = *(const u32x2*)(PROJ + (size_t)(row0 + i - 3) * PROJ_LD + c); else { xr[i].x = 0u; xr[i].y = 0u; } }
}
__device__ __forceinline__ void conv_compute(const u32x2 (&xr)[11], const f32x4 (&w)[4], const Ptrs& p, const int unit, const int lane) {
    bf16_t* QM = (bf16_t*)(p.WS() + WS_QM); bf16_t* KM = (bf16_t*)(p.WS() + WS_KM);
    const int rg = unit >> 3, slab = unit & 7, row0 = 8 * rg, t0 = row0 & 2047, b = row0 >> 11, c = 256 * slab + 4 * lane;
    const float scl = c < 1024 ? 1.0f : 0.0625f; bf16_t* dst = c < 1024 ? QM + c : KM + (c - 1024);
#pragma unroll
    for (int i = 0; i < 8; ++i) {
        f32x4 y = (f32x4){0.f, 0.f, 0.f, 0.f};
#pragma unroll
        for (int k = 0; k < 4; ++k) { const u32x2 x = xr[i + k]; f32x4 xv; xv[0] = bflo(x.x); xv[1] = bfhi(x.x); xv[2] = bflo(x.y); xv[3] = bfhi(x.y); y += w[k] * xv; }
        u32x2 o; o.x = pk2(silu_f(y[0]) * scl, silu_f(y[1]) * scl); o.y = pk2(silu_f(y[2]) * scl, silu_f(y[3]) * scl);
        *(u32x2*)(dst + (size_t)(row0 + i) * 1024) = o;
        const int slot = t0 + i - (TP - 3);
        if (slot >= 0) { const u32x2 x = xr[i + 3]; f32x4 xv; xv[0] = bflo(x.x); xv[1] = bfhi(x.x); xv[2] = bflo(x.y); xv[3] = bfhi(x.y); *(f32x4*)(p.out + O_CVP + ((size_t)b * 3 + slot) * 2048 + c) = xv; }
    }
}
__device__ __forceinline__ float logsigmoid_f(float x) { return fminf(x, 0.f) - log1pf(expf(-fabsf(x))); }
__device__ __forceinline__ void scan_bh(const Ptrs& p, int bh, int lane) {
    const float* SMALL = (const float*)(p.WS() + WS_SMALL);
    float* BC = (float*)(p.WS() + WS_BC) + (size_t)bh * 2048; float* IG = (float*)(p.WS() + WS_IG) + (size_t)bh * 2048; float* MMa = (float*)(p.WS() + WS_MM) + (size_t)bh * 2048;
    const int b = bh >> 2, h = bh & 3; const float bi = p.gate_b[h], bfv = p.gate_b[4 + h];
    float lf[32], ig[32];
    float A = 0.f, Bv = -INFINITY;
#pragma unroll
    for (int i = 0; i < 32; ++i) { const float* sm = SMALL + ((size_t)b * 2048 + 32 * lane + i) * SMALL_LD; ig[i] = sm[64 + h] + bi; lf[i] = logsigmoid_f(sm[68 + h] + bfv); A += lf[i]; Bv = fmaxf(Bv + lf[i], ig[i]); }
    const float Aown = A;
#pragma unroll
    for (int off = 1; off < 64; off <<= 1) { const float Ap = __shfl_up(A, off), Bp = __shfl_up(Bv, off); if (lane >= off) { Bv = fmaxf(Bp + A, Bv); A = Ap + A; } }
    float Aex = __shfl_up(A, 1), Bex = __shfl_up(Bv, 1); if (lane == 0) { Aex = 0.f; Bex = -INFINITY; }
    float m = fmaxf(0.0f + Aex, Bex);
    float c = __shfl_up(Aown, 1); if ((lane & 1) == 0) c = 0.f;
#pragma unroll
    for (int i = 0; i < 32; ++i) { m = fmaxf(m + lf[i], ig[i]); c += lf[i]; const int t = 32 * lane + i; MMa[t] = m; BC[t] = c; IG[t] = ig[i]; }
}

__device__ __forceinline__ void mlstm_sample_items(const Ptrs& p, unsigned char* lds, const int first, const int stride, const int tid) {
    float (*qf)[256] = (float (*)[256])(lds); float (*kf)[256] = (float (*)[256])(lds + 4096); float (*vf)[256] = (float (*)[256])(lds + 8192);
    float (*red)[4][256] = (float (*)[4][256])(lds + 12288);
    float* bc = (float*)(lds + 12288 + 32768); float* ig = bc + 4; float* mm = bc + 8; float* sw = bc + 12; float* wl = bc + 16; float (*Pm)[4] = (float (*)[4])(bc + 20); float* qn = bc + 36; float* sc2 = bc + 40;
    const int lane = tid & 63, wv = tid >> 6;
    const bf16_t* QM = (const bf16_t*)(p.WS() + WS_QM); const bf16_t* KM = (const bf16_t*)(p.WS() + WS_KM); const bf16_t* PROJ = (const bf16_t*)(p.WS() + WS_PROJ); const float* SMALL = (const float*)(p.WS() + WS_SMALL);
    float* HM = (float*)(p.WS() + WS_HM);
    for (int item = first; item < BS * 4; item += stride) {
        const int b = item >> 2, h = item & 3; const size_t r0 = (size_t)MP + 4 * b;
        for (int i = tid; i < 1024; i += 512) { const int t = i >> 8, d = i & 255;
            qf[t][d] = bf2f(QM[(r0 + t) * 1024 + h * 256 + d]); kf[t][d] = bf2f(KM[(r0 + t) * 1024 + h * 256 + d]); vf[t][d] = bf2f(PROJ[(r0 + t) * PROJ_LD + PC_VM + h * 256 + d]); }
        if (tid == 0) {
            const float m0 = p.state_m[item]; float m = m0, c = 0.f;
            for (int t = 0; t < 4; ++t) { const float* sm = SMALL + (r0 + t) * SMALL_LD; const float igt = sm[64 + h] + p.gate_b[h], lft = logsigmoid_f(sm[68 + h] + p.gate_b[4 + h]);
                m = fmaxf(m + lft, igt); c += lft; bc[t] = c; ig[t] = igt; mm[t] = m; sw[t] = expf(c + m0 - m); }
            for (int t = 0; t < 4; ++t) wl[t] = expf(bc[3] - bc[t] + ig[t] - mm[3]);
            sc2[0] = expf(bc[3] + m0 - mm[3]);
        }
        __syncthreads();
        if (wv < 4) {
            const int t = wv; float a = 0.f, d0 = 0.f, d1 = 0.f, d2 = 0.f, d3 = 0.f;
            for (int i = 0; i < 4; ++i) { const int d = lane + 64 * i; const float qv = qf[t][d]; a += qv * p.state_n[(size_t)item * 256 + d]; d0 += qv * kf[0][d]; d1 += qv * kf[1][d]; d2 += qv * kf[2][d]; d3 += qv * kf[3][d]; }
            a = wave_sum(a); d0 = wave_sum(d0); d1 = wave_sum(d1); d2 = wave_sum(d2); d3 = wave_sum(d3);
            if (lane == 0) { qn[t] = a; const float dd[4] = {d0, d1, d2, d3};
                for (int s = 0; s < 4; ++s) Pm[t][s] = s <= t ? dd[s] * expf(bc[t] - bc[s] + ig[s] - mm[t]) : 0.f; }
        }
        __syncthreads();
        {
            const int e = 4 * lane; const float decay = sc2[0];
            f32x4 qc[4]; for (int t = 0; t < 4; ++t) qc[t] = (f32x4){0.f, 0.f, 0.f, 0.f};
            f32x4 vv[4]; for (int s = 0; s < 4; ++s) vv[s] = *(const f32x4*)&vf[s][e];
            const float* Cin = p.state_C + (size_t)item * 65536; float* Cout = p.out + O_CS + (size_t)item * 65536;
            for (int i0 = 0; i0 < 32; i0 += 8) { f32x4 c8[8];
#pragma unroll
                for (int ii = 0; ii < 8; ++ii) c8[ii] = *(const f32x4*)(Cin + (size_t)(wv + 8 * (i0 + ii)) * 256 + e);
#pragma unroll
                for (int ii = 0; ii < 8; ++ii) { const int d = wv + 8 * (i0 + ii); const f32x4 c0 = c8[ii];
                    f32x4 cn = c0 * decay;
#pragma unroll
                    for (int s = 0; s < 4; ++s) cn += (wl[s] * kf[s][d]) * vv[s];
                    *(f32x4*)(Cout + (size_t)d * 256 + e) = cn;
#pragma unroll
                    for (int t = 0; t < 4; ++t) qc[t] += qf[t][d] * c0; } }
#pragma unroll
            for (int t = 0; t < 4; ++t) *(f32x4*)&red[wv][t][e] = qc[t];
        }
        __syncthreads();
        for (int i = tid; i < 1024; i += 512) { const int t = i >> 8, e = i & 255; float QC = 0.f;
#pragma unroll
            for (int w = 0; w < 8; ++w) QC += red[w][t][e];
            float num = sw[t] * QC, rs = 0.f;
            for (int s = 0; s <= t; ++s) { num += Pm[t][s] * vf[s][e]; rs += Pm[t][s]; }
            const float den = rs + sw[t] * qn[t];
            HM[(r0 + t) * 1024 + h * 256 + e] = num / fmaxf(fabsf(den), expf(-mm[t])); }
        if (tid < 256) { const int d = tid; float a = sc2[0] * p.state_n[(size_t)item * 256 + d]; for (int s = 0; s < 4; ++s) a += wl[s] * kf[s][d]; p.out[O_NS + (size_t)item * 256 + d] = a; }
        if (tid == 0) p.out[O_MS + item] = mm[3];
        __syncthreads();
    }
}

__device__ __forceinline__ void mlstm_out_row(const Ptrs& p, const int row, const int lane) {
    const float* HM = (const float*)(p.WS() + WS_HM); const bf16_t* PROJ = (const bf16_t*)(p.WS() + WS_PROJ); bf16_t* CAT = (bf16_t*)(p.WS() + WS_CAT);
    {
        const float* hr = HM + (size_t)row * 1024 + 16 * lane; float hv[16];
#pragma unroll
        for (int i = 0; i < 4; ++i) { const f32x4 a = *(const f32x4*)(hr + 4 * i); hv[4 * i] = a[0]; hv[4 * i + 1] = a[1]; hv[4 * i + 2] = a[2]; hv[4 * i + 3] = a[3]; }
        float ss = 0.f;
#pragma unroll
        for (int i = 0; i < 16; ++i) ss += hv[i] * hv[i];
        ss += __shfl_xor(ss, 1); ss += __shfl_xor(ss, 2); ss += __shfl_xor(ss, 4); ss += __shfl_xor(ss, 8);
        const float r = 1.0f / sqrtf(ss * (1.0f / 256.0f) + EPS);
        const bf16_t* orow = PROJ + (size_t)row * PROJ_LD + PC_OM + 16 * lane; const u32x4 w0 = *(const u32x4*)orow, w1 = *(const u32x4*)(orow + 8);
        float ov[16];
#pragma unroll
        for (int i = 0; i < 4; ++i) { ov[2 * i] = bflo(w0[i]); ov[2 * i + 1] = bfhi(w0[i]); ov[8 + 2 * i] = bflo(w1[i]); ov[8 + 2 * i + 1] = bfhi(w1[i]); }
        const float* g = p.out_g + 16 * lane; u32x4 o0, o1;
#pragma unroll
        for (int i = 0; i < 4; ++i) {
            const float a0 = hv[2 * i] * r * g[2 * i] / (1.0f + __expf(-ov[2 * i])), a1 = hv[2 * i + 1] * r * g[2 * i + 1] / (1.0f + __expf(-ov[2 * i + 1]));
            const float b0 = hv[8 + 2 * i] * r * g[8 + 2 * i] / (1.0f + __expf(-ov[8 + 2 * i])), b1 = hv[8 + 2 * i + 1] * r * g[8 + 2 * i + 1] / (1.0f + __expf(-ov[8 + 2 * i + 1]));
            o0[i] = pk2(a0, a1); o1[i] = pk2(b0, b1); }
        bf16_t* cr = CAT + (size_t)row * D + 16 * lane; *(u32x4*)cr = o0; *(u32x4*)(cr + 8) = o1;
    }
}

__device__ __forceinline__ unsigned order_key(float x) { const unsigned bts = __float_as_uint(x); return (bts & 0x80000000u) ? ~bts : (bts | 0x80000000u); }
template <int NREG> __device__ __forceinline__ void select_load(float (&raw)[NREG], const float* sc, int lane) {
#pragma unroll
    for (int i = 0; i < NREG; ++i) raw[i] = sc[64 * i + lane];
}
template <int NREG> __device__ __forceinline__ void select_compute(const float (&raw)[NREG], int nvalid, u64* mask, int lane) {
    unsigned u[NREG];
#pragma unroll
    for (int i = 0; i < NREG; ++i) { const int s = 64 * i + lane; u[i] = s < nvalid ? order_key(raw[i]) : 0u; }
    if (nvalid <= 256) {
#pragma unroll
        for (int i = 0; i < NREG; ++i) { const u64 mk = __ballot(64 * i + lane < nvalid); if (lane == 0) mask[i] = mk; }
        return;
    }
    unsigned T = 0u; bool exact = false;
    for (int bit = 31; bit >= 0; --bit) {
        const unsigned cand = T | (1u << bit);
        int cnt = 0;
#pragma unroll
        for (int i = 0; i + 3 < NREG; i += 4) { u64 m0, m1, m2, m3;
            asm volatile("v_cmp_ge_u32_e64 %0, %4, %8\n\tv_cmp_ge_u32_e64 %1, %5, %8\n\tv_cmp_ge_u32_e64 %2, %6, %8\n\tv_cmp_ge_u32_e64 %3, %7, %8\n\ts_nop 4"
                         : "=&s"(m0), "=&s"(m1), "=&s"(m2), "=&s"(m3) : "v"(u[i]), "v"(u[i + 1]), "v"(u[i + 2]), "v"(u[i + 3]), "s"(cand));
            cnt += (__popcll(m0) + __popcll(m1)) + (__popcll(m2) + __popcll(m3)); }
#pragma unroll
        for (int i = NREG & ~3; i < NREG; ++i) cnt += __popcll(__ballot(u[i] >= cand));
        if (cnt >= 256) T = cand;
        if (cnt == 256) { exact = true; break; }
    }
    if (exact) {
#pragma unroll
        for (int i = 0; i < NREG; ++i) { const u64 mk = __ballot(u[i] >= T); if (lane == 0) mask[i] = mk; }
        return;
    }
    int G = 0;
#pragma unroll
    for (int i = 0; i < NREG; ++i) G += __popcll(__ballot(u[i] > T));
    int need = 256 - G;
#pragma unroll
    for (int i = 0; i < NREG; ++i) {
        const u64 gt = __ballot(u[i] > T), eq = __ballot(u[i] == T); const int c = __popcll(eq); u64 take;
        if (c <= need) { take = eq; need -= c; }
        else { u64 mrem = eq; take = 0ull; for (int k = 0; k < need; ++k) { const u64 low = mrem & (~mrem + 1ull); take |= low; mrem ^= low; } need = 0; }
        if (lane == 0) mask[i] = gt | take;
    }
}

namespace pg8 {
#define PG8_LAS __attribute__((address_space(3)))
typedef unsigned short bf16_t;
typedef short bf16x8 __attribute__((ext_vector_type(8)));
typedef float f32x4 __attribute__((ext_vector_type(4)));
typedef unsigned u32x4 __attribute__((ext_vector_type(4)));
typedef int i32x4 __attribute__((ext_vector_type(4)));
constexpr int BM = 256, BK = 64, HALF = 128, HTB = HALF * BK * 2  , STAGE_BYTES = 8 * HTB, NXCD = 8, WGM = 8;

__host__ __device__ __forceinline__ int lds_byte(int r, int c) { const int st = (r >> 4) * 2 + (c >> 5), rr = r & 15, cc = c & 31, ob = rr * 64 + cc * 2; return st * 1024 + (ob ^ (((ob >> 9) & 1) << 5)); }
__host__ __device__ __forceinline__ void stage_rc(int b, int& R, int& C) { const int st = b / 1024, sb = b % 1024, swz = sb ^ (((sb >> 9) & 1) << 5); R = (st >> 1) * 16 + swz / 64; C = (st & 1) * 32 + (swz % 64) / 2; }
__host__ __device__ __forceinline__ int perm32(int rho) { const int n = rho >> 4, i = rho & 15; return 8 * (i >> 2) + 4 * n + (i & 3); }

struct Unit { int pm, pn, pk; };
struct Gemm { const bf16_t* A; const bf16_t* Bt; int M, N, K, KL; };

struct StaticOrder {
    int nM, nN, nwg, G, c, wgm;
    __host__ __device__ void init(int M, int N, int G_, int c_, int wgm_ = WGM) { nM = M / BM; nN = N / BM; nwg = nM * nN; G = G_; c = c_; wgm = wgm_; }
    __host__ __device__ bool next(int i, Unit& u) const {
        const long L = (long)i * G + c; if (L >= nwg) return false;
        int wgid = (int)L; { const int q = nwg / NXCD, r = nwg % NXCD, xcd = wgid % NXCD, off = wgid / NXCD; wgid = (xcd < r ? xcd * (q + 1) : r * (q + 1) + (xcd - r) * q) + off; }
        const int nig = wgm * nN, gid = wgid / nig, fm = gid * wgm, gsz = (nM - fm) < wgm ? (nM - fm) : wgm;
        u.pm = fm + ((wgid % nig) % gsz); u.pn = (wgid % nig) / gsz; u.pk = 0; return true;
    }
    __device__ __forceinline__ void a_ready(const Unit&) const {}
    __device__ __forceinline__ void done(const Unit&) const {}
};
struct SampleOrder {
    StaticOrder S;
    __host__ __device__ void init(int N, int G_, int c_) { S.init(MS, N, G_, c_); }
    __host__ __device__ bool next(int i, Unit& u) const { if (!S.next(i, u)) return false; u.pm += MP / BM; return true; }
    __device__ __forceinline__ void a_ready(const Unit&) const {}
    __device__ __forceinline__ void done(const Unit&) const {}
};


typedef float f32x2_t __attribute__((ext_vector_type(2)));
typedef __bf16 bf16x2_t __attribute__((ext_vector_type(2)));
__device__ __forceinline__ unsigned cvt_pk_bf16(float lo, float hi) { const f32x2_t v = {lo, hi}; const bf16x2_t b = __builtin_convertvector(v, bf16x2_t); return __builtin_bit_cast(unsigned, b); }
__device__ __forceinline__ float silu_fast(float x) { return x * __builtin_amdgcn_rcpf(1.0f + __expf(-x)); }

struct EpiSwiglu {
    typedef f32x4 AccT; static constexpr bool PERM = true, AFTER_DRAIN = false;
    bf16_t* O;
    __device__ __forceinline__ void operator()(const f32x4 (&acc)[2][2][4][2], const Unit& u, int wr, int wc, int fr, int fq) const {
        const int row0 = u.pm * BM + wr * 64 + fr, col0 = u.pn * HALF + wc * 32 + 8 * fq;
#pragma unroll
        for (int ai = 0; ai < 2; ++ai)
#pragma unroll
            for (int m = 0; m < 4; ++m) { bf16_t* rowp = O + (size_t)(row0 + ai * HALF + m * 16) * FF + col0;
                const f32x4 g0 = acc[ai][0][m][0], g1 = acc[ai][0][m][1], u0 = acc[ai][1][m][0], u1 = acc[ai][1][m][1];
                u32x4 w; w.x = cvt_pk_bf16(silu_fast(g0[0]) * u0[0], silu_fast(g0[1]) * u0[1]); w.y = cvt_pk_bf16(silu_fast(g0[2]) * u0[2], silu_fast(g0[3]) * u0[3]);
                w.z = cvt_pk_bf16(silu_fast(g1[0]) * u1[0], silu_fast(g1[1]) * u1[1]); w.w = cvt_pk_bf16(silu_fast(g1[2]) * u1[2], silu_fast(g1[3]) * u1[3]);
                *(u32x4*)rowp = w; }
    }
};
struct EpiSwigluI8 {
    typedef i32x4 AccT; static constexpr bool PERM = true, AFTER_DRAIN = false;
    bf16_t* O; const float* sa; const float* sb; float* rmaxp; unsigned char* O8;
    __device__ __forceinline__ void operator()(const i32x4 (&acc)[2][2][4][2], const Unit& u, int wr, int wc, int fr, int fq) const {
        const int row0 = u.pm * BM + wr * 64 + fr, col0 = u.pn * HALF + wc * 32 + 8 * fq, brow = u.pn * BM + wc * 32 + 8 * fq;
        const f32x4 sg0 = *(const f32x4*)(sb + brow), sg1 = *(const f32x4*)(sb + brow + 4), su0 = *(const f32x4*)(sb + brow + HALF), su1 = *(const f32x4*)(sb + brow + HALF + 4);
#pragma unroll
        for (int ai = 0; ai < 2; ++ai)
#pragma unroll
            for (int m = 0; m < 4; ++m) { const int row = row0 + ai * HALF + m * 16; const float sr = sa[row]; bf16_t* rowp = O + (size_t)row * FF + col0;
                const i32x4 g0 = acc[ai][0][m][0], g1 = acc[ai][0][m][1], u0 = acc[ai][1][m][0], u1 = acc[ai][1][m][1];
                float o[8];
#pragma unroll
                for (int e = 0; e < 4; ++e) { o[e] = silu_fast((float)g0[e] * (sr * sg0[e])) * ((float)u0[e] * (sr * su0[e])); o[4 + e] = silu_fast((float)g1[e] * (sr * sg1[e])) * ((float)u1[e] * (sr * su1[e])); }
                float mx = fmaxf(fmaxf(fmaxf(fabsf(o[0]), fabsf(o[1])), fmaxf(fabsf(o[2]), fabsf(o[3]))), fmaxf(fmaxf(fabsf(o[4]), fabsf(o[5])), fmaxf(fabsf(o[6]), fabsf(o[7]))));
                mx = x32_max(x16_max(mx));
                if (u.pm < MP / BM) {
                    const float inv = 127.0f / fmaxf(mx, 1e-30f); unsigned b[8];
#pragma unroll
                    for (int e = 0; e < 8; ++e) b[e] = __float_as_uint(__builtin_fmaf(o[e], inv, 12583040.0f));
                    u32x2 w8; w8.x = __builtin_amdgcn_perm(b[1], b[0], 0x0c0c0400u) | __builtin_amdgcn_perm(b[3], b[2], 0x04000c0cu); w8.y = __builtin_amdgcn_perm(b[5], b[4], 0x0c0c0400u) | __builtin_amdgcn_perm(b[7], b[6], 0x04000c0cu);
                    *(u32x2*)(O8 + (size_t)row * FF + col0) = w8;
                    if (fq == 0) rmaxp[(size_t)row * 176 + u.pn * 4 + wc] = mx;
                } else { u32x4 w; w.x = cvt_pk_bf16(o[0], o[1]); w.y = cvt_pk_bf16(o[2], o[3]); w.z = cvt_pk_bf16(o[4], o[5]); w.w = cvt_pk_bf16(o[6], o[7]); *(u32x4*)rowp = w; } }
    }
};
struct EpiResid {
    typedef f32x4 AccT; static constexpr bool PERM = false, AFTER_DRAIN = false;
    const float* base_p; const float* base_s; float* out; const float* gate; float scale;
    __device__ __forceinline__ void operator()(const f32x4 (&acc)[2][2][4][2], const Unit& u, int wr, int wc, int fr, int fq) const {
        const int col0 = u.pn * BM + wc * 32 + 4 * fq;
#pragma unroll
        for (int ai = 0; ai < 2; ++ai)
#pragma unroll
            for (int m = 0; m < 4; ++m) { const int row = u.pm * BM + ai * HALF + wr * 64 + m * 16 + fr;
                const float* bp = (row < MP ? base_p + (size_t)row * D : base_s + (size_t)(row - MP) * D) + col0;
                const float* gp = gate + (size_t)row_bm(row) * NMOD + col0; float* op = out + (size_t)row * D + col0;
#pragma unroll
                for (int bj = 0; bj < 2; ++bj)
#pragma unroll
                    for (int n = 0; n < 2; ++n) { const int o = bj * HALF + n * 16; const f32x4 bs = *(const f32x4*)(bp + o), g = *(const f32x4*)(gp + o);
                        *(f32x4*)(op + o) = bs + (g * scale) * acc[ai][bj][m][n]; } }
    }
};
template <bool BB, bool OB> struct EpiResidT {
    typedef f32x4 AccT; static constexpr bool PERM = false, AFTER_DRAIN = false;
    const void* base; void* out; const float* gate; float scale;
    __device__ __forceinline__ void operator()(const f32x4 (&acc)[2][2][4][2], const Unit& u, int wr, int wc, int fr, int fq) const {
        const int col0 = u.pn * BM + wc * 32 + 4 * fq, row0 = u.pm * BM + wr * 64 + fr;
        const float* gp = gate + (size_t)(u.pm >> 3) * NMOD + col0;
#pragma unroll
        for (int bj = 0; bj < 2; ++bj)
#pragma unroll
            for (int n = 0; n < 2; ++n) { const int o = bj * HALF + n * 16; const f32x4 gs = *(const f32x4*)(gp + o) * scale;
#pragma unroll
                for (int ai = 0; ai < 2; ++ai) { f32x4 bs[4];
#pragma unroll
                    for (int m = 0; m < 4; ++m) { const size_t off = (size_t)(row0 + ai * HALF + m * 16) * D + col0 + o;
                        if (BB) { const u32x2 w = *(const u32x2*)((const bf16_t*)base + off); bs[m][0] = bflo(w.x); bs[m][1] = bfhi(w.x); bs[m][2] = bflo(w.y); bs[m][3] = bfhi(w.y); }
                        else bs[m] = *(const f32x4*)((const float*)base + off); }
#pragma unroll
                    for (int m = 0; m < 4; ++m) { const size_t off = (size_t)(row0 + ai * HALF + m * 16) * D + col0 + o; const f32x4 v = bs[m] + gs * acc[ai][bj][m][n];
                        if (OB) { u32x2 w; w.x = cvt_pk_bf16(v[0], v[1]); w.y = cvt_pk_bf16(v[2], v[3]); *(u32x2*)((bf16_t*)out + off) = w; }
                        else *(f32x4*)((float*)out + off) = v; }
                    asm volatile("" ::: "memory"); } }
    }
};
template <bool BB, bool OB> struct EpiResidI8T {
    typedef i32x4 AccT; static constexpr bool PERM = false, AFTER_DRAIN = false;
    const void* base; void* out; const float* gate; float scale; const float* sa; const float* sb;
    __device__ __forceinline__ void operator()(const i32x4 (&acc)[2][2][4][2], const Unit& u, int wr, int wc, int fr, int fq) const {
        const int col0 = u.pn * BM + wc * 32 + 4 * fq, row0 = u.pm * BM + wr * 64 + fr;
        const float* gp = gate + (size_t)(u.pm >> 3) * NMOD + col0;
        float sr[2][4];
#pragma unroll
        for (int ai = 0; ai < 2; ++ai)
#pragma unroll
            for (int m = 0; m < 4; ++m) sr[ai][m] = sa[row0 + ai * HALF + m * 16] * scale;
#pragma unroll
        for (int bj = 0; bj < 2; ++bj)
#pragma unroll
            for (int n = 0; n < 2; ++n) { const int o = bj * HALF + n * 16; const f32x4 gs = *(const f32x4*)(sb + col0 + o) * *(const f32x4*)(gp + o);
#pragma unroll
                for (int ai = 0; ai < 2; ++ai) { f32x4 bs[4];
#pragma unroll
                    for (int m = 0; m < 4; ++m) { const size_t off = (size_t)(row0 + ai * HALF + m * 16) * D + col0 + o;
                        if (BB) { const u32x2 w = *(const u32x2*)((const bf16_t*)base + off); bs[m][0] = bflo(w.x); bs[m][1] = bfhi(w.x); bs[m][2] = bflo(w.y); bs[m][3] = bfhi(w.y); }
                        else bs[m] = *(const f32x4*)((const float*)base + off); }
#pragma unroll
                    for (int m = 0; m < 4; ++m) { const size_t off = (size_t)(row0 + ai * HALF + m * 16) * D + col0 + o; const i32x4 a = acc[ai][bj][m][n];
                        f32x4 v; v[0] = (float)a[0]; v[1] = (float)a[1]; v[2] = (float)a[2]; v[3] = (float)a[3];
                        v = bs[m] + (gs * sr[ai][m]) * v;
                        if (OB) { u32x2 w; w.x = cvt_pk_bf16(v[0], v[1]); w.y = cvt_pk_bf16(v[2], v[3]); *(u32x2*)((bf16_t*)out + off) = w; }
                        else *(f32x4*)((float*)out + off) = v; }
                    asm volatile("" ::: "memory"); } }
    }
};
struct SplitOrder {
    int NS, G, c;
    __device__ __forceinline__ bool next(int i, Unit& u) const { const int L = i * G + c; if (L >= 16 * NS) return false; const int tile = L / NS; u.pk = L - tile * NS; u.pm = 64 + (tile >> 3); u.pn = tile & 7; return true; }
    __device__ __forceinline__ void a_ready(const Unit&) const {}
    __device__ __forceinline__ void done(const Unit&) const {}
};
struct EpiSlab {
    typedef f32x4 AccT; static constexpr bool PERM = false, AFTER_DRAIN = false;
    float* slab;
    __device__ __forceinline__ void operator()(const f32x4 (&acc)[2][2][4][2], const Unit& u, int wr, int wc, int fr, int fq) const {
        const int col0 = u.pn * BM + wc * 32 + 4 * fq;
#pragma unroll
        for (int ai = 0; ai < 2; ++ai)
#pragma unroll
            for (int m = 0; m < 4; ++m) { const int row = (u.pm - 64) * BM + ai * HALF + wr * 64 + m * 16 + fr; float* op = slab + ((size_t)u.pk * MS + row) * D + col0;
#pragma unroll
                for (int bj = 0; bj < 2; ++bj)
#pragma unroll
                    for (int n = 0; n < 2; ++n) *(f32x4*)(op + bj * HALF + n * 16) = acc[ai][bj][m][n]; }
    }
};
struct EpiProj {
    typedef f32x4 AccT; static constexpr bool PERM = true, AFTER_DRAIN = false;
    bf16_t* PROJ; float* SMALL;
    __device__ __forceinline__ void operator()(const f32x4 (&acc)[2][2][4][2], const Unit& u, int wr, int wc, int fr, int fq) const {
        const int row0 = u.pm * BM + wr * 64 + fr;
        if (u.pn < 24) {
            const int col0 = u.pn * BM + wc * 32 + 8 * fq;
#pragma unroll
            for (int ai = 0; ai < 2; ++ai)
#pragma unroll
                for (int m = 0; m < 4; ++m) { bf16_t* rowp = PROJ + (size_t)(row0 + ai * HALF + m * 16) * PROJ_LD + col0;
#pragma unroll
                    for (int bj = 0; bj < 2; ++bj) { const f32x4 v0 = acc[ai][bj][m][0], v1 = acc[ai][bj][m][1];
                        u32x4 w; w.x = cvt_pk_bf16(v0[0], v0[1]); w.y = cvt_pk_bf16(v0[2], v0[3]); w.z = cvt_pk_bf16(v1[0], v1[1]); w.w = cvt_pk_bf16(v1[2], v1[3]);
                        *(u32x4*)(rowp + bj * HALF) = w; } }
        } else {
            const int col0 = wc * 32 + 8 * fq;
#pragma unroll
            for (int ai = 0; ai < 2; ++ai)
#pragma unroll
                for (int m = 0; m < 4; ++m) { float* rowp = SMALL + (size_t)(row0 + ai * HALF + m * 16) * SMALL_LD + col0;
                    *(f32x4*)rowp = acc[ai][0][m][0]; *(f32x4*)(rowp + 4) = acc[ai][0][m][1]; }
        }
    }
};

template <class T> struct Mma16;
template <> struct Mma16<f32x4> { static __device__ __forceinline__ f32x4 op(bf16x8 a, bf16x8 b, f32x4 c) { return __builtin_amdgcn_mfma_f32_16x16x32_bf16(a, b, c, 0, 0, 0); } };
template <> struct Mma16<i32x4> { static __device__ __forceinline__ i32x4 op(bf16x8 a, bf16x8 b, i32x4 c) { return __builtin_amdgcn_mfma_i32_16x16x64_i8(__builtin_bit_cast(i32x4, a), __builtin_bit_cast(i32x4, b), c, 0, 0, 0); } };
template <class Epi, class Sched, bool ALIGN_EPI = false, bool SP2 = false>
__device__ __forceinline__ void gemm_phase(PG8_LAS unsigned char* lds, const Gemm g, const Sched& S, const Epi& E) {
    int tid = threadIdx.x; asm volatile("" : "+v"(tid));
    const int wid = __builtin_amdgcn_readfirstlane(tid >> 6), lane = tid & 63, wr = wid >> 2, wc = wid & 3, fr = lane & 15, fq = lane >> 4;
    const int K = g.K, nt = g.KL / BK; const size_t kslice = (size_t)g.KL * 2;
    unsigned voffA[2], voffB[2];
#pragma unroll
    for (int i = 0; i < 2; ++i) { int R, C; stage_rc(tid * 16 + i * 8192, R, C); const int Rb = Epi::PERM ? ((R & ~31) + perm32(R & 31)) : R;
        voffA[i] = (unsigned)(R * K + C) * 2u; voffB[i] = (unsigned)(Rb * K + C) * 2u; }
    const size_t kstep = (size_t)(BK * 2);
    const size_t hstep = (size_t)HALF * K * 2;
    const size_t tstep = 2 * hstep;
    const unsigned ldsw = (unsigned)wid * 1024u;
    const int aoff = lds_byte(wr * 64 + fr, fq * 8), boff = lds_byte(wc * 32 + fr, fq * 8);
#define PG8_SA(b, h) (((b) * 2 + (h)) * HTB)
#define PG8_SB(b, h) ((4 + (b) * 2 + (h)) * HTB)
#define PG8_STAGE(bufoff, gbase, voff) do { _Pragma("unroll") for (int _i = 0; _i < 2; ++_i) \
        __builtin_amdgcn_global_load_lds((const unsigned*)((const char*)(gbase) + (voff)[_i]), (PG8_LAS unsigned*)(lds + (bufoff) + ldsw + _i * 8192), 16, 0, 0); } while (0)
#define PG8_LDA(dst, b, h) do { _Pragma("unroll") for (int m = 0; m < 4; ++m) _Pragma("unroll") for (int k = 0; k < 2; ++k) dst[m][k] = *(const PG8_LAS bf16x8*)(lds + PG8_SA(b, h) + aoff + m * 2048 + k * 1024); } while (0)
#define PG8_LDB(dst, b, h) do { _Pragma("unroll") for (int n = 0; n < 2; ++n) _Pragma("unroll") for (int k = 0; k < 2; ++k) dst[n][k] = *(const PG8_LAS bf16x8*)(lds + PG8_SB(b, h) + boff + n * 2048 + k * 1024); } while (0)
#define PG8_MMA(ai, bj, At, Bt) do { __builtin_amdgcn_s_setprio(1); _Pragma("unroll") for (int m = 0; m < 4; ++m) _Pragma("unroll") for (int n = 0; n < 2; ++n) _Pragma("unroll") for (int k = 0; k < 2; ++k) \
        acc[ai][bj][m][n] = Mma16<AccT>::op(Bt[n][k], At[m][k], acc[ai][bj][m][n]); __builtin_amdgcn_s_setprio(0); } while (0)
#define PG8_WAIT_V(n) asm volatile("s_waitcnt vmcnt(" #n ")" ::: "memory")
#define PG8_WAIT_L(n) asm volatile("s_waitcnt lgkmcnt(" #n ")" ::: "memory")
#define PG8_BAR __builtin_amdgcn_s_barrier()
#define PG8_SCHED __builtin_amdgcn_sched_barrier(0)
    Unit cur, nxt; int ui = 0;
    if (!S.next(0, cur)) return;
    typedef typename Epi::AccT AccT; AccT acc[2][2][4][2];
#pragma unroll
    for (int a = 0; a < 2; ++a)
#pragma unroll
        for (int b = 0; b < 2; ++b)
#pragma unroll
            for (int m = 0; m < 4; ++m)
#pragma unroll
                for (int n = 0; n < 2; ++n) acc[a][b][m][n] = AccT{};
    bf16x8 At[4][2], B0[2][2], B1[2][2];
    const char* cA = (const char*)g.A + (size_t)cur.pm * tstep + (size_t)cur.pk * kslice; const char* cB = (const char*)g.Bt + (size_t)cur.pn * tstep + (size_t)cur.pk * kslice;
    S.a_ready(cur);
    if constexpr (SP2) {
        PG8_STAGE(PG8_SB(0, 0), cB, voffB); PG8_STAGE(PG8_SB(0, 1), cB + hstep, voffB); PG8_STAGE(PG8_SA(0, 0), cA, voffA); PG8_STAGE(PG8_SA(0, 1), cA + hstep, voffA);
        if (wr == 1) PG8_BAR;
        PG8_WAIT_V(2); PG8_BAR;
        PG8_STAGE(PG8_SB(1, 0), cB + kstep, voffB); PG8_STAGE(PG8_SA(1, 0), cA + kstep, voffA); PG8_STAGE(PG8_SB(1, 1), cB + hstep + kstep, voffB);
        PG8_WAIT_V(6); PG8_BAR;
    } else {
        PG8_STAGE(PG8_SB(0, 0), cB, voffB); PG8_STAGE(PG8_SA(0, 0), cA, voffA); PG8_STAGE(PG8_SB(0, 1), cB + hstep, voffB); PG8_STAGE(PG8_SA(0, 1), cA + hstep, voffA);
        if (wr == 1) PG8_BAR;
        PG8_WAIT_V(4); PG8_BAR;
        PG8_STAGE(PG8_SB(1, 0), cB + kstep, voffB); PG8_STAGE(PG8_SA(1, 0), cA + kstep, voffA); PG8_STAGE(PG8_SB(1, 1), cB + hstep + kstep, voffB);
        PG8_WAIT_V(6); PG8_BAR;
    }
    for (;;) {
        const bool has_next = S.next(ui + 1, nxt);
        const char* nA = has_next ? (const char*)g.A + (size_t)nxt.pm * tstep + (size_t)nxt.pk * kslice : cA; const char* nB = has_next ? (const char*)g.Bt + (size_t)nxt.pn * tstep + (size_t)nxt.pk * kslice : cB;
        for (int t = 0; t < nt; t += 2) {
            const bool last = (t == nt - 2);
            const char* a1 = cA + (size_t)(t + 1) * kstep;
            const char* a2 = last ? nA : cA + (size_t)(t + 2) * kstep; const char* b2 = last ? nB : cB + (size_t)(t + 2) * kstep;
            const char* a3 = a2 + kstep; const char* b3 = b2 + kstep;
            if (last && has_next) S.a_ready(nxt);
            if constexpr (SP2) {
            PG8_LDB(B0, 0, 0); PG8_LDB(B1, 0, 1); PG8_SCHED; PG8_LDA(At, 0, 0); PG8_STAGE(PG8_SA(1, 1), a1 + hstep, voffA);
            PG8_WAIT_V(8); PG8_WAIT_L(0); PG8_BAR; PG8_MMA(0, 0, At, B0); PG8_MMA(0, 1, At, B1); PG8_BAR; PG8_SCHED;
            PG8_LDA(At, 0, 1); PG8_STAGE(PG8_SB(0, 0), b2, voffB); PG8_STAGE(PG8_SB(0, 1), b2 + hstep, voffB); PG8_STAGE(PG8_SA(0, 0), a2, voffA);
            PG8_WAIT_V(8); PG8_WAIT_L(0); PG8_BAR; PG8_MMA(1, 0, At, B0); PG8_MMA(1, 1, At, B1); PG8_BAR; PG8_SCHED;
            PG8_LDB(B0, 1, 0); PG8_LDB(B1, 1, 1); PG8_SCHED; PG8_LDA(At, 1, 0); PG8_STAGE(PG8_SA(0, 1), a2 + hstep, voffA);
            PG8_WAIT_V(8); PG8_WAIT_L(0); PG8_BAR; PG8_MMA(0, 0, At, B0); PG8_MMA(0, 1, At, B1); PG8_BAR; PG8_SCHED;
            PG8_LDA(At, 1, 1); PG8_STAGE(PG8_SB(1, 0), b3, voffB); PG8_STAGE(PG8_SB(1, 1), b3 + hstep, voffB); PG8_STAGE(PG8_SA(1, 0), a3, voffA);
            PG8_WAIT_V(8); PG8_WAIT_L(0); PG8_BAR; PG8_MMA(1, 0, At, B0); PG8_MMA(1, 1, At, B1); PG8_BAR; PG8_SCHED;
            } else {
            PG8_LDB(B0, 0, 0); PG8_SCHED; PG8_LDA(At, 0, 0); PG8_STAGE(PG8_SA(1, 1), a1 + hstep, voffA);
            PG8_WAIT_L(8); PG8_BAR; PG8_WAIT_L(0); PG8_MMA(0, 0, At, B0); PG8_BAR; PG8_SCHED;
            PG8_LDB(B1, 0, 1); PG8_STAGE(PG8_SB(0, 0), b2, voffB);
            PG8_BAR; PG8_WAIT_L(0); PG8_MMA(0, 1, At, B1); PG8_BAR;
            PG8_LDA(At, 0, 1); PG8_STAGE(PG8_SA(0, 0), a2, voffA);
            PG8_BAR; PG8_WAIT_L(0); PG8_MMA(1, 0, At, B0); PG8_BAR; PG8_SCHED;
            PG8_STAGE(PG8_SB(0, 1), b2 + hstep, voffB);
            PG8_WAIT_V(6); PG8_BAR; PG8_MMA(1, 1, At, B1); PG8_BAR;
            PG8_LDB(B0, 1, 0); PG8_SCHED; PG8_LDA(At, 1, 0); PG8_STAGE(PG8_SA(0, 1), a2 + hstep, voffA);
            PG8_WAIT_L(8); PG8_BAR; PG8_WAIT_L(0); PG8_MMA(0, 0, At, B0); PG8_BAR; PG8_SCHED;
            PG8_LDB(B1, 1, 1); PG8_STAGE(PG8_SB(1, 0), b3, voffB);
            PG8_BAR; PG8_WAIT_L(0); PG8_MMA(0, 1, At, B1); PG8_BAR;
            PG8_LDA(At, 1, 1); PG8_STAGE(PG8_SA(1, 0), a3, voffA);
            PG8_BAR; PG8_WAIT_L(0); PG8_MMA(1, 0, At, B0); PG8_BAR; PG8_SCHED;
            PG8_STAGE(PG8_SB(1, 1), b3 + hstep, voffB);
            PG8_WAIT_V(6); PG8_BAR; PG8_MMA(1, 1, At, B1); PG8_BAR;
            }
        }
        if constexpr (ALIGN_EPI) { if (wr == 0) PG8_BAR; }
        if constexpr (!Epi::AFTER_DRAIN) { E(acc, cur, wr, wc, fr, fq); S.done(cur); }
        if (!has_next) break;
#pragma unroll
        for (int a = 0; a < 2; ++a)
#pragma unroll
            for (int b = 0; b < 2; ++b)
#pragma unroll
                for (int m = 0; m < 4; ++m)
#pragma unroll
                    for (int n = 0; n < 2; ++n) acc[a][b][m][n] = AccT{};
        cur = nxt; cA = nA; cB = nB; ++ui;
        if constexpr (ALIGN_EPI) { if (wr == 1) PG8_BAR; }
    }
    PG8_WAIT_V(0);
    if constexpr (!ALIGN_EPI) { if (wr == 0) PG8_BAR; }
    PG8_BAR;
    if constexpr (Epi::AFTER_DRAIN) { E.fused(acc, cur, wr, wc, fr, fq, lds, wid, lane); S.done(cur); }
#undef PG8_SA
#undef PG8_SB
#undef PG8_STAGE
#undef PG8_LDA
#undef PG8_LDB
#undef PG8_MMA
#undef PG8_WAIT_V
#undef PG8_WAIT_L
#undef PG8_BAR
#undef PG8_SCHED
}
}

#define PG8_SP2 true
#define PG8_ALIGN true

#define XB_TMO      128
#define XB_XCNT(j)  (256  + 64 * (j))
#define XB_XSUB(j)  (1280 + 64 * (j))
#define XB_XGEN(j)  (2304 + 64 * (j))
#define XB_TOP      3328
#define XB_TOPGEN   3392
#define XCD_BAR_WORDS 3456
#define XB_SPIN_CAP (1u << 18)
#define LAS __attribute__((address_space(3)))

__device__ __forceinline__ unsigned xb_ld(unsigned* p)              { return __hip_atomic_load(p, __ATOMIC_RELAXED, __HIP_MEMORY_SCOPE_AGENT); }
__device__ __forceinline__ unsigned xb_add(unsigned* p, unsigned v) { return __hip_atomic_fetch_add(p, v, __ATOMIC_RELAXED, __HIP_MEMORY_SCOPE_AGENT); }
__device__ __forceinline__ unsigned xb_xcc_id() { return (unsigned)__builtin_amdgcn_s_getreg((3 << 11) | 20) & 0xFu; }
#define XB_SPIN(cond, bar) do { unsigned _sp = 0; while (cond) { __builtin_amdgcn_s_sleep(1); \
    if ((++_sp & 255u) == 0u) { if (xb_ld(&(bar)[XB_TMO])) break; if (_sp > XB_SPIN_CAP) { atomicAdd(&(bar)[XB_TMO], 1u); break; } } } } while (0)

struct XcdBarrier {
    unsigned* bar; unsigned x;
    volatile LAS unsigned* st;
};

__device__ __forceinline__ XcdBarrier xcd_barrier_post(unsigned* bar, volatile LAS unsigned* st) {
    XcdBarrier b; b.bar = bar; b.x = xb_xcc_id(); b.st = st;
    if (threadIdx.x == 0) (void)xb_add(&bar[XB_XCNT(b.x)], 1u);
    return b;
}
__device__ __forceinline__ void xcd_barrier_complete(unsigned* bar, unsigned x, unsigned& nloc, unsigned& nx) {
    const unsigned G = gridDim.x * gridDim.y * gridDim.z;
    unsigned sum, cnt, mine, sp = 0u;
    for (;;) {
        sum = 0u; cnt = 0u; mine = 0u;
#pragma unroll
        for (unsigned j = 0; j < 16; ++j) { const unsigned c = xb_ld(&bar[XB_XCNT(j)]); sum += c; cnt += (c > 0u) ? 1u : 0u; mine = (j == x) ? c : mine; }
        if (sum == G) break;
        __builtin_amdgcn_s_sleep(1);
        if ((++sp & 255u) == 0u) { if (xb_ld(&bar[XB_TMO])) break; if (sp > XB_SPIN_CAP) { atomicAdd(&bar[XB_TMO], 1u); break; } }
    }
    nloc = mine > 0u ? mine : 1u; nx = cnt > 0u ? cnt : 1u;
}

__device__ __forceinline__ void xcd_barrier(const XcdBarrier& b) {
    asm volatile("s_waitcnt vmcnt(0)" ::: "memory");
    __syncthreads();
    if (threadIdx.x == 0) {
        unsigned* bar = b.bar;
        __builtin_amdgcn_s_waitcnt(0);
        unsigned nloc = b.st[0], nx = b.st[1];
        if (nloc == 0u) { xcd_barrier_complete(bar, b.x, nloc, nx); b.st[0] = nloc; b.st[1] = nx; }
        const unsigned old = xb_add(&bar[XB_XSUB(b.x)], 1u);
        const unsigned gen = old / nloc;
        if (old + 1u == (gen + 1u) * nloc) {
            __builtin_amdgcn_fence(__ATOMIC_RELEASE, "agent");
            asm volatile("s_waitcnt vmcnt(0)" ::: "memory");
            const unsigned og = xb_add(&bar[XB_TOP], 1u);
            const unsigned tg = og / nx;
            if (og + 1u == (tg + 1u) * nx) xb_add(&bar[XB_TOPGEN], 1u);
            else XB_SPIN(xb_ld(&bar[XB_TOPGEN]) == tg, bar);
            __builtin_amdgcn_fence(__ATOMIC_ACQUIRE, "agent");
            xb_add(&bar[XB_XGEN(b.x)], 1u);
            asm volatile("s_waitcnt vmcnt(0)" ::: "memory");
        } else {
            XB_SPIN(xb_ld(&bar[XB_XGEN(b.x)]) == gen, bar);
            __builtin_amdgcn_fence(__ATOMIC_ACQUIRE, "agent");
            asm volatile("s_waitcnt vmcnt(0)" ::: "memory");
        }
    }
    __syncthreads();
}


constexpr int RING_OFF = 0, RING_BYTES = 131072, LDSCTL_OFF = 146432, MISC_OFF = LDSCTL_OFF + 320, LDS_BYTES = 147456;
constexpr int CW_BAR = 4096;
constexpr size_t CTL_CMAX = 65536;
constexpr size_t CTL_ZERO_BYTES = 1u << 20;
#define LDS_WAIT() asm volatile("s_waitcnt lgkmcnt(0)" ::: "memory")
typedef short bf16x8_t __attribute__((ext_vector_type(8)));
using pg8::cvt_pk_bf16;

__device__ __forceinline__ void tr_item(const float* colp, int ld, bf16_t* WT, int K, int k0, int n0, LAS float* scr, int lane, unsigned* cmaxp = nullptr) {
    float tv[32];
#pragma unroll
    for (int i = 0; i < 32; ++i) { const int kk = 2 * i + (lane >> 5); tv[i] = colp ? colp[(size_t)(k0 + kk) * ld] : 0.f; }
    if (cmaxp) { float mx = 0.f;
#pragma unroll
        for (int i = 0; i < 32; ++i) mx = fmaxf(mx, fabsf(tv[i]));
        mx = fmaxf(mx, __shfl_xor(mx, 32));
        if (lane < 32) atomicMax(cmaxp + n0 + lane, __float_as_uint(mx)); }
#pragma unroll
    for (int i = 0; i < 32; ++i) { const int kk = 2 * i + (lane >> 5); scr[kk * 33 + (lane & 31)] = tv[i]; }
    LDS_WAIT(); asm volatile("" ::: "memory");
    const int c = lane & 7;
#pragma unroll
    for (int j = 0; j < 4; ++j) { const int n = (lane >> 3) + 8 * j; const LAS float* s = scr + (8 * c) * 33 + n;
        u32x4 o; o.x = pk2(s[0 * 33], s[1 * 33]); o.y = pk2(s[2 * 33], s[3 * 33]); o.z = pk2(s[4 * 33], s[5 * 33]); o.w = pk2(s[6 * 33], s[7 * 33]);
        *(u32x4*)(WT + (size_t)(n0 + n) * K + k0 + 8 * c) = o; }
    LDS_WAIT(); asm volatile("" ::: "memory");
}
constexpr int IT_GU = 32 * 352, IT_D = 88 * 64, IT_IN = 32 * 200, IT_OUT = 32 * 64, IT_ALL = 2 * IT_GU + 2 * IT_D + IT_IN + IT_OUT;
__device__ __forceinline__ void convert_item(const Ptrs& p, int it, LAS float* scr, int lane) {
    int r = it; const int ln = lane & 31;
#pragma unroll
    for (int which = 0; which < 2; ++which) {
        if (r < IT_GU) { const int kb = r / 352, q32 = r % 352, n = 32 * q32 + ln, pn = n >> 8, rr = n & 255;
            const float* src = rr < 128 ? (which ? p.f2_wg : p.f1_wg) : (which ? p.f2_wu : p.f1_wu);
            tr_item(src + 128 * pn + (rr & 127), FF, (bf16_t*)(p.WS() + (which ? WS_W2GU : WS_W1GU)), D, 64 * kb, 32 * q32, scr, lane, (unsigned*)(p.WS() + WS_CTL + CTL_CMAX) + which * 2 * FF); return; }
        r -= IT_GU;
        if (r < IT_D) { const int kb = r / 64, q32 = r % 64;
            tr_item((which ? p.f2_wd : p.f1_wd) + 32 * q32 + ln, D, (bf16_t*)(p.WS() + (which ? WS_W2D : WS_W1D)), FF, 64 * kb, 32 * q32, scr, lane, (unsigned*)(p.WS() + WS_CTL + CTL_CMAX) + 4 * FF + which * D); return; }
        r -= IT_D;
    }
    if (r < IT_IN) { const int kb = r / 200, q32 = r % 200, n = 32 * q32 + ln; int col;
        if (n < 4096) col = n; else if (n < 6144) col = n + 8; else { const int j = n - 6144; col = j < 64 ? 6152 + j : j < 72 ? 4096 + (j - 64) : j < 80 ? 6216 + (j - 72) : -1; }
        tr_item(col >= 0 ? p.w_in + col : nullptr, PW, (bf16_t*)(p.WS() + WS_WIN), D, 64 * kb, 32 * q32, scr, lane); return; }
    r -= IT_IN;
    { const int kb = r / 64, q32 = r % 64; tr_item(p.w_out + 32 * q32 + ln, D, (bf16_t*)(p.WS() + WS_WOUT), D, 64 * kb, 32 * q32, scr, lane); }
}
constexpr int MW_PITCH = 528;
template <int MT0, int NMT> __device__ __forceinline__ void mods_wg_body(const Ptrs& p, LAS unsigned char* lds, const int slab, const int tid) {
    const int lane = tid & 63, r = lane & 15, q = lane >> 4, n0 = 32 * slab;
    f32x4 acc[NMT][2];
#pragma unroll
    for (int mt = 0; mt < NMT; ++mt) { acc[mt][0] = (f32x4){0.f, 0.f, 0.f, 0.f}; acc[mt][1] = (f32x4){0.f, 0.f, 0.f, 0.f}; }
    const float* wp = p.w_ada + n0 + r + (size_t)(8 * q) * NMOD;
    float ring[4][2][8];
#define MW_LOADW(slot_, g_) do { _Pragma("unroll") for (int nt = 0; nt < 2; ++nt) _Pragma("unroll") for (int j = 0; j < 8; ++j) ring[slot_][nt][j] = wp[(size_t)(32 * (g_) + j) * NMOD + 16 * nt]; } while (0)
    MW_LOADW(0, 0); MW_LOADW(1, 1); MW_LOADW(2, 2); MW_LOADW(3, 3);
    for (int c = 0; c < 8; ++c) {
        f32x4 cv[17];
#pragma unroll
        for (int i = 0; i < 17; ++i) { const int e = tid + 512 * i, row = e >> 6, c4 = e & 63;
            cv[i] = *(const f32x4*)((row < BP ? p.c_p + (size_t)row * D : p.c_s + (size_t)(row - BP) * D) + 256 * c + 4 * c4); }
        __syncthreads();
#pragma unroll
        for (int i = 0; i < 17; ++i) { const int e = tid + 512 * i, row = e >> 6, c4 = e & 63; u32x2 w; w.x = cvt_pk_bf16(cv[i][0], cv[i][1]); w.y = cvt_pk_bf16(cv[i][2], cv[i][3]);
            *(LAS u32x2*)(lds + row * MW_PITCH + c4 * 8) = w; }
        if (tid < 8 * 64) { const int row = 136 + (tid >> 6), c4 = tid & 63; u32x2 z; z.x = 0u; z.y = 0u; *(LAS u32x2*)(lds + row * MW_PITCH + c4 * 8) = z; }
        __syncthreads();
#pragma unroll
        for (int s = 0; s < 8; ++s) {
            bf16x8_t bfr[2];
#pragma unroll
            for (int nt = 0; nt < 2; ++nt) { const float* v = ring[s & 3][nt]; u32x4 w; w.x = cvt_pk_bf16(v[0], v[1]); w.y = cvt_pk_bf16(v[2], v[3]); w.z = cvt_pk_bf16(v[4], v[5]); w.w = cvt_pk_bf16(v[6], v[7]); bfr[nt] = __builtin_bit_cast(bf16x8_t, w); }
            if (8 * c + s + 4 < 64) MW_LOADW(s & 3, 8 * c + s + 4);
            bf16x8_t afr[NMT];
#pragma unroll
            for (int mt = 0; mt < NMT; ++mt) afr[mt] = *(LAS const bf16x8_t*)(lds + (16 * (MT0 + mt) + r) * MW_PITCH + (32 * s + 8 * q) * 2);
            LDS_WAIT();
#pragma unroll
            for (int mt = 0; mt < NMT; ++mt) { acc[mt][0] = __builtin_amdgcn_mfma_f32_16x16x32_bf16(afr[mt], bfr[0], acc[mt][0], 0, 0, 0); acc[mt][1] = __builtin_amdgcn_mfma_f32_16x16x32_bf16(afr[mt], bfr[1], acc[mt][1], 0, 0, 0); }
        }
    }
#undef MW_LOADW
    float* MODS = (float*)(p.WS() + WS_MODS);
#pragma unroll
    for (int nt = 0; nt < 2; ++nt) { const int n = n0 + 16 * nt + r; const float bb = p.b_ada[n];
#pragma unroll
        for (int mt = 0; mt < NMT; ++mt)
#pragma unroll
            for (int i = 0; i < 4; ++i) { const int row = 16 * (MT0 + mt) + 4 * q + i; if (row < NB) MODS[(size_t)row * NMOD + n] = acc[mt][nt][i] + bb; } }
    __syncthreads();
}
template <int MT0, int NMT> __device__ __forceinline__ void mods_item_t(const Ptrs& p, const int slab, const int lane) {
    const int r = lane & 15, q = lane >> 4, n0 = 32 * slab;
    f32x4 acc[NMT][2];
#pragma unroll
    for (int mt = 0; mt < NMT; ++mt) { acc[mt][0] = (f32x4){0.f, 0.f, 0.f, 0.f}; acc[mt][1] = (f32x4){0.f, 0.f, 0.f, 0.f}; }
    const float* wp = p.w_ada + n0 + r + (size_t)(8 * q) * NMOD;
    const float* cp[NMT];
#pragma unroll
    for (int mt = 0; mt < NMT; ++mt) { int row = 16 * (MT0 + mt) + r; if (row > NB - 1) row = NB - 1; cp[mt] = (row < BP ? p.c_p + (size_t)row * D : p.c_s + (size_t)(row - BP) * D) + 8 * q; }
    const bool vlast = (16 * (MT0 + NMT - 1) + r) < NB;
    float bv[2][8]; f32x4 av[NMT][2];
#define MODS_LOAD(k0_) do { _Pragma("unroll") for (int nt = 0; nt < 2; ++nt) _Pragma("unroll") for (int j = 0; j < 8; ++j) bv[nt][j] = wp[(size_t)((k0_) + j) * NMOD + 16 * nt]; \
        _Pragma("unroll") for (int mt = 0; mt < NMT; ++mt) { av[mt][0] = *(const f32x4*)(cp[mt] + (k0_)); av[mt][1] = *(const f32x4*)(cp[mt] + (k0_) + 4); } } while (0)
    MODS_LOAD(0);
    for (int k0 = 0; k0 < D; k0 += 32) {
        bf16x8_t bfr[2], afr[NMT];
#pragma unroll
        for (int nt = 0; nt < 2; ++nt) { u32x4 w; w.x = cvt_pk_bf16(bv[nt][0], bv[nt][1]); w.y = cvt_pk_bf16(bv[nt][2], bv[nt][3]); w.z = cvt_pk_bf16(bv[nt][4], bv[nt][5]); w.w = cvt_pk_bf16(bv[nt][6], bv[nt][7]); bfr[nt] = __builtin_bit_cast(bf16x8_t, w); }
#pragma unroll
        for (int mt = 0; mt < NMT; ++mt) { f32x4 a0 = av[mt][0], a1 = av[mt][1]; if (mt == NMT - 1 && !vlast) { a0 = (f32x4){0.f, 0.f, 0.f, 0.f}; a1 = a0; }
            u32x4 w; w.x = cvt_pk_bf16(a0[0], a0[1]); w.y = cvt_pk_bf16(a0[2], a0[3]); w.z = cvt_pk_bf16(a1[0], a1[1]); w.w = cvt_pk_bf16(a1[2], a1[3]); afr[mt] = __builtin_bit_cast(bf16x8_t, w); }
        if (k0 + 32 < D) MODS_LOAD(k0 + 32);
#pragma unroll
        for (int mt = 0; mt < NMT; ++mt) { acc[mt][0] = __builtin_amdgcn_mfma_f32_16x16x32_bf16(afr[mt], bfr[0], acc[mt][0], 0, 0, 0); acc[mt][1] = __builtin_amdgcn_mfma_f32_16x16x32_bf16(afr[mt], bfr[1], acc[mt][1], 0, 0, 0); }
    }
#undef MODS_LOAD
    float* MODS = (float*)(p.WS() + WS_MODS);
#pragma unroll
    for (int nt = 0; nt < 2; ++nt) { const int n = n0 + 16 * nt + r; const float bb = p.b_ada[n];
#pragma unroll
        for (int mt = 0; mt < NMT; ++mt)
#pragma unroll
            for (int i = 0; i < 4; ++i) { const int row = 16 * (MT0 + mt) + 4 * q + i; if (row < NB) MODS[(size_t)row * NMOD + n] = acc[mt][nt][i] + bb; } }
}

template <int O0, int O1, int O2, int O3, int O4, int O5, int O6, int O7> __device__ __forceinline__ void tr_read8(u32x2 (&o)[8], const unsigned addr) {
    asm volatile("ds_read_b64_tr_b16 %0, %8 offset:%9\n\tds_read_b64_tr_b16 %1, %8 offset:%10\n\tds_read_b64_tr_b16 %2, %8 offset:%11\n\tds_read_b64_tr_b16 %3, %8 offset:%12\n\t"
                 "ds_read_b64_tr_b16 %4, %8 offset:%13\n\tds_read_b64_tr_b16 %5, %8 offset:%14\n\tds_read_b64_tr_b16 %6, %8 offset:%15\n\tds_read_b64_tr_b16 %7, %8 offset:%16\n\ts_waitcnt lgkmcnt(0)"
                 : "=&v"(o[0]), "=&v"(o[1]), "=&v"(o[2]), "=&v"(o[3]), "=&v"(o[4]), "=&v"(o[5]), "=&v"(o[6]), "=&v"(o[7])
                 : "v"(addr), "n"(O0), "n"(O1), "n"(O2), "n"(O3), "n"(O4), "n"(O5), "n"(O6), "n"(O7) : "memory");
}
__device__ __forceinline__ bf16x8_t frag2(const u32x2 a, const u32x2 b) { u32x4 v; v.x = a.x; v.y = a.y; v.z = b.x; v.w = b.y; return __builtin_bit_cast(bf16x8_t, v); }
constexpr int ML_QC = 0, ML_KC = 33792, ML_KW = 67584, ML_VR = 101376, ML_CB = 109056, ML_N = 142848, ML_SC = 144896, ML_END = 145920; __device__ __forceinline__ void mlstm_mfma_unit(const Ptrs& p, LAS unsigned char* lds, const int unit, const int tid) {
    const int lane = tid & 63, wv = __builtin_amdgcn_readfirstlane(tid >> 6), r = lane & 15, q = lane >> 4;
    const int bh = unit >> 3, sl = unit & 7, b = bh >> 2, h = bh & 3, e0 = 32 * sl;
    const bf16_t* QM = (const bf16_t*)(p.WS() + WS_QM); const bf16_t* KM = (const bf16_t*)(p.WS() + WS_KM); const bf16_t* PROJ = (const bf16_t*)(p.WS() + WS_PROJ);
    const float* BC = (const float*)(p.WS() + WS_BC) + (size_t)bh * 2048; const float* IG = (const float*)(p.WS() + WS_IG) + (size_t)bh * 2048; const float* MMa = (const float*)(p.WS() + WS_MM) + (size_t)bh * 2048;
    float* HM = (float*)(p.WS() + WS_HM);
    const int srow = tid >> 3, sd = (tid & 7) * 32, se = (tid & 7) * 4;
    LAS float* su = (LAS float*)(lds + ML_SC); LAS float* sv = su + 64; LAS float* ssw = su + 128; LAS float* smm = su + 192;
    for (int i = tid; i < 16896 / 4; i += 512) ((LAS unsigned*)(lds + ML_CB))[i] = 0u;
    if (tid < 256) ((LAS float*)(lds + ML_N))[tid] = 0.f;
    f32x4 accC[4][2];
#pragma unroll
    for (int k = 0; k < 4; ++k) { accC[k][0] = (f32x4){0.f, 0.f, 0.f, 0.f}; accC[k][1] = (f32x4){0.f, 0.f, 0.f, 0.f}; }
    u32x4 pq[4], pk[4]; u32x2 pv; float pbc, pig, pmm, pbL, pmL, pm0;
#define ML_PREFETCH(cc) do { const size_t rr_ = (size_t)b * 2048 + 64 * (cc) + srow; const bf16_t* qp_ = QM + rr_ * 1024 + h * 256 + sd; const bf16_t* kp_ = KM + rr_ * 1024 + h * 256 + sd; \
        _Pragma("unroll") for (int j_ = 0; j_ < 4; ++j_) { pq[j_] = *(const u32x4*)(qp_ + 8 * j_); pk[j_] = *(const u32x4*)(kp_ + 8 * j_); } \
        pv = *(const u32x2*)(PROJ + rr_ * PROJ_LD + PC_VM + h * 256 + e0 + se); pbc = BC[64 * (cc) + srow]; pig = IG[64 * (cc) + srow]; pmm = MMa[64 * (cc) + srow]; \
        pbL = BC[64 * (cc) + 63]; pmL = MMa[64 * (cc) + 63]; pm0 = (cc) ? MMa[64 * (cc) - 1] : 0.f; } while (0)
    ML_PREFETCH(0);
    for (int c = 0; c < 32; ++c) {
        const int cur = c & 1, nxt = cur ^ 1;
        const float bL = pbL, mL = pmL, m0 = pm0;
        {
            const float wl = __expf(bL - pbc + pig - mL);
#pragma unroll
            for (int j = 0; j < 4; ++j) { *(LAS u32x4*)(lds + ML_QC + srow * 528 + (sd + 8 * j) * 2) = pq[j]; *(LAS u32x4*)(lds + ML_KC + srow * 528 + (sd + 8 * j) * 2) = pk[j]; }
#pragma unroll
            for (int j = 0; j < 4; ++j) { u32x4 ws_;
#pragma unroll
                for (int e2 = 0; e2 < 4; ++e2) { const unsigned w = pk[j][e2]; ws_[e2] = cvt_pk_bf16(bflo(w) * wl, bfhi(w) * wl); }
                *(LAS u32x4*)(lds + ML_KW + srow * 528 + (sd + 8 * j) * 2) = ws_; }
            *(LAS u32x2*)(lds + ML_VR + srow * 96 + se * 2) = pv;
            if ((tid & 7) == 0) { su[srow] = pbc - pmm; sv[srow] = pig - pbc; ssw[srow] = __expf(pbc + m0 - pmm); smm[srow] = pmm; }
        }
        __syncthreads();
        if (c < 31) ML_PREFETCH(c + 1);
        if (wv < 4) {
            const int tt = wv; const size_t r0 = (size_t)b * 2048 + 64 * c;
            bf16x8_t qf[8];
            { LAS const unsigned char* qrow = lds + ML_QC + (16 * tt + r) * 528 + q * 16;
#pragma unroll
              for (int kk = 0; kk < 8; ++kk) qf[kk] = *(LAS const bf16x8_t*)(qrow + kk * 64); }
            const float ut = su[16 * tt + r]; float rs = 0.f; unsigned pw[4][2];
#pragma unroll
            for (int a = 0; a < 4; ++a) {
                if (a <= tt) {
                    LAS const unsigned char* krow = lds + ML_KC + (16 * a + r) * 528 + q * 16;
                    const f32x4 vs4 = *(LAS const f32x4*)(sv + 16 * a + 4 * q);
                    f32x4 S0 = (f32x4){0.f, 0.f, 0.f, 0.f}, S1 = S0;
#pragma unroll
                    for (int hf = 0; hf < 2; ++hf) { bf16x8_t kf[4];
#pragma unroll
                        for (int k4 = 0; k4 < 4; ++k4) kf[k4] = *(LAS const bf16x8_t*)(krow + (4 * hf + k4) * 64);
                        LDS_WAIT();
#pragma unroll
                        for (int k4 = 0; k4 < 4; k4 += 2) { S0 = __builtin_amdgcn_mfma_f32_16x16x32_bf16(kf[k4], qf[4 * hf + k4], S0, 0, 0, 0); S1 = __builtin_amdgcn_mfma_f32_16x16x32_bf16(kf[k4 + 1], qf[4 * hf + k4 + 1], S1, 0, 0, 0); } }
                    const f32x4 S = S0 + S1; float pe[4];
#pragma unroll
                    for (int i = 0; i < 4; ++i) { float x = S[i] * __expf(ut + vs4[i]); if (a == tt && (4 * q + i) > r) x = 0.f; pe[i] = x; rs += x; }
                    pw[a][0] = cvt_pk_bf16(pe[0], pe[1]); pw[a][1] = cvt_pk_bf16(pe[2], pe[3]);
                } else { pw[a][0] = 0u; pw[a][1] = 0u; }
            }
            rs = x32_sum(x16_sum(rs));
            u32x4 pf0, pf1; pf0.x = pw[0][0]; pf0.y = pw[0][1]; pf0.z = pw[1][0]; pf0.w = pw[1][1]; pf1.x = pw[2][0]; pf1.y = pw[2][1]; pf1.z = pw[3][0]; pf1.w = pw[3][1];
            f32x4 accn[2], accq[2];
            u32x2 vtr[8];
            tr_read8<0, 16 * 96, 32 * 96, 48 * 96, 32, 32 + 16 * 96, 32 + 32 * 96, 32 + 48 * 96>(vtr, (unsigned)(size_t)(lds + ML_VR) + (unsigned)((4 * q + (r >> 2)) * 96 + 8 * (r & 3)));
#pragma unroll
            for (int et = 0; et < 2; ++et) {
                LAS const unsigned char* crow = lds + ML_CB + cur * 16896 + (16 * et + r) * 528 + q * 16;
                bf16x8_t cf[4];
#pragma unroll
                for (int kk = 0; kk < 4; ++kk) cf[kk] = *(LAS const bf16x8_t*)(crow + kk * 64);
                LDS_WAIT();
                accn[et] = __builtin_amdgcn_mfma_f32_16x16x32_bf16(__builtin_bit_cast(bf16x8_t, pf0), frag2(vtr[4 * et + 0], vtr[4 * et + 1]), (f32x4){0.f, 0.f, 0.f, 0.f}, 0, 0, 0);
                if (tt >= 2) accn[et] = __builtin_amdgcn_mfma_f32_16x16x32_bf16(__builtin_bit_cast(bf16x8_t, pf1), frag2(vtr[4 * et + 2], vtr[4 * et + 3]), accn[et], 0, 0, 0);
                f32x4 q0 = (f32x4){0.f, 0.f, 0.f, 0.f}, q1 = q0;
#pragma unroll
                for (int kk = 0; kk < 4; kk += 2) { q0 = __builtin_amdgcn_mfma_f32_16x16x32_bf16(qf[kk], cf[kk], q0, 0, 0, 0); q1 = __builtin_amdgcn_mfma_f32_16x16x32_bf16(qf[kk + 1], cf[kk + 1], q1, 0, 0, 0); }
#pragma unroll
                for (int kk = 0; kk < 4; ++kk) cf[kk] = *(LAS const bf16x8_t*)(crow + (4 + kk) * 64);
                LDS_WAIT();
#pragma unroll
                for (int kk = 0; kk < 4; kk += 2) { q0 = __builtin_amdgcn_mfma_f32_16x16x32_bf16(qf[4 + kk], cf[kk], q0, 0, 0, 0); q1 = __builtin_amdgcn_mfma_f32_16x16x32_bf16(qf[4 + kk + 1], cf[kk + 1], q1, 0, 0, 0); }
                accq[et] = q0 + q1;
            }
            float qn = 0.f;
            { LAS const float* nrow = (LAS const float*)(lds + ML_N + cur * 1024) + 64 * q; LAS const unsigned char* qrow2 = lds + ML_QC + (16 * tt + r) * 528 + 128 * q;
#pragma unroll
              for (int hf = 0; hf < 2; ++hf) { u32x4 wq[4]; f32x4 n0[4], n1[4];
#pragma unroll
                  for (int c4 = 0; c4 < 4; ++c4) { const int c8 = 4 * hf + c4; wq[c4] = *(LAS const u32x4*)(qrow2 + c8 * 16); n0[c4] = *(LAS const f32x4*)(nrow + 8 * c8); n1[c4] = *(LAS const f32x4*)(nrow + 8 * c8 + 4); }
                  LDS_WAIT();
#pragma unroll
                  for (int c4 = 0; c4 < 4; ++c4) { const u32x4 w = wq[c4];
                      qn += (bflo(w.x) * n0[c4][0] + bfhi(w.x) * n0[c4][1]) + (bflo(w.y) * n0[c4][2] + bfhi(w.y) * n0[c4][3]) + (bflo(w.z) * n1[c4][0] + bfhi(w.z) * n1[c4][1]) + (bflo(w.w) * n1[c4][2] + bfhi(w.w) * n1[c4][3]); } } }
            qn = x32_sum(x16_sum(qn));
            const float swt = ssw[16 * tt + r], mmt = smm[16 * tt + r];
            const float inv = 1.0f / fmaxf(fabsf(rs + swt * qn), __expf(-mmt));
#pragma unroll
            for (int i = 0; i < 4; ++i) { const float invv = __shfl(inv, 4 * q + i), swv = __shfl(swt, 4 * q + i);
                float* hp = HM + (r0 + 16 * tt + 4 * q + i) * 1024 + h * 256 + e0 + r;
                hp[0] = (accn[0][i] + swv * accq[0][i]) * invv; hp[16] = (accn[1][i] + swv * accq[1][i]) * invv; }
        } else {
            const int sw4 = wv - 4; const float decay = __expf(bL + m0 - mL);
#pragma unroll
            for (int k = 0; k < 4; ++k) { accC[k][0] = accC[k][0] * decay; accC[k][1] = accC[k][1] * decay; }
            u32x2 vt2[8], ka[8], kb[8];
            tr_read8<0, 4 * 96, 32 * 96, 36 * 96, 32, 32 + 4 * 96, 32 + 32 * 96, 32 + 36 * 96>(vt2, (unsigned)(size_t)(lds + ML_VR) + (unsigned)((8 * q + (r >> 2)) * 96 + 8 * (r & 3)));
            const unsigned kaddr = (unsigned)(size_t)(lds + ML_KW) + (unsigned)((8 * q + (r >> 2)) * 528 + 8 * (r & 3) + sw4 * 128);
            tr_read8<0, 4 * 528, 32 * 528, 36 * 528, 32, 32 + 4 * 528, 32 + 32 * 528, 32 + 36 * 528>(ka, kaddr);
            tr_read8<64, 64 + 4 * 528, 64 + 32 * 528, 64 + 36 * 528, 96, 96 + 4 * 528, 96 + 32 * 528, 96 + 36 * 528>(kb, kaddr);
            float nsum[4];
#pragma unroll
            for (int k = 0; k < 4; ++k) { const int dt = 4 * sw4 + k; float ns_ = 0.f;
#pragma unroll
                for (int kk2 = 0; kk2 < 2; ++kk2) { const u32x2 a0 = (k < 2 ? ka : kb)[4 * (k & 1) + 2 * kk2], a1 = (k < 2 ? ka : kb)[4 * (k & 1) + 2 * kk2 + 1]; const bf16x8_t af = frag2(a0, a1);
                    ns_ += (bflo(a0.x) + bfhi(a0.x)) + (bflo(a0.y) + bfhi(a0.y)) + (bflo(a1.x) + bfhi(a1.x)) + (bflo(a1.y) + bfhi(a1.y));
#pragma unroll
                    for (int et = 0; et < 2; ++et) accC[k][et] = __builtin_amdgcn_mfma_f32_16x16x32_bf16(af, frag2(vt2[4 * et + 2 * kk2], vt2[4 * et + 2 * kk2 + 1]), accC[k][et], 0, 0, 0); }
                nsum[k] = x32_sum(x16_sum(ns_));
#pragma unroll
                for (int et = 0; et < 2; ++et) { u32x2 o; o.x = cvt_pk_bf16(accC[k][et][0], accC[k][et][1]); o.y = cvt_pk_bf16(accC[k][et][2], accC[k][et][3]);
                    *(LAS u32x2*)(lds + ML_CB + nxt * 16896 + (16 * et + r) * 528 + (16 * dt + 4 * q) * 2) = o; } }
            if (q == 0) { LAS float* nb = (LAS float*)(lds + ML_N);
#pragma unroll
                for (int k = 0; k < 4; ++k) { const int d = 16 * (4 * sw4 + k) + r; nb[nxt * 256 + d] = decay * nb[cur * 256 + d] + nsum[k]; } }
        }
        __syncthreads();
    }
#undef ML_PREFETCH
    if (wv >= 4) { const int sw4 = wv - 4;
#pragma unroll
        for (int k = 0; k < 4; ++k)
#pragma unroll
            for (int et = 0; et < 2; ++et)
#pragma unroll
                for (int i = 0; i < 4; ++i) p.out[O_CP + ((size_t)bh * 256 + 16 * (4 * sw4 + k) + 4 * q + i) * 256 + e0 + 16 * et + r] = accC[k][et][i]; }
    if (sl == 0 && tid < 256) { p.out[O_NP + (size_t)bh * 256 + tid] = ((LAS const float*)(lds + ML_N))[tid]; if (tid == 0) p.out[O_MP + bh] = MMa[2047]; }
    __syncthreads();
}

__device__ __forceinline__ void scores_seg(const Ptrs& p, const int b, const int qt, const int klo, const int khi, const int lane) {
    const int r = lane & 15, q = lane >> 4;
    const bf16_t* PROJ = (const bf16_t*)(p.WS() + WS_PROJ); const float* SMALL = (const float*)(p.WS() + WS_SMALL); const bf16_t* KI = (const bf16_t*)(p.WS() + WS_KI) + (size_t)b * 2048 * 64; float* SC = (float*)(p.WS() + WS_SC);
    const size_t row = (size_t)b * 2048 + 16 * qt + r;
    bf16x8_t qa[8][2]; float w8[8];
#pragma unroll
    for (int j = 0; j < 8; ++j) { qa[j][0] = *(const bf16x8_t*)(PROJ + row * PROJ_LD + PC_QI + 64 * j + 8 * q); qa[j][1] = *(const bf16x8_t*)(PROJ + row * PROJ_LD + PC_QI + 64 * j + 32 + 8 * q); w8[j] = SMALL[row * SMALL_LD + 72 + j] * (0.35355339059327373f * 0.125f); }
    float* scrow = SC + row * 2048 + 4 * q;
#pragma unroll 2
    for (int kt = klo; kt < khi; ++kt) {
        const bf16_t* kp = KI + (size_t)(16 * kt + r) * 64 + 8 * q;
        const bf16x8_t k0 = *(const bf16x8_t*)kp, k1 = *(const bf16x8_t*)(kp + 32);
        f32x4 sc = (f32x4){0.f, 0.f, 0.f, 0.f};
#pragma unroll
        for (int j = 0; j < 8; ++j) { f32x4 S = __builtin_amdgcn_mfma_f32_16x16x32_bf16(k0, qa[j][0], (f32x4){0.f, 0.f, 0.f, 0.f}, 0, 0, 0); S = __builtin_amdgcn_mfma_f32_16x16x32_bf16(k1, qa[j][1], S, 0, 0, 0);
#pragma unroll
            for (int i = 0; i < 4; ++i) sc[i] += w8[j] * fmaxf(S[i], 0.f); }
        *(f32x4*)(scrow + 16 * kt) = sc;
    }
}
__device__ __forceinline__ void scores_mfma_prompt(const Ptrs& p, const int u, const int lane) {
    const int b = u >> 8, rem = u & 255, pair = rem >> 2, part = rem & 3;
    const int qtA = pair, qtB = 127 - pair, nA = qtA + 1, ntot = 129;
    const int j0 = part * 33, j1 = (j0 + 33 < ntot) ? j0 + 33 : ntot;
    if (j0 < nA) scores_seg(p, b, qtA, j0, j1 < nA ? j1 : nA, lane);
    if (j1 > nA) scores_seg(p, b, qtB, (j0 > nA ? j0 : nA) - nA, j1 - nA, lane);
}

constexpr int SS_PITCH = 8208;
__device__ __forceinline__ void scores_select_unit(const Ptrs& p, LAS unsigned char* lds, const int b, const int qt, const int tid) {
    const int lane = tid & 63, wv = __builtin_amdgcn_readfirstlane(tid >> 6), r = lane & 15, q = lane >> 4;
    const bf16_t* PROJ = (const bf16_t*)(p.WS() + WS_PROJ); const float* SMALL = (const float*)(p.WS() + WS_SMALL); const bf16_t* KI = (const bf16_t*)(p.WS() + WS_KI) + (size_t)b * 2048 * 64;
    const size_t row = (size_t)b * 2048 + 16 * qt + r;
    bf16x8_t qa[8][2]; float w8[8];
#pragma unroll
    for (int j = 0; j < 8; ++j) { qa[j][0] = *(const bf16x8_t*)(PROJ + row * PROJ_LD + PC_QI + 64 * j + 8 * q); qa[j][1] = *(const bf16x8_t*)(PROJ + row * PROJ_LD + PC_QI + 64 * j + 32 + 8 * q); w8[j] = SMALL[row * SMALL_LD + 72 + j] * (0.35355339059327373f * 0.125f); }
    __syncthreads();
#pragma unroll 2
    for (int kt = wv; kt <= qt; kt += 8) {
        const bf16_t* kp = KI + (size_t)(16 * kt + r) * 64 + 8 * q;
        const bf16x8_t k0 = *(const bf16x8_t*)kp, k1 = *(const bf16x8_t*)(kp + 32);
        f32x4 sc = (f32x4){0.f, 0.f, 0.f, 0.f};
#pragma unroll
        for (int j = 0; j < 8; ++j) { f32x4 S = __builtin_amdgcn_mfma_f32_16x16x32_bf16(k0, qa[j][0], (f32x4){0.f, 0.f, 0.f, 0.f}, 0, 0, 0); S = __builtin_amdgcn_mfma_f32_16x16x32_bf16(k1, qa[j][1], S, 0, 0, 0);
#pragma unroll
            for (int i = 0; i < 4; ++i) sc[i] += w8[j] * fmaxf(S[i], 0.f); }
        *(LAS f32x4*)(lds + r * SS_PITCH + (16 * kt + 4 * q) * 4) = sc;
    }
    __syncthreads();
#pragma unroll
    for (int rr = 0; rr < 2; ++rr) { const int tl = 2 * wv + rr, nvalid = 16 * qt + tl + 1; float raw[32];
#pragma unroll
        for (int i = 0; i < 32; ++i) raw[i] = *(LAS const float*)(lds + tl * SS_PITCH + (64 * i + lane) * 4);
        select_compute<32>(raw, nvalid, (u64*)(p.WS() + WS_MASK) + ((size_t)b * 2048 + 16 * qt + tl) * 32, lane); }
}

template <int DT0> __device__ __forceinline__ void v_tr_read8(u32x2 (&o)[2][2][2]  , const unsigned addr) {
    asm volatile("ds_read_b64_tr_b16 %0, %8 offset:%9\n\tds_read_b64_tr_b16 %1, %8 offset:%10\n\tds_read_b64_tr_b16 %2, %8 offset:%11\n\tds_read_b64_tr_b16 %3, %8 offset:%12\n\t"
                 "ds_read_b64_tr_b16 %4, %8 offset:%13\n\tds_read_b64_tr_b16 %5, %8 offset:%14\n\tds_read_b64_tr_b16 %6, %8 offset:%15\n\tds_read_b64_tr_b16 %7, %8 offset:%16\n\ts_waitcnt lgkmcnt(0)"
                 : "=&v"(o[0][0][0]), "=&v"(o[0][0][1]), "=&v"(o[0][1][0]), "=&v"(o[0][1][1]), "=&v"(o[1][0][0]), "=&v"(o[1][0][1]), "=&v"(o[1][1][0]), "=&v"(o[1][1][1])
                 : "v"(addr), "n"(DT0 * 32), "n"(DT0 * 32 + 16 * 288), "n"(DT0 * 32 + 32 * 288), "n"(DT0 * 32 + 48 * 288),
                   "n"(DT0 * 32 + 32), "n"(DT0 * 32 + 32 + 16 * 288), "n"(DT0 * 32 + 32 + 32 * 288), "n"(DT0 * 32 + 32 + 48 * 288) : "memory");
}
constexpr int AT_BUF = 35840, AT_KC = 0, AT_VT = 17408, AT_MASK = 71680, AT_BIAS = 88064, AT_END = 96256;
__device__ __forceinline__ void attn_mfma_block(const Ptrs& p, LAS unsigned char* lds, const int b, const int qb, const int g, const int tid) {
    const int lane = tid & 63, wv = __builtin_amdgcn_readfirstlane(tid >> 6), r = lane & 15, q = lane >> 4, hh = 4 * g + (wv & 3), mh = wv >> 2;
    const int t0 = 64 * qb, ntile = qb + 1; const size_t row0 = (size_t)b * 2048 + t0;
    const bf16_t* QA = (const bf16_t*)(p.WS() + WS_QA); const bf16_t* KA = (const bf16_t*)(p.WS() + WS_KA); const bf16_t* PROJ = (const bf16_t*)(p.WS() + WS_PROJ); const u64* MASK = (const u64*)(p.WS() + WS_MASK);
    LAS u64* maskL = (LAS u64*)(lds + AT_MASK); LAS const float* biasn = (LAS const float*)(lds + AT_BIAS);
    __syncthreads();
    for (int i = tid; i < 2048; i += 512) maskL[i] = MASK[(row0 + (i >> 5)) * 32 + (i & 31)];
    bf16x8_t qf[2][4];
#pragma unroll
    for (int m2 = 0; m2 < 2; ++m2)
#pragma unroll
        for (int kk = 0; kk < 4; ++kk) qf[m2][kk] = *(const bf16x8_t*)(QA + (row0 + 16 * (2 * mh + m2) + r) * 1024 + hh * 128 + 32 * kk + 8 * q);
    f32x4 O[2][8]; float mrun[2], lrun[2];
#pragma unroll
    for (int m2 = 0; m2 < 2; ++m2) { mrun[m2] = -INFINITY; lrun[m2] = 0.f;
#pragma unroll
        for (int dt = 0; dt < 8; ++dt) O[m2][dt] = (f32x4){0.f, 0.f, 0.f, 0.f}; }
    const float bfar = p.t5[31 * 8 + hh];
    const int srow = tid >> 3, sp = tid & 7;
    u32x4 pk[2], pv[2];
#define AT_PREFETCH(kt_) do { const size_t kr_ = (size_t)b * 2048 + 64 * (kt_) + srow; const bf16_t* kp_ = KA + kr_ * 256 + g * 128 + sp * 16; const bf16_t* vp_ = PROJ + kr_ * PROJ_LD + PC_VA + g * 128 + sp * 16; \
        pk[0] = *(const u32x4*)kp_; pk[1] = *(const u32x4*)(kp_ + 8); pv[0] = *(const u32x4*)vp_; pv[1] = *(const u32x4*)(vp_ + 8); } while (0)
#define AT_STAGE(buf_) do { LAS unsigned char* bb_ = lds + (buf_) * AT_BUF; \
        *(LAS u32x4*)(bb_ + AT_KC + srow * 272 + sp * 32) = pk[0]; *(LAS u32x4*)(bb_ + AT_KC + srow * 272 + sp * 32 + 16) = pk[1]; \
        *(LAS u32x4*)(bb_ + AT_VT + srow * 288 + sp * 32) = pv[0]; *(LAS u32x4*)(bb_ + AT_VT + srow * 288 + sp * 32 + 16) = pv[1]; } while (0)
    AT_PREFETCH(0); AT_STAGE(0); if (ntile > 1) AT_PREFETCH(1);
    __syncthreads();
    for (int kt = 0; kt < ntile; ++kt) {
        const int buf = kt & 1; LAS const unsigned char* bb = lds + buf * AT_BUF;
        f32x4 S[2][4];
#pragma unroll
        for (int a = 0; a < 4; ++a) { bf16x8_t kf[4];
#pragma unroll
            for (int kk = 0; kk < 4; ++kk) kf[kk] = *(LAS const bf16x8_t*)(bb + AT_KC + (16 * a + r) * 272 + kk * 64 + q * 16);
            LDS_WAIT();
            S[0][a] = (f32x4){0.f, 0.f, 0.f, 0.f}; S[1][a] = (f32x4){0.f, 0.f, 0.f, 0.f};
#pragma unroll
            for (int kk = 0; kk < 4; ++kk) { S[0][a] = __builtin_amdgcn_mfma_f32_16x16x32_bf16(kf[kk], qf[0][kk], S[0][a], 0, 0, 0); S[1][a] = __builtin_amdgcn_mfma_f32_16x16x32_bf16(kf[kk], qf[1][kk], S[1][a], 0, 0, 0); } }
        u32x4 pf[2][2];
#pragma unroll
        for (int m2 = 0; m2 < 2; ++m2) {
            const int mt = 2 * mh + m2, t = t0 + 16 * mt + r; const u64 mwq = maskL[(16 * mt + r) * 32 + kt] >> (4 * q);
            const unsigned mlo = (unsigned)mwq, mhi = (unsigned)(mwq >> 32);
            const bool far = (t0 + 16 * mt - 64 * kt - 63) >= 128;
            float bia[4][4];
            if (far) {
#pragma unroll
                for (int a = 0; a < 4; ++a)
#pragma unroll
                    for (int i = 0; i < 4; ++i) bia[a][i] = bfar;
            } else {
                const int dbase = t - 64 * kt - 4 * q;
#pragma unroll
                for (int a = 0; a < 4; ++a)
#pragma unroll
                    for (int i = 0; i < 4; ++i) { int dist = dbase - (16 * a + i); dist = dist < 0 ? 0 : (dist > 255 ? 255 : dist); bia[a][i] = biasn[dist * 8 + hh]; }
                LDS_WAIT();
            }
            float mx = -INFINITY;
#pragma unroll
            for (int a = 0; a < 4; ++a)
#pragma unroll
                for (int i = 0; i < 4; ++i) { const bool on = (((a < 2) ? mlo : mhi) >> (16 * (a & 1) + i)) & 1u; const float lg = on ? S[m2][a][i] + bia[a][i] : -INFINITY; S[m2][a][i] = lg; mx = fmaxf(mx, lg); }
            mx = x32_max(x16_max(mx));
            const float mnew = fmaxf(mrun[m2], mx), muse = (mnew == -INFINITY) ? 0.f : mnew; const float alpha = __expf(mrun[m2] - muse); mrun[m2] = mnew;
            float psum = 0.f; unsigned pw[4][2];
#pragma unroll
            for (int a = 0; a < 4; ++a) { float pe[4];
#pragma unroll
                for (int i = 0; i < 4; ++i) { pe[i] = __expf(S[m2][a][i] - muse); psum += pe[i]; }
                pw[a][0] = cvt_pk_bf16(pe[0], pe[1]); pw[a][1] = cvt_pk_bf16(pe[2], pe[3]); }
            psum = x32_sum(x16_sum(psum));
            lrun[m2] = lrun[m2] * alpha + psum;
            pf[m2][0].x = pw[0][0]; pf[m2][0].y = pw[0][1]; pf[m2][0].z = pw[1][0]; pf[m2][0].w = pw[1][1]; pf[m2][1].x = pw[2][0]; pf[m2][1].y = pw[2][1]; pf[m2][1].z = pw[3][0]; pf[m2][1].w = pw[3][1];
#pragma unroll
            for (int i = 0; i < 4; ++i) { const float al = __shfl(alpha, 4 * q + i);
#pragma unroll
                for (int dt = 0; dt < 8; ++dt) O[m2][dt][i] *= al; }
        }
        {
            const unsigned vaddr = (unsigned)(size_t)(bb + AT_VT) + (unsigned)((4 * q + (r >> 2)) * 288 + 8 * (r & 3));
#define AT_PV2(DT0_) do { u32x2 vt_[2][2][2]; v_tr_read8<DT0_>(vt_, vaddr); \
            _Pragma("unroll") for (int a2 = 0; a2 < 2; ++a2) _Pragma("unroll") for (int d2 = 0; d2 < 2; ++d2) { u32x4 vf; vf.x = vt_[d2][a2][0].x; vf.y = vt_[d2][a2][0].y; vf.z = vt_[d2][a2][1].x; vf.w = vt_[d2][a2][1].y; \
                O[0][(DT0_) + d2] = __builtin_amdgcn_mfma_f32_16x16x32_bf16(__builtin_bit_cast(bf16x8_t, pf[0][a2]), __builtin_bit_cast(bf16x8_t, vf), O[0][(DT0_) + d2], 0, 0, 0); \
                O[1][(DT0_) + d2] = __builtin_amdgcn_mfma_f32_16x16x32_bf16(__builtin_bit_cast(bf16x8_t, pf[1][a2]), __builtin_bit_cast(bf16x8_t, vf), O[1][(DT0_) + d2], 0, 0, 0); } } while (0)
            AT_PV2(0); AT_PV2(2); AT_PV2(4); AT_PV2(6);
#undef AT_PV2
        }
        if (kt + 1 < ntile) { AT_STAGE(buf ^ 1); if (kt + 2 < ntile) AT_PREFETCH(kt + 2); }
        __syncthreads();
    }
#undef AT_PREFETCH
#undef AT_STAGE
    bf16_t* CAT = (bf16_t*)(p.WS() + WS_CAT);
#pragma unroll
    for (int m2 = 0; m2 < 2; ++m2) { const float invl = 1.0f / lrun[m2];
#pragma unroll
        for (int i = 0; i < 4; ++i) { const float iv = __shfl(invl, 4 * q + i); bf16_t* cp = CAT + (row0 + 16 * (2 * mh + m2) + 4 * q + i) * D + 1024 + hh * 128 + r;
#pragma unroll
            for (int dt = 0; dt < 8; ++dt) cp[16 * dt] = f2bf(O[m2][dt][i] * iv); } }
}

__device__ __forceinline__ void scores_mfma_sample(const Ptrs& p, const int u, const int lane) {
    const int r = lane & 15, q = lane >> 4, b = u >> 4, part = u & 15;
    const bf16_t* PROJ = (const bf16_t*)(p.WS() + WS_PROJ); const float* SMALL = (const float*)(p.WS() + WS_SMALL); float* SCS = (float*)(p.WS() + WS_SCS);
    bf16x8_t qa[2][2]; float w4[2][4];
#pragma unroll
    for (int mtl = 0; mtl < 2; ++mtl) { const size_t row = (size_t)MP + 4 * b + 2 * mtl + (r >> 3);
        qa[mtl][0] = *(const bf16x8_t*)(PROJ + row * PROJ_LD + PC_QI + 64 * (r & 7) + 8 * q); qa[mtl][1] = *(const bf16x8_t*)(PROJ + row * PROJ_LD + PC_QI + 64 * (r & 7) + 32 + 8 * q);
        const size_t wrow = (size_t)MP + 4 * b + 2 * mtl + (q >> 1);
#pragma unroll
        for (int i = 0; i < 4; ++i) w4[mtl][i] = SMALL[wrow * SMALL_LD + 72 + 4 * (q & 1) + i] * (0.35355339059327373f * 0.125f); }
    const int tlo = 8 * part, thi = (part == 15) ? 129 : 8 * part + 8;
    for (int kt = tlo; kt < thi; ++kt) {
        const int s = 16 * kt + r; f32x4 k0a, k0b, k1a, k1b;
        if (s < 2052) { const float* kr = s < 2048 ? p.cache_ik + ((size_t)p.page_table[b * 16 + (s >> 7)] * 128 + (s & 127)) * 64 : SMALL + (size_t)(MP + 4 * b + (s - 2048)) * SMALL_LD;
            k0a = *(const f32x4*)(kr + 8 * q); k0b = *(const f32x4*)(kr + 8 * q + 4); k1a = *(const f32x4*)(kr + 32 + 8 * q); k1b = *(const f32x4*)(kr + 32 + 8 * q + 4); }
        else { k0a = (f32x4){0.f, 0.f, 0.f, 0.f}; k0b = k0a; k1a = k0a; k1b = k0a; }
        u32x4 w0, w1; w0.x = cvt_pk_bf16(k0a[0], k0a[1]); w0.y = cvt_pk_bf16(k0a[2], k0a[3]); w0.z = cvt_pk_bf16(k0b[0], k0b[1]); w0.w = cvt_pk_bf16(k0b[2], k0b[3]);
        w1.x = cvt_pk_bf16(k1a[0], k1a[1]); w1.y = cvt_pk_bf16(k1a[2], k1a[3]); w1.z = cvt_pk_bf16(k1b[0], k1b[1]); w1.w = cvt_pk_bf16(k1b[2], k1b[3]);
        const bf16x8_t kb0 = __builtin_bit_cast(bf16x8_t, w0), kb1 = __builtin_bit_cast(bf16x8_t, w1);
#pragma unroll
        for (int mtl = 0; mtl < 2; ++mtl) {
            f32x4 S = __builtin_amdgcn_mfma_f32_16x16x32_bf16(qa[mtl][0], kb0, (f32x4){0.f, 0.f, 0.f, 0.f}, 0, 0, 0); S = __builtin_amdgcn_mfma_f32_16x16x32_bf16(qa[mtl][1], kb1, S, 0, 0, 0);
            float sc = (w4[mtl][0] * fmaxf(S[0], 0.f) + w4[mtl][1] * fmaxf(S[1], 0.f)) + (w4[mtl][2] * fmaxf(S[2], 0.f) + w4[mtl][3] * fmaxf(S[3], 0.f));
            sc = x16_sum(sc);
            if ((q & 1) == 0) SCS[(size_t)(4 * b + 2 * mtl + (q >> 1)) * SCS_LD + s] = sc;
        }
    }
}

constexpr int SA_LS = 96256, SA_LP = 104960, SA_SEL = 113664, SA_N = 115840;
__device__ __forceinline__ void attn_mfma_sample(const Ptrs& p, LAS unsigned char* lds, const int b, const int g, const int tid) {
    const int lane = tid & 63, wv = __builtin_amdgcn_readfirstlane(tid >> 6), r = lane & 15, q = lane >> 4;
    const bf16_t* QA = (const bf16_t*)(p.WS() + WS_QA); const bf16_t* KA = (const bf16_t*)(p.WS() + WS_KA); const bf16_t* PROJ = (const bf16_t*)(p.WS() + WS_PROJ); const u64* MASKS = (const u64*)(p.WS() + WS_MASKS);
    LAS int* listS = (LAS int*)(lds + SA_LS); LAS int* listP = (LAS int*)(lds + SA_LP); LAS unsigned char* sel = lds + SA_SEL; LAS int* nk = (LAS int*)(lds + SA_N); LAS const float* biasn = (LAS const float*)(lds + AT_BIAS);
    __syncthreads();
    LAS u64* mk4 = (LAS u64*)(lds + SA_N + 64);
    if (wv < 4) {
        float raw[33]; select_load<33>(raw, (const float*)(p.WS() + WS_SCS) + (size_t)(4 * b + wv) * SCS_LD, lane);
        select_compute<33>(raw, 2049 + wv, (u64*)(mk4 + wv * 33), lane);
    }
    __syncthreads();
    if (wv == 0) {
        int base = 0;
        for (int w = 0; w < 33; ++w) {
            const u64 m0 = mk4[w], m1 = mk4[33 + w], m2 = mk4[66 + w], m3 = mk4[99 + w];
            const unsigned s4 = (unsigned)((m0 >> lane) & 1ull) | ((unsigned)((m1 >> lane) & 1ull) << 1) | ((unsigned)((m2 >> lane) & 1ull) << 2) | ((unsigned)((m3 >> lane) & 1ull) << 3);
            const bool on = s4 != 0u; const u64 bal = __ballot(on);
            if (on) { const int pos = base + __popcll(bal & ((1ull << lane) - 1ull)); listS[pos] = 64 * w + lane; sel[pos] = (unsigned char)s4; }
            base += __popcll(bal);
        }
        const int npad = (base + 63) & ~63;
        for (int i = base + lane; i < npad; i += 64) { listS[i] = 0; sel[i] = 0; }
        if (lane == 0) { nk[0] = base; nk[1] = npad; }
    }
    __syncthreads();
    const int npad = nk[1], ntile = npad >> 6;
    for (int i = tid; i < npad; i += 512) { const int s = listS[i]; listP[i] = s < 2048 ? p.page_table[b * 16 + (s >> 7)] * 128 + (s & 127) : -(1 + (s - 2048)); }
    bf16x8_t qf[4];
    { const size_t qrow = (size_t)MP + 4 * b + (r >> 2); const int hh = 4 * g + (r & 3);
#pragma unroll
      for (int kk = 0; kk < 4; ++kk) qf[kk] = *(const bf16x8_t*)(QA + qrow * 1024 + hh * 128 + 32 * kk + 8 * q); }
    const int trow = r >> 2, hrow = 4 * g + (r & 3), qpos = 2048 + trow;
    f32x4 O = (f32x4){0.f, 0.f, 0.f, 0.f}; float mrun = -INFINITY, lrun = 0.f;
    const int srow = tid >> 3, sp = tid & 7;
    f32x4 pkf[4], pvf[4];
    __syncthreads();
#define SA_PREFETCH(kt_) do { const int e_ = listP[64 * (kt_) + srow]; \
        if (e_ >= 0) { const float* kp_ = p.cache_k + ((size_t)e_ * 2 + g) * 128 + sp * 16; const float* vp_ = p.cache_v + ((size_t)e_ * 2 + g) * 128 + sp * 16; \
            _Pragma("unroll") for (int j_ = 0; j_ < 4; ++j_) { pkf[j_] = *(const f32x4*)(kp_ + 4 * j_); pvf[j_] = *(const f32x4*)(vp_ + 4 * j_); } } \
        else { const size_t nr_ = (size_t)MP + 4 * b + (-e_ - 1); const bf16_t* kp_ = KA + nr_ * 256 + g * 128 + sp * 16; const bf16_t* vp_ = PROJ + nr_ * PROJ_LD + PC_VA + g * 128 + sp * 16; \
            const u32x4 a0_ = *(const u32x4*)kp_, a1_ = *(const u32x4*)(kp_ + 8), c0_ = *(const u32x4*)vp_, c1_ = *(const u32x4*)(vp_ + 8); \
            pkf[0] = (f32x4){bflo(a0_.x), bfhi(a0_.x), bflo(a0_.y), bfhi(a0_.y)}; pkf[1] = (f32x4){bflo(a0_.z), bfhi(a0_.z), bflo(a0_.w), bfhi(a0_.w)}; pkf[2] = (f32x4){bflo(a1_.x), bfhi(a1_.x), bflo(a1_.y), bfhi(a1_.y)}; pkf[3] = (f32x4){bflo(a1_.z), bfhi(a1_.z), bflo(a1_.w), bfhi(a1_.w)}; \
            pvf[0] = (f32x4){bflo(c0_.x), bfhi(c0_.x), bflo(c0_.y), bfhi(c0_.y)}; pvf[1] = (f32x4){bflo(c0_.z), bfhi(c0_.z), bflo(c0_.w), bfhi(c0_.w)}; pvf[2] = (f32x4){bflo(c1_.x), bfhi(c1_.x), bflo(c1_.y), bfhi(c1_.y)}; pvf[3] = (f32x4){bflo(c1_.z), bfhi(c1_.z), bflo(c1_.w), bfhi(c1_.w)}; } } while (0)
#define SA_STAGE(buf_) do { LAS unsigned char* bb_ = lds + (buf_) * AT_BUF; u32x4 w0_, w1_; \
        w0_.x = cvt_pk_bf16(pkf[0][0], pkf[0][1]); w0_.y = cvt_pk_bf16(pkf[0][2], pkf[0][3]); w0_.z = cvt_pk_bf16(pkf[1][0], pkf[1][1]); w0_.w = cvt_pk_bf16(pkf[1][2], pkf[1][3]); \
        w1_.x = cvt_pk_bf16(pkf[2][0], pkf[2][1]); w1_.y = cvt_pk_bf16(pkf[2][2], pkf[2][3]); w1_.z = cvt_pk_bf16(pkf[3][0], pkf[3][1]); w1_.w = cvt_pk_bf16(pkf[3][2], pkf[3][3]); \
        *(LAS u32x4*)(bb_ + AT_KC + srow * 272 + sp * 32) = w0_; *(LAS u32x4*)(bb_ + AT_KC + srow * 272 + sp * 32 + 16) = w1_; \
        _Pragma("unroll") for (int j_ = 0; j_ < 4; ++j_) _Pragma("unroll") for (int e_ = 0; e_ < 4; e_ += 2) { const unsigned w_ = cvt_pk_bf16(pvf[j_][e_], pvf[j_][e_ + 1]); const int d_ = sp * 16 + 4 * j_ + e_; \
            *(LAS bf16_t*)(bb_ + AT_VT + d_ * 144 + srow * 2) = (bf16_t)(w_ & 0xffffu); *(LAS bf16_t*)(bb_ + AT_VT + (d_ + 1) * 144 + srow * 2) = (bf16_t)(w_ >> 16); } } while (0)
    SA_PREFETCH(0); SA_STAGE(0); if (ntile > 1) SA_PREFETCH(1);
    __syncthreads();
    for (int kt = 0; kt < ntile; ++kt) {
        const int buf = kt & 1; LAS const unsigned char* bb = lds + buf * AT_BUF;
        if (kt + 1 < ntile) { SA_STAGE(buf ^ 1); if (kt + 2 < ntile) SA_PREFETCH(kt + 2); }
        f32x4 S[4];
#pragma unroll
        for (int a = 0; a < 4; ++a) { S[a] = (f32x4){0.f, 0.f, 0.f, 0.f};
#pragma unroll
            for (int kk = 0; kk < 4; ++kk) S[a] = __builtin_amdgcn_mfma_f32_16x16x32_bf16(*(LAS const bf16x8_t*)(bb + AT_KC + (16 * a + r) * 272 + kk * 64 + q * 16), qf[kk], S[a], 0, 0, 0); }
        float mx = -INFINITY;
#pragma unroll
        for (int a = 0; a < 4; ++a) { const int i0 = 64 * kt + 16 * a + 4 * q; const unsigned s4w = *(LAS const unsigned*)(sel + i0);
            const int ks0 = listS[i0], ks1 = listS[i0 + 1], ks2 = listS[i0 + 2], ks3 = listS[i0 + 3]; const int ksv[4] = {ks0, ks1, ks2, ks3};
#pragma unroll
            for (int i = 0; i < 4; ++i) { const bool on = (s4w >> (8 * i + trow)) & 1u; int dist = qpos - ksv[i]; dist = dist < 0 ? 0 : (dist > 255 ? 255 : dist);
                const float lg = on ? S[a][i] + biasn[dist * 8 + hrow] : -INFINITY; S[a][i] = lg; mx = fmaxf(mx, lg); } }
        mx = x32_max(x16_max(mx));
        const float mnew = fmaxf(mrun, mx), muse = (mnew == -INFINITY) ? 0.f : mnew; const float alpha = __expf(mrun - muse); mrun = mnew;
        float psum = 0.f; unsigned pw[4][2];
#pragma unroll
        for (int a = 0; a < 4; ++a) { float pe[4];
#pragma unroll
            for (int i = 0; i < 4; ++i) { pe[i] = __expf(S[a][i] - muse); psum += pe[i]; }
            pw[a][0] = cvt_pk_bf16(pe[0], pe[1]); pw[a][1] = cvt_pk_bf16(pe[2], pe[3]); }
        psum = x32_sum(x16_sum(psum));
        lrun = lrun * alpha + psum;
        u32x4 pf[2]; pf[0].x = pw[0][0]; pf[0].y = pw[0][1]; pf[0].z = pw[1][0]; pf[0].w = pw[1][1]; pf[1].x = pw[2][0]; pf[1].y = pw[2][1]; pf[1].z = pw[3][0]; pf[1].w = pw[3][1];
#pragma unroll
        for (int i = 0; i < 4; ++i) O[i] *= __shfl(alpha, 4 * q + i);
        { LAS const unsigned char* vrow = bb + AT_VT + (16 * wv + r) * 144;
#pragma unroll
          for (int a2 = 0; a2 < 2; ++a2) { const u32x2 lo = *(LAS const u32x2*)(vrow + (32 * a2 + 4 * q) * 2), hi = *(LAS const u32x2*)(vrow + (32 * a2 + 16 + 4 * q) * 2); u32x4 vf; vf.x = lo.x; vf.y = lo.y; vf.z = hi.x; vf.w = hi.y;
              O = __builtin_amdgcn_mfma_f32_16x16x32_bf16(__builtin_bit_cast(bf16x8_t, pf[a2]), __builtin_bit_cast(bf16x8_t, vf), O, 0, 0, 0); } }
        __syncthreads();
    }
#undef SA_PREFETCH
#undef SA_STAGE
    bf16_t* CAT = (bf16_t*)(p.WS() + WS_CAT); const float invl = 1.0f / lrun;
#pragma unroll
    for (int i = 0; i < 4; ++i) { const float iv = __shfl(invl, 4 * q + i); CAT[((size_t)MP + 4 * b + q) * D + 1024 + (4 * g + i) * 128 + 16 * wv + r] = f2bf(O[i] * iv); }
}

struct MkArgs { Ptrs p; int ph_lo, ph_hi, sub, pad; };
__global__ void __launch_bounds__(512, 2) mk_fwd(MkArgs a) {
    extern __shared__ __attribute__((aligned(16))) unsigned char lds_raw[];
    LAS unsigned char* lds = (LAS unsigned char*)lds_raw;
    const int lo_ = a.ph_lo, hi_ = a.ph_hi;
    const Ptrs& p = a.p;
    { unsigned char* w = p.ws_; asm volatile("" :: "s"(w), "s"(lo_), "s"(hi_)); }
    const int tid0 = threadIdx.x;
#define PART_ENV int tid = tid0; asm volatile("" : "+v"(tid)); const int lane = tid & 63, wave = __builtin_amdgcn_readfirstlane(tid >> 6), gw = vcu * 8 + wave; (void)lane; (void)wave; (void)gw;
    const int tid = tid0, lane = tid & 63, wave = __builtin_amdgcn_readfirstlane(tid >> 6);
    const int G = gridDim.x; const int bx = blockIdx.x; const int vcu = (G % 8 == 0) ? (bx % 8) * (G / 8) + bx / 8 : bx;
    const int gw = vcu * 8 + wave, NGW = G * 8;
    for (int u = tid; u < (LDS_BYTES - LDSCTL_OFF) / 4; u += 512) ((LAS unsigned*)(lds + LDSCTL_OFF))[u] = 0u;
    __syncthreads();
    const bool one_launch = (hi_ - lo_) > 1;
    XcdBarrier bar; bar.bar = (unsigned*)(p.WS() + WS_CTL) + CW_BAR; bar.x = 0; bar.st = nullptr;
    if (one_launch) bar = xcd_barrier_post((unsigned*)(p.WS() + WS_CTL) + CW_BAR, (volatile LAS unsigned*)(lds + MISC_OFF) + 8);
    const int lo = lo_, hi = hi_;
#define IN(k) (lo <= (k) && (k) < hi)
#define SEAM(k) do { if (IN(k) && IN((k) + 1)) xcd_barrier(bar); } while (0)
    const float* mods = (const float*)(p.WS() + WS_MODS);
    bf16_t* Hb = (bf16_t*)(p.WS() + WS_H); bf16_t* ACT = (bf16_t*)(p.WS() + WS_ACT); bf16_t* CAT = (bf16_t*)(p.WS() + WS_CAT);
    float* X = p.out + O_Y;

    if (IN(0)) {
        if (G == 256) {
            if (vcu < 144) { PART_ENV const int wi = 8 * vcu + wave; if (wi & 1) mods_wg_body<5, 4>(p, lds, wi >> 1, tid); else mods_wg_body<0, 5>(p, lds, wi >> 1, tid); }
            { PART_ENV LAS float* scr = (LAS float*)(lds + RING_OFF + wave * 16384);
              constexpr int NM = 12, NMW = 1152, IT_M = NM * NMW;
              if (vcu < 144) { const int mw = vcu * 8 + wave; for (int k = 0; k < NM; ++k) convert_item(p, mw + k * NMW, scr, lane); }
              else { const int ow = (vcu - 144) * 8 + wave; for (int it = IT_M + ow; it < IT_ALL; it += 896) convert_item(p, it, scr, lane); } }
        } else {
            { PART_ENV if ((gw & 15) < 9) { const int it = (gw >> 4) * 9 + (gw & 15); if (it < 2 * (NMOD / 32)) { if (it & 1) mods_item_t<5, 4>(p, it >> 1, lane); else mods_item_t<0, 5>(p, it >> 1, lane); } } }
            { PART_ENV LAS float* scr = (LAS float*)(lds + RING_OFF + wave * 16384); for (int it = gw; it < IT_ALL; it += NGW) convert_item(p, it, scr, lane); }
        }
    }
    SEAM(0);
    if (IN(1)) { PART_ENV for (int row = gw; row < M; row += NGW) { const float* mr = mods + (size_t)row_bm(row) * NMOD;
        normmod_q8(row < MP ? p.x_p + (size_t)row * D : p.x_s + (size_t)(row - MP) * D, p.f1_g, mr + D, mr, p.WS() + WS_H8 + (size_t)row * D, (float*)(p.WS() + WS_SA) + row, lane); }
        for (int n = gw; n < 4 * FF; n += NGW) { const int which = n >= 2 * FF, nn = which ? n - 2 * FF : n;
            quant_wrow<D>((const bf16_t*)(p.WS() + (which ? WS_W2GU : WS_W1GU)) + (size_t)nn * D, p.WS() + (which ? WS_W2GU8 : WS_W1GU8) + (size_t)nn * D, (unsigned*)(p.WS() + WS_CTL + CTL_CMAX) + n, lane); }
        for (int n = gw; n < 2 * D; n += NGW) { const int which = n >= D, nn = which ? n - D : n;
            quant_wrow<FF>((const bf16_t*)(p.WS() + (which ? WS_W2D : WS_W1D)) + (size_t)nn * FF, p.WS() + (which ? WS_W2D8 : WS_W1D8) + (size_t)nn * FF, (unsigned*)(p.WS() + WS_CTL + CTL_CMAX) + 4 * FF + n, lane); } }
    SEAM(1);
    if (IN(2)) { PART_ENV pg8::Gemm g{(const bf16_t*)(p.WS() + WS_H8), (const bf16_t*)(p.WS() + WS_W1GU8), M, 2 * FF, D / 2, D / 2}; pg8::StaticOrder S; S.init(MP, 2 * FF, G, bx);
        pg8::EpiSwigluI8 E{ACT, (const float*)(p.WS() + WS_SA), (const float*)(p.WS() + WS_CTL + CTL_CMAX), (float*)(p.WS() + WS_RMAXP), p.WS() + WS_ACT8};
        pg8::gemm_phase<pg8::EpiSwigluI8, pg8::StaticOrder, PG8_ALIGN, PG8_SP2>(lds + RING_OFF, g, S, E); }
    if (IN(2) && IN(15)) xcd_barrier(bar);
    if (IN(15)) { PART_ENV
        const int ngemm = G > 88 ? 88 : G, nreq = G > 88 ? G - 88 : G, creq = G > 88 ? bx - 88 : bx;
        if (bx < ngemm) { pg8::Gemm g{(const bf16_t*)(p.WS() + WS_H8), (const bf16_t*)(p.WS() + WS_W1GU8), M, 2 * FF, D / 2, D / 2}; pg8::SampleOrder S; S.init(2 * FF, ngemm, bx);
            pg8::EpiSwigluI8 E{ACT, (const float*)(p.WS() + WS_SA), (const float*)(p.WS() + WS_CTL + CTL_CMAX), (float*)(p.WS() + WS_RMAXP), p.WS() + WS_ACT8};
            pg8::gemm_phase<pg8::EpiSwigluI8, pg8::SampleOrder, PG8_ALIGN, PG8_SP2>(lds + RING_OFF, g, S, E); }
        const int nown = G > 88 ? 3 * ngemm * 8 : 0;
        if (G > 88 && bx < ngemm) for (int row = bx * 8 + wave; row < nown; row += ngemm * 8) requant_act_row(p.WS() + WS_ACT8 + (size_t)row * FF, (const float*)(p.WS() + WS_RMAXP) + (size_t)row * 176, (float*)(p.WS() + WS_SA2) + row, lane);
        if (creq >= 0) for (int row = nown + creq * 8 + wave; row < MP; row += nreq * 8) requant_act_row(p.WS() + WS_ACT8 + (size_t)row * FF, (const float*)(p.WS() + WS_RMAXP) + (size_t)row * 176, (float*)(p.WS() + WS_SA2) + row, lane); }
    if (IN(15) && IN(3)) xcd_barrier(bar);
    if (IN(3)) { PART_ENV
#pragma nounroll
      for (int s_ = 0; s_ < 2; ++s_) {
        if ((s_ == 0) != ((bx & 1) != 0)) { pg8::Gemm g{(const bf16_t*)(p.WS() + WS_ACT8), (const bf16_t*)(p.WS() + WS_W1D8), MP, D, FF / 2, FF / 2}; pg8::StaticOrder S; S.init(MP, D, G, bx, 4);
        pg8::EpiResidI8T<false, true> E{p.x_p, (bf16_t*)(p.WS() + WS_XB), mods + 2 * D, 0.5f, (const float*)(p.WS() + WS_SA2), (const float*)(p.WS() + WS_CTL + CTL_CMAX) + 4 * FF};
        pg8::gemm_phase<pg8::EpiResidI8T<false, true>, pg8::StaticOrder, PG8_ALIGN, PG8_SP2>(lds + RING_OFF, g, S, E); }
        else { pg8::Gemm g{ACT, (const bf16_t*)(p.WS() + WS_W1D), M, D, FF, 512}; pg8::SplitOrder S{11, G, (bx & 1) ? (bx >> 1) : (G >> 1) + (bx >> 1)}; pg8::EpiSlab E{(float*)(p.WS() + WS_SLAB)};
        pg8::gemm_phase<pg8::EpiSlab, pg8::SplitOrder, PG8_ALIGN, PG8_SP2>(lds + RING_OFF, g, S, E); }
        __syncthreads(); } }
    SEAM(3);
    if (IN(4)) { PART_ENV const int nit = fix_rows_n(gw, NGW); for (int it = 0; it < nit; ++it) { const int row = fix_row_at(gw, NGW, it); const float* mr = mods + (size_t)row_bm(row) * NMOD + 3 * D;
        bf16_t* xb = (bf16_t*)(p.WS() + WS_XB) + (size_t)row * D; f32x4 v[8];
        if (row < MP) row_load_b(v, xb, lane);
        else { row_load(v, p.x_s + (size_t)(row - MP) * D, lane); fix_add<11>(v, (const float*)(p.WS() + WS_SLAB) + (size_t)(row - MP) * D, mr - D, 0.5f, lane); row_store_b(v, xb, lane); }
        normmod_vals(v, p.mix_g, mr + D, mr, Hb + (size_t)row * D, lane); } }
    SEAM(4);
    if (IN(5)) { PART_ENV pg8::Gemm g{Hb, (const bf16_t*)(p.WS() + WS_WIN), M, 6400, D, D}; pg8::StaticOrder S; S.init(M, 6400, G, bx); pg8::EpiProj E{(bf16_t*)(p.WS() + WS_PROJ), (float*)(p.WS() + WS_SMALL)};
        pg8::gemm_phase<pg8::EpiProj, pg8::StaticOrder, PG8_ALIGN, PG8_SP2>(lds + RING_OFF, g, S, E); }
    SEAM(5);
    if (IN(6)) { const bool spread = G >= 64; const int NGI = spread ? NGW - 32 : NGW;
        { PART_ENV const bool scanw = spread ? (wave == 7 && vcu < 32) : (gw < 32); const int gi = !spread ? gw : (vcu < 32 ? vcu * 7 + wave : 224 + (vcu - 32) * 8 + wave);
          if (scanw) scan_bh(p, spread ? vcu : gw, lane);
          if (!(spread && scanw)) for (int row = gi; row < M; row += NGI) post_row(p, row, lane); }
        { PART_ENV constexpr int NU = (MP / 8) * 8; const bool scanw = spread && wave == 7 && vcu < 32; const int gi = !spread ? gw : (vcu < 32 ? vcu * 7 + wave : 224 + (vcu - 32) * 8 + wave);
          if (scanw) {}
          else if ((NGI & 7) == 0 && gi < NU) { f32x4 w[4];
#pragma unroll
              for (int k = 0; k < 4; ++k) w[k] = *(const f32x4*)(p.conv_w + (size_t)k * 2048 + 256 * (gi & 7) + 4 * lane);
              u32x2 cur[11], nxt[11]; conv_load(cur, p, gi, lane);
              for (int u = gi; u < NU; u += NGI) { const bool more = u + NGI < NU; if (more) conv_load(nxt, p, u + NGI, lane); conv_compute(cur, w, p, u, lane);
                  if (more) {
#pragma unroll
                      for (int i = 0; i < 11; ++i) cur[i] = nxt[i]; } } }
          else if ((NGI & 7) != 0) { for (int u = gi; u < NU; u += NGI) { f32x4 w[4];
#pragma unroll
              for (int k = 0; k < 4; ++k) w[k] = *(const f32x4*)(p.conv_w + (size_t)k * 2048 + 256 * (u & 7) + 4 * lane);
              u32x2 cur[11]; conv_load(cur, p, u, lane); conv_compute(cur, w, p, u, lane); } } } }
    SEAM(6);
    if (IN(7)) {
        if (a.sub & 1) { PART_ENV for (int u = vcu; u < 256; u += G) { const int b = u >> 5;
            for (int k = 0; k < 2; ++k) { const int pi = 2 * (u & 31) + k; scores_select_unit(p, lds, b, pi, tid); scores_select_unit(p, lds, b, 127 - pi, tid); } }
          __syncthreads(); }
        if (a.sub & 2) { PART_ENV for (int u = gw; u < 2048; u += NGW) scores_mfma_sample(p, u, lane); }
        if (a.sub & 4) { PART_ENV for (int unit = vcu; unit < 256; unit += G) mlstm_mfma_unit(p, lds, unit, tid); }
        if (a.sub & 8) { PART_ENV mlstm_sample_items(p, lds_raw, vcu, G, tid); }
    }
    SEAM(7);
    if (IN(9)) {
        { PART_ENV for (int i = tid; i < 2048; i += 512) ((LAS float*)(lds + AT_BIAS))[i] = p.t5[t5_bucket(i >> 3) * 8 + (i & 7)];
          if (a.sub & 16) for (int u = vcu; u < 256; u += G) { const int b = u >> 5, g = (u >> 4) & 1, qb = u & 15; attn_mfma_block(p, lds, b, qb, g, tid); attn_mfma_block(p, lds, b, 31 - qb, g, tid); }
          __syncthreads(); }
        if (a.sub & 32) { PART_ENV for (int u = vcu; u < 256; u += G) attn_mfma_sample(p, lds, u >> 1, u & 1, tid);
          __syncthreads(); }
        if (a.sub & 64) { PART_ENV for (int row = gw; row < M; row += 2 * NGW) { mlstm_out_row(p, row, lane); if (row + NGW < M) mlstm_out_row(p, row + NGW, lane); } }
    }
    SEAM(9);
    if (IN(10)) { PART_ENV { pg8::Gemm g{CAT, (const bf16_t*)(p.WS() + WS_WOUT), MP, D, D, D}; pg8::StaticOrder S; S.init(MP, D, G, bx, 4); pg8::EpiResidT<true, true> E{(bf16_t*)(p.WS() + WS_XB), (bf16_t*)(p.WS() + WS_XB), mods + 5 * D, 1.0f};
        pg8::gemm_phase<pg8::EpiResidT<true, true>, pg8::StaticOrder, PG8_ALIGN, PG8_SP2>(lds + RING_OFF, g, S, E); }
        __syncthreads();
        { pg8::Gemm g{CAT, (const bf16_t*)(p.WS() + WS_WOUT), M, D, D, 256}; pg8::SplitOrder S{8, G, bx}; pg8::EpiSlab E{(float*)(p.WS() + WS_SLAB)};
        pg8::gemm_phase<pg8::EpiSlab, pg8::SplitOrder, PG8_ALIGN, PG8_SP2>(lds + RING_OFF, g, S, E); } }
    SEAM(10);
    if (IN(11)) { PART_ENV const int nit = fix_rows_n(gw, NGW); for (int it = 0; it < nit; ++it) { const int row = fix_row_at(gw, NGW, it); const float* mr = mods + (size_t)row_bm(row) * NMOD + 6 * D;
        bf16_t* xb = (bf16_t*)(p.WS() + WS_XB) + (size_t)row * D; f32x4 v[8]; row_load_b(v, xb, lane);
        if (row >= MP) { fix_add<8>(v, (const float*)(p.WS() + WS_SLAB) + (size_t)(row - MP) * D, mr - D, 1.0f, lane); row_store_b(v, xb, lane); }
        normmod_q8_vals(v, p.f2_g, mr + D, mr, p.WS() + WS_H8 + (size_t)row * D, (float*)(p.WS() + WS_SA) + row, lane); } }
    SEAM(11);
    if (IN(12)) { PART_ENV pg8::Gemm g{(const bf16_t*)(p.WS() + WS_H8), (const bf16_t*)(p.WS() + WS_W2GU8), M, 2 * FF, D / 2, D / 2}; pg8::StaticOrder S; S.init(MP, 2 * FF, G, bx);
        pg8::EpiSwigluI8 E{ACT, (const float*)(p.WS() + WS_SA), (const float*)(p.WS() + WS_CTL + CTL_CMAX) + 2 * FF, (float*)(p.WS() + WS_RMAXP), p.WS() + WS_ACT8};
        pg8::gemm_phase<pg8::EpiSwigluI8, pg8::StaticOrder, PG8_ALIGN, PG8_SP2>(lds + RING_OFF, g, S, E); }
    if (IN(12) && IN(16)) xcd_barrier(bar);
    if (IN(16)) { PART_ENV
        const int ngemm = G > 88 ? 88 : G, nreq = G > 88 ? G - 88 : G, creq = G > 88 ? bx - 88 : bx;
        if (bx < ngemm) { pg8::Gemm g{(const bf16_t*)(p.WS() + WS_H8), (const bf16_t*)(p.WS() + WS_W2GU8), M, 2 * FF, D / 2, D / 2}; pg8::SampleOrder S; S.init(2 * FF, ngemm, bx);
            pg8::EpiSwigluI8 E{ACT, (const float*)(p.WS() + WS_SA), (const float*)(p.WS() + WS_CTL + CTL_CMAX) + 2 * FF, (float*)(p.WS() + WS_RMAXP), p.WS() + WS_ACT8};
            pg8::gemm_phase<pg8::EpiSwigluI8, pg8::SampleOrder, PG8_ALIGN, PG8_SP2>(lds + RING_OFF, g, S, E); }
        const int nown = G > 88 ? 3 * ngemm * 8 : 0;
        if (G > 88 && bx < ngemm) for (int row = bx * 8 + wave; row < nown; row += ngemm * 8) requant_act_row(p.WS() + WS_ACT8 + (size_t)row * FF, (const float*)(p.WS() + WS_RMAXP) + (size_t)row * 176, (float*)(p.WS() + WS_SA2) + row, lane);
        if (creq >= 0) for (int row = nown + creq * 8 + wave; row < MP; row += nreq * 8) requant_act_row(p.WS() + WS_ACT8 + (size_t)row * FF, (const float*)(p.WS() + WS_RMAXP) + (size_t)row * 176, (float*)(p.WS() + WS_SA2) + row, lane); }
    if (IN(16) && IN(13)) xcd_barrier(bar);
    if (IN(13)) { PART_ENV
#pragma nounroll
      for (int s_ = 0; s_ < 2; ++s_) {
        if ((s_ == 0) != ((bx & 1) != 0)) { pg8::Gemm g{(const bf16_t*)(p.WS() + WS_ACT8), (const bf16_t*)(p.WS() + WS_W2D8), MP, D, FF / 2, FF / 2}; pg8::StaticOrder S; S.init(MP, D, G, bx, 4);
        pg8::EpiResidI8T<true, false> E{(bf16_t*)(p.WS() + WS_XB), X, mods + 8 * D, 0.5f, (const float*)(p.WS() + WS_SA2), (const float*)(p.WS() + WS_CTL + CTL_CMAX) + 4 * FF + D};
        pg8::gemm_phase<pg8::EpiResidI8T<true, false>, pg8::StaticOrder, PG8_ALIGN, PG8_SP2>(lds + RING_OFF, g, S, E); }
        else { pg8::Gemm g{ACT, (const bf16_t*)(p.WS() + WS_W2D), M, D, FF, 512}; pg8::SplitOrder S{11, G, (bx & 1) ? (bx >> 1) : (G >> 1) + (bx >> 1)}; pg8::EpiSlab E{(float*)(p.WS() + WS_SLAB)};
        pg8::gemm_phase<pg8::EpiSlab, pg8::SplitOrder, PG8_ALIGN, PG8_SP2>(lds + RING_OFF, g, S, E); }
        __syncthreads(); } }
    SEAM(13);
    if (IN(14)) { PART_ENV for (int t = gw; t < 4 * MS; t += NGW) { int ln = lane; asm volatile("" : "+v"(ln)); const int row = MP + (t >> 2), j0 = 2 * (t & 3);
        const float* mr = mods + (size_t)row_bm(row) * NMOD + 8 * D; const bf16_t* xr = (const bf16_t*)(p.WS() + WS_XB) + (size_t)row * D; const float* slab = (const float*)(p.WS() + WS_SLAB) + (size_t)(row - MP) * D;
        f32x4 v[2], a[2];
#pragma unroll
        for (int jj = 0; jj < 2; ++jj) { const u32x2 w = *(const u32x2*)(xr + 256 * (j0 + jj) + 4 * ln); v[jj][0] = bflo(w.x); v[jj][1] = bfhi(w.x); v[jj][2] = bflo(w.y); v[jj][3] = bfhi(w.y); a[jj] = (f32x4){0.f, 0.f, 0.f, 0.f};
#pragma unroll
            for (int k = 0; k < 11; ++k) a[jj] += ((const f32x4*)(slab + (size_t)k * MS * D))[64 * (j0 + jj) + ln]; }
#pragma unroll
        for (int jj = 0; jj < 2; ++jj) ((f32x4*)(X + (size_t)row * D))[64 * (j0 + jj) + ln] = v[jj] + (((const f32x4*)mr)[64 * (j0 + jj) + ln] * 0.5f) * a[jj]; } }
#undef IN
#undef SEAM
}

extern "C" void kernel_launch(void* const* d_in, const int* in_sizes, int n_in, void* d_out, int out_size, void* d_ws, size_t ws_size, hipStream_t stream) {
    static int ok = 0, grid = 0;
    if (ok == 0) {
        if (n_in != 31 || out_size != (int)O_END || ws_size < WS_END) { fprintf(stderr, "kernel_launch: unexpected shapes: n_in %d out %d ws %zu (need %zu)\n", n_in, out_size, ws_size, (size_t)WS_END); ok = -1; return; }
        if (hipFuncSetAttribute((const void*)mk_fwd, hipFuncAttributeMaxDynamicSharedMemorySize, LDS_BYTES) != hipSuccess) { fprintf(stderr, "kernel_launch: hipFuncSetAttribute(mk_fwd) failed\n"); ok = -1; return; }
        int dev = 0, cus = 0; if (hipGetDevice(&dev) != hipSuccess || hipDeviceGetAttribute(&cus, hipDeviceAttributeMultiprocessorCount, dev) != hipSuccess || cus < 8) { fprintf(stderr, "kernel_launch: device query failed\n"); ok = -1; return; }
        grid = cus;
        ok = 1;
    }
    if (ok < 0) return;
    Ptrs p{};
    const float* const* f = (const float* const*)d_in;
    p.x_p = f[0]; p.x_s = f[1]; p.c_p = f[2]; p.c_s = f[3]; p.cache_k = f[4]; p.cache_v = f[5]; p.cache_ik = f[6]; p.page_table = (const int*)d_in[7];
    p.state_C = f[8]; p.state_n = f[9]; p.state_m = f[10]; p.state_conv = f[11];
    p.f1_g = f[12]; p.f1_wg = f[13]; p.f1_wu = f[14]; p.f1_wd = f[15]; p.mix_g = f[16]; p.w_in = f[17]; p.conv_w = f[18]; p.gate_b = f[19]; p.out_g = f[20]; p.qn_g = f[21]; p.kn_g = f[22]; p.t5 = f[23];
    p.w_out = f[24]; p.f2_g = f[25]; p.f2_wg = f[26]; p.f2_wu = f[27]; p.f2_wd = f[28]; p.w_ada = f[29]; p.b_ada = f[30];
    p.out = (float*)d_out; p.ws_ = (unsigned char*)d_ws;
    if (hipMemsetAsync((char*)d_ws + WS_CTL, 0, CTL_ZERO_BYTES, stream) != hipSuccess) { fprintf(stderr, "kernel_launch: memset failed\n"); return; }
    MkArgs a{}; a.p = p;
    a.sub = 127; a.pad = 0;
#ifdef MK_SEQ
    { static const int seq[] = {MK_SEQ}; for (unsigned i = 0; i < sizeof(seq) / sizeof(seq[0]); ++i) { a.ph_lo = seq[i] & 255; a.ph_hi = a.ph_lo + 1; a.sub = (seq[i] >> 8) ? (seq[i] >> 8) : 127; hipLaunchKernelGGL(mk_fwd, dim3(grid), dim3(512), LDS_BYTES, stream, a); } }
#else
    a.ph_lo = 0; a.ph_hi = 17; hipLaunchKernelGGL(mk_fwd, dim3(grid), dim3(512), LDS_BYTES, stream, a);
#endif
}
```

```cpp
#include <hip/hip_runtime.h>
#include <stdint.h>
#include <stdio.h>

typedef unsigned short bf16_t;
typedef float f32x4 __attribute__((ext_vector_type(4)));
typedef unsigned u32x2 __attribute__((ext_vector_type(2)));
typedef unsigned u32x4 __attribute__((ext_vector_type(4)));
typedef unsigned long long u64;

constexpr int D = 2048, BP = 8, TP = 2048, BS = 128, TS = 4;
constexpr int MP = BP * TP, MS = BS * TS, M = MP + MS;
constexpr int FF = 5632, NMOD = 9 * D, NB = BP + BS;
constexpr int PW = 6224;
constexpr int PROJ_LD = 6144, SMALL_LD = 128;
constexpr int SCS_LD = 2112;
constexpr float EPS = 1e-6f;
constexpr int PC_QM = 0, PC_KM = 1024, PC_VM = 2048, PC_OM = 3072, PC_QA = 4096, PC_KA = 5120, PC_VA = 5376, PC_QI = 5632;

constexpr size_t O_Y = 0;
constexpr size_t O_KP = O_Y + (size_t)M * D;
constexpr size_t O_VP = O_KP + (size_t)MP * 256;
constexpr size_t O_IKP = O_VP + (size_t)MP * 256;
constexpr size_t O_CP = O_IKP + (size_t)MP * 64;
constexpr size_t O_NP = O_CP + (size_t)BP * 4 * 65536;
constexpr size_t O_MP = O_NP + (size_t)BP * 4 * 256;
constexpr size_t O_CVP = O_MP + (size_t)BP * 4;
constexpr size_t O_KS = O_CVP + (size_t)BP * 3 * 2048;
constexpr size_t O_VS = O_KS + (size_t)MS * 256;
constexpr size_t O_IKS = O_VS + (size_t)MS * 256;
constexpr size_t O_CS = O_IKS + (size_t)MS * 64;
constexpr size_t O_NS = O_CS + (size_t)BS * 4 * 65536;
constexpr size_t O_MS = O_NS + (size_t)BS * 4 * 256;
constexpr size_t O_CVS = O_MS + (size_t)BS * 4;
constexpr size_t O_END = O_CVS + (size_t)BS * 3 * 2048;
static_assert(O_END == 80962080, "output size");

constexpr size_t al256(size_t x) { return (x + 255) & ~(size_t)255; }
constexpr size_t WS_CTL = 0;
constexpr size_t WS_MODS = 1u << 20;
constexpr size_t WS_H = al256(WS_MODS + (size_t)NB * NMOD * 4);
constexpr size_t WS_ACT = al256(WS_H + (size_t)M * D * 2);
constexpr size_t WS_PROJ = al256(WS_ACT + (size_t)M * FF * 2);
constexpr size_t WS_SMALL = al256(WS_PROJ + (size_t)M * PROJ_LD * 2);
constexpr size_t WS_QA = al256(WS_SMALL + (size_t)M * SMALL_LD * 4);
constexpr size_t WS_KA = al256(WS_QA + (size_t)M * 1024 * 2);
constexpr size_t WS_QM = al256(WS_KA + (size_t)M * 256 * 2);
constexpr size_t WS_KM = al256(WS_QM + (size_t)M * 1024 * 2);
constexpr size_t WS_HM = al256(WS_KM + (size_t)M * 1024 * 2);
constexpr size_t WS_CAT = al256(WS_HM + (size_t)M * 1024 * 4);
constexpr size_t WS_BC = al256(WS_CAT + (size_t)M * D * 2);
constexpr size_t WS_IG = al256(WS_BC + (size_t)32 * 2048 * 4);
constexpr size_t WS_MM = al256(WS_IG + (size_t)32 * 2048 * 4);
constexpr size_t WS_SC = al256(WS_MM + (size_t)32 * 2048 * 4);
constexpr size_t WS_SCS = al256(WS_SC + (size_t)MP * 2048 * 4);
constexpr size_t WS_MASK = al256(WS_SCS + (size_t)MS * SCS_LD * 4);
constexpr size_t WS_MASKS = al256(WS_MASK + (size_t)MP * 32 * 8);
constexpr size_t WS_KI = al256(WS_MASKS + (size_t)MS * 33 * 8);
constexpr size_t WS_SLAB = al256(WS_KI + (size_t)M * 64 * 2);
constexpr size_t WS_XB = al256(WS_SLAB + (size_t)11 * MS * D * 4);
constexpr size_t WS_H8 = al256(WS_XB + (size_t)M * D * 2);
constexpr size_t WS_SA = al256(WS_H8 + (size_t)M * D);
constexpr size_t WS_W1GU8 = al256(WS_SA + (size_t)M * 4);
constexpr size_t WS_W2GU8 = al256(WS_W1GU8 + (size_t)2 * FF * D);
constexpr size_t WS_ACT8 = al256(WS_W2GU8 + (size_t)2 * FF * D);
constexpr size_t WS_SA2 = al256(WS_ACT8 + (size_t)M * FF);
constexpr size_t WS_RMAXP = al256(WS_SA2 + (size_t)M * 4);
constexpr size_t WS_W1D8 = al256(WS_RMAXP + (size_t)M * 176 * 4);
constexpr size_t WS_W2D8 = al256(WS_W1D8 + (size_t)D * FF);
constexpr size_t WS_W1GU = al256(WS_W2D8 + (size_t)D * FF);
constexpr size_t WS_W1D = al256(WS_W1GU + (size_t)2 * FF * D * 2);
constexpr size_t WS_WIN = al256(WS_W1D + (size_t)D * FF * 2);
constexpr size_t WS_WOUT = al256(WS_WIN + (size_t)6400 * D * 2);
constexpr size_t WS_W2GU = al256(WS_WOUT + (size_t)D * D * 2);
constexpr size_t WS_W2D = al256(WS_W2GU + (size_t)2 * FF * D * 2);
constexpr size_t WS_END = al256(WS_W2D + (size_t)D * FF * 2);

struct Ptrs {
    const float *x_p, *x_s, *c_p, *c_s, *cache_k, *cache_v, *cache_ik; const int* page_table;
    const float *state_C, *state_n, *state_m, *state_conv;
    const float *f1_g, *f1_wg, *f1_wu, *f1_wd, *mix_g, *w_in, *conv_w, *gate_b, *out_g, *qn_g, *kn_g, *t5, *w_out, *f2_g, *f2_wg, *f2_wu, *f2_wd, *w_ada, *b_ada;
    float* out; unsigned char* ws_;
    __device__ __forceinline__ unsigned char* WS() const { const unsigned long long w = (unsigned long long)ws_; unsigned w0 = (unsigned)w, w1 = (unsigned)(w >> 32); asm volatile("" : "+v"(w0), "+v"(w1));
        return (unsigned char*)(__attribute__((address_space(1))) unsigned char*)(((unsigned long long)(unsigned)__builtin_amdgcn_readfirstlane(w1) << 32) | (unsigned)__builtin_amdgcn_readfirstlane(w0)); }
};

__device__ __forceinline__ float bf2f(bf16_t v) { return __uint_as_float(((unsigned)v) << 16); }
__device__ __forceinline__ bf16_t f2bf(float f) { unsigned u = __float_as_uint(f); u += 0x7fffu + ((u >> 16) & 1u); return (bf16_t)(u >> 16); }
__device__ __forceinline__ unsigned pk2(float lo, float hi) { return (unsigned)f2bf(lo) | ((unsigned)f2bf(hi) << 16); }
__device__ __forceinline__ float bflo(unsigned w) { return __uint_as_float(w << 16); }
__device__ __forceinline__ float bfhi(unsigned w) { return __uint_as_float(w & 0xffff0000u); }
__device__ __forceinline__ float wave_sum(float v) {
#pragma unroll
    for (int o = 1; o < 64; o <<= 1) v += __shfl_xor(v, o);
    return v;
}
__device__ __forceinline__ float wave_max(float v) {
#pragma unroll
    for (int o = 1; o < 64; o <<= 1) v = fmaxf(v, __shfl_xor(v, o));
    return v;
}
__device__ __forceinline__ float x16_max(float x) { const auto r = __builtin_amdgcn_permlane16_swap(__float_as_uint(x), __float_as_uint(x), false, false); return fmaxf(__uint_as_float(r[0]), __uint_as_float(r[1])); }
__device__ __forceinline__ float x32_max(float x) { const auto r = __builtin_amdgcn_permlane32_swap(__float_as_uint(x), __float_as_uint(x), false, false); return fmaxf(__uint_as_float(r[0]), __uint_as_float(r[1])); }
__device__ __forceinline__ float x16_sum(float x) { const auto r = __builtin_amdgcn_permlane16_swap(__float_as_uint(x), __float_as_uint(x), false, false); return __uint_as_float(r[0]) + __uint_as_float(r[1]); }
__device__ __forceinline__ float x32_sum(float x) { const auto r = __builtin_amdgcn_permlane32_swap(__float_as_uint(x), __float_as_uint(x), false, false); return __uint_as_float(r[0]) + __uint_as_float(r[1]); }
__device__ __forceinline__ float silu_f(float x) { return x / (1.0f + __expf(-x)); }
__device__ __forceinline__ int row_bm(int row) { return row < MP ? (row >> 11) : BP + ((row - MP) >> 2); }
__device__ __forceinline__ int t5_bucket(int dist) {
    if (dist < 16) return dist;
    const float ratio = logf((float)dist / 16.0f) / 2.0794415416798357f;
    int large = 16 + (int)(ratio * 16.0f);
    return large < 31 ? large : 31;
}

__device__ __forceinline__ void normmod_vals(const f32x4 (&v)[8], const float* g, const float* sc, const float* sh, bf16_t* hr, int lane);
__device__ __forceinline__ void normmod_row(const float* xr, const float* g, const float* sc, const float* sh, bf16_t* hr, int lane) {
    f32x4 v[8];
#pragma unroll
    for (int j = 0; j < 8; ++j) v[j] = ((const f32x4*)xr)[64 * j + lane];
    normmod_vals(v, g, sc, sh, hr, lane);
}
template <int NS> __device__ __forceinline__ void normmod_fix_row(const float* base, const float* slab, const float* gate, const float scale, float* xo, const float* g, const float* sc, const float* sh, bf16_t* hr, int lane) {
    f32x4 v[8];
#pragma unroll
    for (int j = 0; j < 8; ++j) { f32x4 a = (f32x4){0.f, 0.f, 0.f, 0.f};
#pragma unroll
        for (int k = 0; k < NS; ++k) a += ((const f32x4*)(slab + (size_t)k * MS * D))[64 * j + lane];
        v[j] = ((const f32x4*)base)[64 * j + lane] + (((const f32x4*)gate)[64 * j + lane] * scale) * a; ((f32x4*)xo)[64 * j + lane] = v[j]; }
    if (hr) normmod_vals(v, g, sc, sh, hr, lane);
}
__device__ __forceinline__ void normmod_vals(const f32x4 (&v)[8], const float* g, const float* sc, const float* sh, bf16_t* hr, int lane) {
    float ss = 0.f;
#pragma unroll
    for (int j = 0; j < 8; ++j) ss += (v[j][0] * v[j][0] + v[j][1] * v[j][1]) + (v[j][2] * v[j][2] + v[j][3] * v[j][3]);
    ss = wave_sum(ss);
    const float r = 1.0f / sqrtf(ss * (1.0f / D) + EPS);
#pragma unroll
    for (int j = 0; j < 8; ++j) {
        const int col = 256 * j + 4 * lane;
        const f32x4 gg = *(const f32x4*)(g + col), s = *(const f32x4*)(sc + col), h = *(const f32x4*)(sh + col);
        const f32x4 o = v[j] * r * gg * (1.0f + s) + h;
        u32x2 w; w[0] = pk2(o[0], o[1]); w[1] = pk2(o[2], o[3]);
        *(u32x2*)(hr + col) = w;
    }
}

__device__ __forceinline__ void row_load(f32x4 (&v)[8], const float* xr, int lane) {
#pragma unroll
    for (int j = 0; j < 8; ++j) v[j] = ((const f32x4*)xr)[64 * j + lane];
}
__device__ __forceinline__ void row_load_b(f32x4 (&v)[8], const bf16_t* xr, int lane) {
#pragma unroll
    for (int j = 0; j < 8; ++j) { const u32x2 w = *(const u32x2*)(xr + 256 * j + 4 * lane); v[j][0] = bflo(w.x); v[j][1] = bfhi(w.x); v[j][2] = bflo(w.y); v[j][3] = bfhi(w.y); }
}
__device__ __forceinline__ void row_store_b(const f32x4 (&v)[8], bf16_t* xr, int lane) {
#pragma unroll
    for (int j = 0; j < 8; ++j) { u32x2 w; w.x = pk2(v[j][0], v[j][1]); w.y = pk2(v[j][2], v[j][3]); *(u32x2*)(xr + 256 * j + 4 * lane) = w; }
}
template <int NS> __device__ __forceinline__ void fix_add(f32x4 (&v)[8], const float* slab, const float* gate, const float scale, int lane) {
#pragma unroll
    for (int j = 0; j < 8; j += 2) { f32x4 a = (f32x4){0.f, 0.f, 0.f, 0.f}, b = a;
#pragma unroll
        for (int k = 0; k < NS; ++k) { a += ((const f32x4*)(slab + (size_t)k * MS * D))[64 * j + lane]; b += ((const f32x4*)(slab + (size_t)k * MS * D))[64 * (j + 1) + lane]; }
        v[j] += (((const f32x4*)gate)[64 * j + lane] * scale) * a; v[j + 1] += (((const f32x4*)gate)[64 * (j + 1) + lane] * scale) * b;
        asm volatile("" : "+v"(v[j]), "+v"(v[j + 1]) :: "memory"); }
}
__device__ __forceinline__ int fix_rows_n(int gw, int NGW) { return NGW == 2048 ? (gw < 512 ? 6 : 9) : (M - gw + NGW - 1) / NGW; }
__device__ __forceinline__ int fix_row_at(int gw, int NGW, int it) {
    if (NGW != 2048) return gw + it * NGW;
    if (gw < 512) return it == 0 ? MP + gw : gw + (it - 1) * 2048;
    return it < 8 ? gw + it * 2048 : ((gw - 512) & 511) + (5 + ((gw - 512) >> 9)) * 2048;
}
__device__ __forceinline__ unsigned q8x4(float a, float b, float c, float d, float inv) {
    const int qa = (int)rintf(fminf(fmaxf(a * inv, -127.f), 127.f)), qb = (int)rintf(fminf(fmaxf(b * inv, -127.f), 127.f)), qc = (int)rintf(fminf(fmaxf(c * inv, -127.f), 127.f)), qd = (int)rintf(fminf(fmaxf(d * inv, -127.f), 127.f));
    return (unsigned)(qa & 0xff) | ((unsigned)(qb & 0xff) << 8) | ((unsigned)(qc & 0xff) << 16) | ((unsigned)(qd & 0xff) << 24);
}
template <int KW> __device__ __forceinline__ void quant_wrow(const bf16_t* wrow, unsigned char* orow, unsigned* cm, int lane) {
    const float mx = fmaxf(__uint_as_float(*cm), 1e-30f), inv = 127.0f / mx;
#pragma unroll
    for (int j = 0; j < KW / 512; ++j) { const u32x4 w = *(const u32x4*)(wrow + 8 * lane + 512 * j); u32x2 o;
        o.x = q8x4(bflo(w.x), bfhi(w.x), bflo(w.y), bfhi(w.y), inv); o.y = q8x4(bflo(w.z), bfhi(w.z), bflo(w.w), bfhi(w.w), inv);
        *(u32x2*)(orow + 8 * lane + 512 * j) = o; }
    if (lane == 0) *(float*)cm = mx * (1.0f / 127.0f);
}
__device__ __forceinline__ void requant_act_row(unsigned char* arow, const float* rmp, float* sa2, int lane) {
    float mx = fmaxf(rmp[lane], rmp[64 + lane]); if (lane < 48) mx = fmaxf(mx, rmp[128 + lane]);
    mx = fmaxf(wave_max(mx), 1e-30f); const float rinv = 1.0f / mx;
    u32x2 w[11]; float f[11];
#pragma unroll
    for (int j = 0; j < 11; ++j) { w[j] = *(const u32x2*)(arow + 8 * lane + 512 * j); f[j] = rmp[16 * j + (lane >> 2)] * rinv; }
#pragma unroll
    for (int j = 0; j < 11; ++j) { unsigned b[8];
#pragma unroll
        for (int e = 0; e < 4; ++e) { b[e] = __float_as_uint(__builtin_fmaf((float)((w[j].x >> (8 * e)) & 255u) - 128.0f, f[j], 12582912.0f)); b[4 + e] = __float_as_uint(__builtin_fmaf((float)((w[j].y >> (8 * e)) & 255u) - 128.0f, f[j], 12582912.0f)); }
        u32x2 o; o.x = __builtin_amdgcn_perm(b[1], b[0], 0x0c0c0400u) | __builtin_amdgcn_perm(b[3], b[2], 0x04000c0cu); o.y = __builtin_amdgcn_perm(b[5], b[4], 0x0c0c0400u) | __builtin_amdgcn_perm(b[7], b[6], 0x04000c0cu);
        *(u32x2*)(arow + 8 * lane + 512 * j) = o; }
    if (lane == 0) *sa2 = mx * (1.0f / 127.0f);
}
__device__ __forceinline__ void normmod_q8_vals(f32x4 (&v)[8], const float* g, const float* sc, const float* sh, unsigned char* hr, float* sa, int lane) {
    float ss = 0.f;
#pragma unroll
    for (int j = 0; j < 8; ++j) ss += (v[j][0] * v[j][0] + v[j][1] * v[j][1]) + (v[j][2] * v[j][2] + v[j][3] * v[j][3]);
    ss = wave_sum(ss);
    const float r = 1.0f / sqrtf(ss * (1.0f / D) + EPS); float amax = 0.f;
#pragma unroll
    for (int j = 0; j < 8; ++j) { const int col = 256 * j + 4 * lane; const f32x4 gg = *(const f32x4*)(g + col), s = *(const f32x4*)(sc + col), h = *(const f32x4*)(sh + col);
        v[j] = v[j] * r * gg * (1.0f + s) + h; amax = fmaxf(amax, fmaxf(fmaxf(fabsf(v[j][0]), fabsf(v[j][1])), fmaxf(fabsf(v[j][2]), fabsf(v[j][3])))); }
    amax = fmaxf(wave_max(amax), 1e-30f); const float inv = 127.0f / amax;
#pragma unroll
    for (int j = 0; j < 8; ++j) *(unsigned*)(hr + 256 * j + 4 * lane) = q8x4(v[j][0], v[j][1], v[j][2], v[j][3], inv);
    if (lane == 0) *sa = amax * (1.0f / 127.0f);
}
__device__ __forceinline__ void normmod_q8(const float* xr, const float* g, const float* sc, const float* sh, unsigned char* hr, float* sa, int lane) {
    f32x4 v[8];
#pragma unroll
    for (int j = 0; j < 8; ++j) v[j] = ((const f32x4*)xr)[64 * j + lane];
    normmod_q8_vals(v, g, sc, sh, hr, sa, lane);
}
template <int NS> __device__ __forceinline__ void fix_row_vals(f32x4 (&v)[8], const float* base, const float* slab, const float* gate, const float scale, float* xo, int lane) {
#pragma unroll
    for (int j = 0; j < 8; ++j) { f32x4 a = (f32x4){0.f, 0.f, 0.f, 0.f};
#pragma unroll
        for (int k = 0; k < NS; ++k) a += ((const f32x4*)(slab + (size_t)k * MS * D))[64 * j + lane];
        v[j] = ((const f32x4*)base)[64 * j + lane] + (((const f32x4*)gate)[64 * j + lane] * scale) * a; ((f32x4*)xo)[64 * j + lane] = v[j]; }
}

__device__ __forceinline__ void post_row(const Ptrs& p, int row, int lane) {
    const bf16_t* PROJ = (const bf16_t*)(p.WS() + WS_PROJ); const float* SMALL = (const float*)(p.WS() + WS_SMALL);
    const bf16_t* pr = PROJ + (size_t)row * PROJ_LD; const float* sm = SMALL + (size_t)row * SMALL_LD;
    const bool prompt = row < MP; const int b = prompt ? row >> 11 : (row - MP) >> 2, t = prompt ? row & 2047 : (row - MP) & 3;
    const int rrel = prompt ? row : row - MP;
    {
        const u32x4 w0 = *(const u32x4*)(pr + PC_QA + 16 * lane), w1 = *(const u32x4*)(pr + PC_QA + 16 * lane + 8);
        float q[16];
#pragma unroll
        for (int i = 0; i < 4; ++i) { q[2 * i] = bflo(w0[i]); q[2 * i + 1] = bfhi(w0[i]); q[8 + 2 * i] = bflo(w1[i]); q[8 + 2 * i + 1] = bfhi(w1[i]); }
        float ss = 0.f;
#pragma unroll
        for (int i = 0; i < 16; ++i) ss += q[i] * q[i];
        ss += __shfl_xor(ss, 1); ss += __shfl_xor(ss, 2); ss += __shfl_xor(ss, 4);
        const float r = (1.0f / sqrtf(ss * (1.0f / 128.0f) + EPS)) * 0.08838834764831845f;
        const float* gq = p.qn_g + ((16 * lane) & 127);
        u32x4 o0, o1;
#pragma unroll
        for (int i = 0; i < 4; ++i) { o0[i] = pk2(q[2 * i] * r * gq[2 * i], q[2 * i + 1] * r * gq[2 * i + 1]); o1[i] = pk2(q[8 + 2 * i] * r * gq[8 + 2 * i], q[8 + 2 * i + 1] * r * gq[8 + 2 * i + 1]); }
        bf16_t* qa = (bf16_t*)(p.WS() + WS_QA) + (size_t)row * 1024 + 16 * lane;
        *(u32x4*)qa = o0; *(u32x4*)(qa + 8) = o1;
    }
    {
        const u32x2 w = *(const u32x2*)(pr + PC_KA + 4 * lane);
        float k[4] = {bflo(w[0]), bfhi(w[0]), bflo(w[1]), bfhi(w[1])};
        float ss = (k[0] * k[0] + k[1] * k[1]) + (k[2] * k[2] + k[3] * k[3]);
        ss += __shfl_xor(ss, 1); ss += __shfl_xor(ss, 2); ss += __shfl_xor(ss, 4); ss += __shfl_xor(ss, 8); ss += __shfl_xor(ss, 16);
        const float r = 1.0f / sqrtf(ss * (1.0f / 128.0f) + EPS);
        const f32x4 gk = *(const f32x4*)(p.kn_g + ((4 * lane) & 127));
        f32x4 o; o[0] = k[0] * r * gk[0]; o[1] = k[1] * r * gk[1]; o[2] = k[2] * r * gk[2]; o[3] = k[3] * r * gk[3];
        *(f32x4*)(p.out + (prompt ? O_KP : O_KS) + (size_t)rrel * 256 + 4 * lane) = o;
        u32x2 ob; ob[0] = pk2(o[0], o[1]); ob[1] = pk2(o[2], o[3]);
        *(u32x2*)((bf16_t*)(p.WS() + WS_KA) + (size_t)row * 256 + 4 * lane) = ob;
        const u32x2 wv = *(const u32x2*)(pr + PC_VA + 4 * lane);
        f32x4 ov; ov[0] = bflo(wv[0]); ov[1] = bfhi(wv[0]); ov[2] = bflo(wv[1]); ov[3] = bfhi(wv[1]);
        *(f32x4*)(p.out + (prompt ? O_VP : O_VS) + (size_t)rrel * 256 + 4 * lane) = ov;
    }
    { const float kv = sm[lane]; p.out[(prompt ? O_IKP : O_IKS) + (size_t)rrel * 64 + lane] = kv; ((bf16_t*)(p.WS() + WS_KI))[(size_t)row * 64 + lane] = f2bf(kv); }
    if (!prompt) {
        bf16_t* QM = (bf16_t*)(p.WS() + WS_QM); bf16_t* KM = (bf16_t*)(p.WS() + WS_KM);
#pragma unroll
        for (int j = 0; j < 4; ++j) {
            const int c = 8 * lane + 512 * j;
            float xs[4][8];
#pragma unroll
            for (int k = 0; k < 4; ++k) {
                if (t - k >= 0) { const u32x4 w = *(const u32x4*)(pr - (size_t)k * PROJ_LD + c);
#pragma unroll
                    for (int i = 0; i < 4; ++i) { xs[k][2 * i] = bflo(w[i]); xs[k][2 * i + 1] = bfhi(w[i]); } }
                else if (prompt) {
#pragma unroll
                    for (int i = 0; i < 8; ++i) xs[k][i] = 0.f; }
                else { const float* sb = p.state_conv + ((size_t)b * 3 + (3 + t - k)) * 2048 + c; const f32x4 a0 = *(const f32x4*)sb, a1 = *(const f32x4*)(sb + 4);
#pragma unroll
                    for (int i = 0; i < 4; ++i) { xs[k][i] = a0[i]; xs[k][4 + i] = a1[i]; } }
            }
            float y[8];
#pragma unroll
            for (int i = 0; i < 8; ++i) y[i] = 0.f;
#pragma unroll
            for (int k = 0; k < 4; ++k) { const float* wk = p.conv_w + (size_t)(3 - k) * 2048 + c; const f32x4 a0 = *(const f32x4*)wk, a1 = *(const f32x4*)(wk + 4);
#pragma unroll
                for (int i = 0; i < 4; ++i) { y[i] += a0[i] * xs[k][i]; y[4 + i] += a1[i] * xs[k][4 + i]; } }
            const float scl = c < 1024 ? 1.0f : 0.0625f;
            u32x4 o;
#pragma unroll
            for (int i = 0; i < 4; ++i) o[i] = pk2(silu_f(y[2 * i]) * scl, silu_f(y[2 * i + 1]) * scl);
            if (c < 1024) *(u32x4*)(QM + (size_t)row * 1024 + c) = o; else *(u32x4*)(KM + (size_t)row * 1024 + (c - 1024)) = o;
            const int slot = prompt ? t - (TP - 3) : t - 1;
            if (slot >= 0) { float* cv = p.out + (prompt ? O_CVP : O_CVS) + ((size_t)b * 3 + slot) * 2048 + c;
                f32x4 a0, a1;
#pragma unroll
                for (int i = 0; i < 4; ++i) { a0[i] = xs[0][i]; a1[i] = xs[0][4 + i]; }
                *(f32x4*)cv = a0; *(f32x4*)(cv + 4) = a1; }
        }
    }
}
__device__ __forceinline__ void conv_load(u32x2 (&xr)[11], const Ptrs& p, const int unit, const int lane) {
    const bf16_t* PROJ = (const bf16_t*)(p.WS() + WS_PROJ);
    const int rg = unit >> 3, slab = unit & 7, row0 = 8 * rg, t0 = row0 & 2047, c = 256 * slab + 4 * lane;
#pragma unroll
    for (int i = 0; i < 11; ++i) { if (t0 + i - 3 >= 0) xr[i] = *(const u32x2*)(PROJ + (size_t)(row0 + i - 3) * PROJ_LD + c); else { xr[i].x = 0u; xr[i].y = 0u; } }
}
__device__ __forceinline__ void conv_compute(const u32x2 (&xr)[11], const f32x4 (&w)[4], const Ptrs& p, const int unit, const int lane) {
    bf16_t* QM = (bf16_t*)(p.WS() + WS_QM); bf16_t* KM = (bf16_t*)(p.WS() + WS_KM);
    const int rg = unit >> 3, slab = unit & 7, row0 = 8 * rg, t0 = row0 & 2047, b = row0 >> 11, c = 256 * slab + 4 * lane;
    const float scl = c < 1024 ? 1.0f : 0.0625f; bf16_t* dst = c < 1024 ? QM + c : KM + (c - 1024);
#pragma unroll
    for (int i = 0; i < 8; ++i) {
        f32x4 y = (f32x4){0.f, 0.f, 0.f, 0.f};
#pragma unroll
        for (int k = 0; k < 4; ++k) { const u32x2 x = xr[i + k]; f32x4 xv; xv[0] = bflo(x.x); xv[1] = bfhi(x.x); xv[2] = bflo(x.y); xv[3] = bfhi(x.y); y += w[k] * xv; }
        u32x2 o; o.x = pk2(silu_f(y[0]) * scl, silu_f(y[1]) * scl); o.y = pk2(silu_f(y[2]) * scl, silu_f(y[3]) * scl);
        *(u32x2*)(dst + (size_t)(row0 + i) * 1024) = o;
        const int slot = t0 + i - (TP - 3);
        if (slot >= 0) { const u32x2 x = xr[i + 3]; f32x4 xv; xv[0] = bflo(x.x); xv[1] = bfhi(x.x); xv[2] = bflo(x.y); xv[3] = bfhi(x.y); *(f32x4*)(p.out + O_CVP + ((size_t)b * 3 + slot) * 2048 + c) = xv; }
    }
}
__device__ __forceinline__ float logsigmoid_f(float x) { return fminf(x, 0.f) - log1pf(expf(-fabsf(x))); }
__device__ __forceinline__ void scan_bh(const Ptrs& p, int bh, int lane) {
    const float* SMALL = (const float*)(p.WS() + WS_SMALL);
    float* BC = (float*)(p.WS() + WS_BC) + (size_t)bh * 2048; float* IG = (float*)(p.WS() + WS_IG) + (size_t)bh * 2048; float* MMa = (float*)(p.WS() + WS_MM) + (size_t)bh * 2048;
    const int b = bh >> 2, h = bh & 3; const float bi = p.gate_b[h], bfv = p.gate_b[4 + h];
    float lf[32], ig[32];
    float A = 0.f, Bv = -INFINITY;
#pragma unroll
    for (int i = 0; i < 32; ++i) { const float* sm = SMALL + ((size_t)b * 2048 + 32 * lane + i) * SMALL_LD; ig[i] = sm[64 + h] + bi; lf[i] = logsigmoid_f(sm[68 + h] + bfv); A += lf[i]; Bv = fmaxf(Bv + lf[i], ig[i]); }
    const float Aown = A;
#pragma unroll
    for (int off = 1; off < 64; off <<= 1) { const float Ap = __shfl_up(A, off), Bp = __shfl_up(Bv, off); if (lane >= off) { Bv = fmaxf(Bp + A, Bv); A = Ap + A; } }
    float Aex = __shfl_up(A, 1), Bex = __shfl_up(Bv, 1); if (lane == 0) { Aex = 0.f; Bex = -INFINITY; }
    float m = fmaxf(0.0f + Aex, Bex);
    float c = __shfl_up(Aown, 1); if ((lane & 1) == 0) c = 0.f;
#pragma unroll
    for (int i = 0; i < 32; ++i) { m = fmaxf(m + lf[i], ig[i]); c += lf[i]; const int t = 32 * lane + i; MMa[t] = m; BC[t] = c; IG[t] = ig[i]; }
}

__device__ __forceinline__ void mlstm_sample_items(const Ptrs& p, unsigned char* lds, const int first, const int stride, const int tid) {
    float (*qf)[256] = (float (*)[256])(lds); float (*kf)[256] = (float (*)[256])(lds + 4096); float (*vf)[256] = (float (*)[256])(lds + 8192);
    float (*red)[4][256] = (float (*)[4][256])(lds + 12288);
    float* bc = (float*)(lds + 12288 + 32768); float* ig = bc + 4; float* mm = bc + 8; float* sw = bc + 12; float* wl = bc + 16; float (*Pm)[4] = (float (*)[4])(bc + 20); float* qn = bc + 36; float* sc2 = bc + 40;
    const int lane = tid & 63, wv = tid >> 6;
    const bf16_t* QM = (const bf16_t*)(p.WS() + WS_QM); const bf16_t* KM = (const bf16_t*)(p.WS() + WS_KM); const bf16_t* PROJ = (const bf16_t*)(p.WS() + WS_PROJ); const float* SMALL = (const float*)(p.WS() + WS_SMALL);
    float* HM = (float*)(p.WS() + WS_HM);
    for (int item = first; item < BS * 4; item += stride) {
        const int b = item >> 2, h = item & 3; const size_t r0 = (size_t)MP + 4 * b;
        for (int i = tid; i < 1024; i += 512) { const int t = i >> 8, d = i & 255;
            qf[t][d] = bf2f(QM[(r0 + t) * 1024 + h * 256 + d]); kf[t][d] = bf2f(KM[(r0 + t) * 1024 + h * 256 + d]); vf[t][d] = bf2f(PROJ[(r0 + t) * PROJ_LD + PC_VM + h * 256 + d]); }
        if (tid == 0) {
            const float m0 = p.state_m[item]; float m = m0, c = 0.f;
            for (int t = 0; t < 4; ++t) { const float* sm = SMALL + (r0 + t) * SMALL_LD; const float igt = sm[64 + h] + p.gate_b[h], lft = logsigmoid_f(sm[68 + h] + p.gate_b[4 + h]);
                m = fmaxf(m + lft, igt); c += lft; bc[t] = c; ig[t] = igt; mm[t] = m; sw[t] = expf(c + m0 - m); }
            for (int t = 0; t < 4; ++t) wl[t] = expf(bc[3] - bc[t] + ig[t] - mm[3]);
            sc2[0] = expf(bc[3] + m0 - mm[3]);
        }
        __syncthreads();
        if (wv < 4) {
            const int t = wv; float a = 0.f, d0 = 0.f, d1 = 0.f, d2 = 0.f, d3 = 0.f;
            for (int i = 0; i < 4; ++i) { const int d = lane + 64 * i; const float qv = qf[t][d]; a += qv * p.state_n[(size_t)item * 256 + d]; d0 += qv * kf[0][d]; d1 += qv * kf[1][d]; d2 += qv * kf[2][d]; d3 += qv * kf[3][d]; }
            a = wave_sum(a); d0 = wave_sum(d0); d1 = wave_sum(d1); d2 = wave_sum(d2); d3 = wave_sum(d3);
            if (lane == 0) { qn[t] = a; const float dd[4] = {d0, d1, d2, d3};
                for (int s = 0; s < 4; ++s) Pm[t][s] = s <= t ? dd[s] * expf(bc[t] - bc[s] + ig[s] - mm[t]) : 0.f; }
        }
        __syncthreads();
        {
            const int e = 4 * lane; const float decay = sc2[0];
            f32x4 qc[4]; for (int t = 0; t < 4; ++t) qc[t] = (f32x4){0.f, 0.f, 0.f, 0.f};
            f32x4 vv[4]; for (int s = 0; s < 4; ++s) vv[s] = *(const f32x4*)&vf[s][e];
            const float* Cin = p.state_C + (size_t)item * 65536; float* Cout = p.out + O_CS + (size_t)item * 65536;
            for (int i0 = 0; i0 < 32; i0 += 8) { f32x4 c8[8];
#pragma unroll
                for (int ii = 0; ii < 8; ++ii) c8[ii] = *(const f32x4*)(Cin + (size_t)(wv + 8 * (i0 + ii)) * 256 + e);
#pragma unroll
                for (int ii = 0; ii < 8; ++ii) { const int d = wv + 8 * (i0 + ii); const f32x4 c0 = c8[ii];
                    f32x4 cn = c0 * decay;
#pragma unroll
                    for (int s = 0; s < 4; ++s) cn += (wl[s] * kf[s][d]) * vv[s];
                    *(f32x4*)(Cout + (size_t)d * 256 + e) = cn;
#pragma unroll
                    for (int t = 0; t < 4; ++t) qc[t] += qf[t][d] * c0; } }
#pragma unroll
            for (int t = 0; t < 4; ++t) *(f32x4*)&red[wv][t][e] = qc[t];
        }
        __syncthreads();
        for (int i = tid; i < 1024; i += 512) { const int t = i >> 8, e = i & 255; float QC = 0.f;
#pragma unroll
            for (int w = 0; w < 8; ++w) QC += red[w][t][e];
            float num = sw[t] * QC, rs = 0.f;
            for (int s = 0; s <= t; ++s) { num += Pm[t][s] * vf[s][e]; rs += Pm[t][s]; }
            const float den = rs + sw[t] * qn[t];
            HM[(r0 + t) * 1024 + h * 256 + e] = num / fmaxf(fabsf(den), expf(-mm[t])); }
        if (tid < 256) { const int d = tid; float a = sc2[0] * p.state_n[(size_t)item * 256 + d]; for (int s = 0; s < 4; ++s) a += wl[s] * kf[s][d]; p.out[O_NS + (size_t)item * 256 + d] = a; }
        if (tid == 0) p.out[O_MS + item] = mm[3];
        __syncthreads();
    }
}

__device__ __forceinline__ void mlstm_out_row(const Ptrs& p, const int row, const int lane) {
    const float* HM = (const float*)(p.WS() + WS_HM); const bf16_t* PROJ = (const bf16_t*)(p.WS() + WS_PROJ); bf16_t* CAT = (bf16_t*)(p.WS() + WS_CAT);
    {
        const float* hr = HM + (size_t)row * 1024 + 16 * lane; float hv[16];
#pragma unroll
        for (int i = 0; i < 4; ++i) { const f32x4 a = *(const f32x4*)(hr + 4 * i); hv[4 * i] = a[0]; hv[4 * i + 1] = a[1]; hv[4 * i + 2] = a[2]; hv[4 * i + 3] = a[3]; }
        float ss = 0.f;
#pragma unroll
        for (int i = 0; i < 16; ++i) ss += hv[i] * hv[i];
        ss += __shfl_xor(ss, 1); ss += __shfl_xor(ss, 2); ss += __shfl_xor(ss, 4); ss += __shfl_xor(ss, 8);
        const float r = 1.0f / sqrtf(ss * (1.0f / 256.0f) + EPS);
        const bf16_t* orow = PROJ + (size_t)row * PROJ_LD + PC_OM + 16 * lane; const u32x4 w0 = *(const u32x4*)orow, w1 = *(const u32x4*)(orow + 8);
        float ov[16];
#pragma unroll
        for (int i = 0; i < 4; ++i) { ov[2 * i] = bflo(w0[i]); ov[2 * i + 1] = bfhi(w0[i]); ov[8 + 2 * i] = bflo(w1[i]); ov[8 + 2 * i + 1] = bfhi(w1[i]); }
        const float* g = p.out_g + 16 * lane; u32x4 o0, o1;
#pragma unroll
        for (int i = 0; i < 4; ++i) {
            const float a0 = hv[2 * i] * r * g[2 * i] / (1.0f + __expf(-ov[2 * i])), a1 = hv[2 * i + 1] * r * g[2 * i + 1] / (1.0f + __expf(-ov[2 * i + 1]));
            const float b0 = hv[8 + 2 * i] * r * g[8 + 2 * i] / (1.0f + __expf(-ov[8 + 2 * i])), b1 = hv[8 + 2 * i + 1] * r * g[8 + 2 * i + 1] / (1.0f + __expf(-ov[8 + 2 * i + 1]));
            o0[i] = pk2(a0, a1); o1[i] = pk2(b0, b1); }
        bf16_t* cr = CAT + (size_t)row * D + 16 * lane; *(u32x4*)cr = o0; *(u32x4*)(cr + 8) = o1;
    }
}

__device__ __forceinline__ unsigned order_key(float x) { const unsigned bts = __float_as_uint(x); return (bts & 0x80000000u) ? ~bts : (bts | 0x80000000u); }
template <int NREG> __device__ __forceinline__ void select_load(float (&raw)[NREG], const float* sc, int lane) {
#pragma unroll
    for (int i = 0; i < NREG; ++i) raw[i] = sc[64 * i + lane];
}
template <int NREG> __device__ __forceinline__ void select_compute(const float (&raw)[NREG], int nvalid, u64* mask, int lane) {
    unsigned u[NREG];
#pragma unroll
    for (int i = 0; i < NREG; ++i) { const int s = 64 * i + lane; u[i] = s < nvalid ? order_key(raw[i]) : 0u; }
    if (nvalid <= 256) {
#pragma unroll
        for (int i = 0; i < NREG; ++i) { const u64 mk = __ballot(64 * i + lane < nvalid); if (lane == 0) mask[i] = mk; }
        return;
    }
    unsigned T = 0u; bool exact = false;
    for (int bit = 31; bit >= 0; --bit) {
        const unsigned cand = T | (1u << bit);
        int cnt = 0;
#pragma unroll
        for (int i = 0; i + 3 < NREG; i += 4) { u64 m0, m1, m2, m3;
            asm volatile("v_cmp_ge_u32_e64 %0, %4, %8\n\tv_cmp_ge_u32_e64 %1, %5, %8\n\tv_cmp_ge_u32_e64 %2, %6, %8\n\tv_cmp_ge_u32_e64 %3, %7, %8\n\ts_nop 4"
                         : "=&s"(m0), "=&s"(m1), "=&s"(m2), "=&s"(m3) : "v"(u[i]), "v"(u[i + 1]), "v"(u[i + 2]), "v"(u[i + 3]), "s"(cand));
            cnt += (__popcll(m0) + __popcll(m1)) + (__popcll(m2) + __popcll(m3)); }
#pragma unroll
        for (int i = NREG & ~3; i < NREG; ++i) cnt += __popcll(__ballot(u[i] >= cand));
        if (cnt >= 256) T = cand;
        if (cnt == 256) { exact = true; break; }
    }
    if (exact) {
#pragma unroll
        for (int i = 0; i < NREG; ++i) { const u64 mk = __ballot(u[i] >= T); if (lane == 0) mask[i] = mk; }
        return;
    }
    int G = 0;
#pragma unroll
    for (int i = 0; i < NREG; ++i) G += __popcll(__ballot(u[i] > T));
    int need = 256 - G;
#pragma unroll
    for (int i = 0; i < NREG; ++i) {
        const u64 gt = __ballot(u[i] > T), eq = __ballot(u[i] == T); const int c = __popcll(eq); u64 take;
        if (c <= need) { take = eq; need -= c; }
        else { u64 mrem = eq; take = 0ull; for (int k = 0; k < need; ++k) { const u64 low = mrem & (~mrem + 1ull); take |= low; mrem ^= low; } need = 0; }
        if (lane == 0) mask[i] = gt | take;
    }
}

namespace pg8 {
#define PG8_LAS __attribute__((address_space(3)))
typedef unsigned short bf16_t;
typedef short bf16x8 __attribute__((ext_vector_type(8)));
typedef float f32x4 __attribute__((ext_vector_type(4)));
typedef unsigned u32x4 __attribute__((ext_vector_type(4)));
typedef int i32x4 __attribute__((ext_vector_type(4)));
constexpr int BM = 256, BK = 64, HALF = 128, HTB = HALF * BK * 2  , STAGE_BYTES = 8 * HTB, NXCD = 8, WGM = 8;

__host__ __device__ __forceinline__ int lds_byte(int r, int c) { const int st = (r >> 4) * 2 + (c >> 5), rr = r & 15, cc = c & 31, ob = rr * 64 + cc * 2; return st * 1024 + (ob ^ (((ob >> 9) & 1) << 5)); }
__host__ __device__ __forceinline__ void stage_rc(int b, int& R, int& C) { const int st = b / 1024, sb = b % 1024, swz = sb ^ (((sb >> 9) & 1) << 5); R = (st >> 1) * 16 + swz / 64; C = (st & 1) * 32 + (swz % 64) / 2; }
__host__ __device__ __forceinline__ int perm32(int rho) { const int n = rho >> 4, i = rho & 15; return 8 * (i >> 2) + 4 * n + (i & 3); }

struct Unit { int pm, pn, pk; };
struct Gemm { const bf16_t* A; const bf16_t* Bt; int M, N, K, KL; };

struct StaticOrder {
    int nM, nN, nwg, G, c, wgm;
    __host__ __device__ void init(int M, int N, int G_, int c_, int wgm_ = WGM) { nM = M / BM; nN = N / BM; nwg = nM * nN; G = G_; c = c_; wgm = wgm_; }
    __host__ __device__ bool next(int i, Unit& u) const {
        const long L = (long)i * G + c; if (L >= nwg) return false;
        int wgid = (int)L; { const int q = nwg / NXCD, r = nwg % NXCD, xcd = wgid % NXCD, off = wgid / NXCD; wgid = (xcd < r ? xcd * (q + 1) : r * (q + 1) + (xcd - r) * q) + off; }
        const int nig = wgm * nN, gid = wgid / nig, fm = gid * wgm, gsz = (nM - fm) < wgm ? (nM - fm) : wgm;
        u.pm = fm + ((wgid % nig) % gsz); u.pn = (wgid % nig) / gsz; u.pk = 0; return true;
    }
    __device__ __forceinline__ void a_ready(const Unit&) const {}
    __device__ __forceinline__ void done(const Unit&) const {}
};
struct SampleOrder {
    StaticOrder S;
    __host__ __device__ void init(int N, int G_, int c_) { S.init(MS, N, G_, c_); }
    __host__ __device__ bool next(int i, Unit& u) const { if (!S.next(i, u)) return false; u.pm += MP / BM; return true; }
    __device__ __forceinline__ void a_ready(const Unit&) const {}
    __device__ __forceinline__ void done(const Unit&) const {}
};


typedef float f32x2_t __attribute__((ext_vector_type(2)));
typedef __bf16 bf16x2_t __attribute__((ext_vector_type(2)));
__device__ __forceinline__ unsigned cvt_pk_bf16(float lo, float hi) { const f32x2_t v = {lo, hi}; const bf16x2_t b = __builtin_convertvector(v, bf16x2_t); return __builtin_bit_cast(unsigned, b); }
__device__ __forceinline__ float silu_fast(float x) { return x * __builtin_amdgcn_rcpf(1.0f + __expf(-x)); }

struct EpiSwiglu {
    typedef f32x4 AccT; static constexpr bool PERM = true, AFTER_DRAIN = false;
    bf16_t* O;
    __device__ __forceinline__ void operator()(const f32x4 (&acc)[2][2][4][2], const Unit& u, int wr, int wc, int fr, int fq) const {
        const int row0 = u.pm * BM + wr * 64 + fr, col0 = u.pn * HALF + wc * 32 + 8 * fq;
#pragma unroll
        for (int ai = 0; ai < 2; ++ai)
#pragma unroll
            for (int m = 0; m < 4; ++m) { bf16_t* rowp = O + (size_t)(row0 + ai * HALF + m * 16) * FF + col0;
                const f32x4 g0 = acc[ai][0][m][0], g1 = acc[ai][0][m][1], u0 = acc[ai][1][m][0], u1 = acc[ai][1][m][1];
                u32x4 w; w.x = cvt_pk_bf16(silu_fast(g0[0]) * u0[0], silu_fast(g0[1]) * u0[1]); w.y = cvt_pk_bf16(silu_fast(g0[2]) * u0[2], silu_fast(g0[3]) * u0[3]);
                w.z = cvt_pk_bf16(silu_fast(g1[0]) * u1[0], silu_fast(g1[1]) * u1[1]); w.w = cvt_pk_bf16(silu_fast(g1[2]) * u1[2], silu_fast(g1[3]) * u1[3]);
                *(u32x4*)rowp = w; }
    }
};
struct EpiSwigluI8 {
    typedef i32x4 AccT; static constexpr bool PERM = true, AFTER_DRAIN = false;
    bf16_t* O; const float* sa; const float* sb; float* rmaxp; unsigned char* O8;
    __device__ __forceinline__ void operator()(const i32x4 (&acc)[2][2][4][2], const Unit& u, int wr, int wc, int fr, int fq) const {
        const int row0 = u.pm * BM + wr * 64 + fr, col0 = u.pn * HALF + wc * 32 + 8 * fq, brow = u.pn * BM + wc * 32 + 8 * fq;
        const f32x4 sg0 = *(const f32x4*)(sb + brow), sg1 = *(const f32x4*)(sb + brow + 4), su0 = *(const f32x4*)(sb + brow + HALF), su1 = *(const f32x4*)(sb + brow + HALF + 4);
#pragma unroll
        for (int ai = 0; ai < 2; ++ai)
#pragma unroll
            for (int m = 0; m < 4; ++m) { const int row = row0 + ai * HALF + m * 16; const float sr = sa[row]; bf16_t* rowp = O + (size_t)row * FF + col0;
                const i32x4 g0 = acc[ai][0][m][0], g1 = acc[ai][0][m][1], u0 = acc[ai][1][m][0], u1 = acc[ai][1][m][1];
                float o[8];
#pragma unroll
                for (int e = 0; e < 4; ++e) { o[e] = silu_fast((float)g0[e] * (sr * sg0[e])) * ((float)u0[e] * (sr * su0[e])); o[4 + e] = silu_fast((float)g1[e] * (sr * sg1[e])) * ((float)u1[e] * (sr * su1[e])); }
                float mx = fmaxf(fmaxf(fmaxf(fabsf(o[0]), fabsf(o[1])), fmaxf(fabsf(o[2]), fabsf(o[3]))), fmaxf(fmaxf(fabsf(o[4]), fabsf(o[5])), fmaxf(fabsf(o[6]), fabsf(o[7]))));
                mx = x32_max(x16_max(mx));
                if (u.pm < MP / BM) {
                    const float inv = 127.0f / fmaxf(mx, 1e-30f); unsigned b[8];
#pragma unroll
                    for (int e = 0; e < 8; ++e) b[e] = __float_as_uint(__builtin_fmaf(o[e], inv, 12583040.0f));
                    u32x2 w8; w8.x = __builtin_amdgcn_perm(b[1], b[0], 0x0c0c0400u) | __builtin_amdgcn_perm(b[3], b[2], 0x04000c0cu); w8.y = __builtin_amdgcn_perm(b[5], b[4], 0x0c0c0400u) | __builtin_amdgcn_perm(b[7], b[6], 0x04000c0cu);
                    *(u32x2*)(O8 + (size_t)row * FF + col0) = w8;
                    if (fq == 0) rmaxp[(size_t)row * 176 + u.pn * 4 + wc] = mx;
                } else { u32x4 w; w.x = cvt_pk_bf16(o[0], o[1]); w.y = cvt_pk_bf16(o[2], o[3]); w.z = cvt_pk_bf16(o[4], o[5]); w.w = cvt_pk_bf16(o[6], o[7]); *(u32x4*)rowp = w; } }
    }
};
struct EpiResid {
    typedef f32x4 AccT; static constexpr bool PERM = false, AFTER_DRAIN = false;
    const float* base_p; const float* base_s; float* out; const float* gate; float scale;
    __device__ __forceinline__ void operator()(const f32x4 (&acc)[2][2][4][2], const Unit& u, int wr, int wc, int fr, int fq) const {
        const int col0 = u.pn * BM + wc * 32 + 4 * fq;
#pragma unroll
        for (int ai = 0; ai < 2; ++ai)
#pragma unroll
            for (int m = 0; m < 4; ++m) { const int row = u.pm * BM + ai * HALF + wr * 64 + m * 16 + fr;
                const float* bp = (row < MP ? base_p + (size_t)row * D : base_s + (size_t)(row - MP) * D) + col0;
                const float* gp = gate + (size_t)row_bm(row) * NMOD + col0; float* op = out + (size_t)row * D + col0;
#pragma unroll
                for (int bj = 0; bj < 2; ++bj)
#pragma unroll
                    for (int n = 0; n < 2; ++n) { const int o = bj * HALF + n * 16; const f32x4 bs = *(const f32x4*)(bp + o), g = *(const f32x4*)(gp + o);
                        *(f32x4*)(op + o) = bs + (g * scale) * acc[ai][bj][m][n]; } }
    }
};
template <bool BB, bool OB> struct EpiResidT {
    typedef f32x4 AccT; static constexpr bool PERM = false, AFTER_DRAIN = false;
    const void* base; void* out; const float* gate; float scale;
    __device__ __forceinline__ void operator()(const f32x4 (&acc)[2][2][4][2], const Unit& u, int wr, int wc, int fr, int fq) const {
        const int col0 = u.pn * BM + wc * 32 + 4 * fq, row0 = u.pm * BM + wr * 64 + fr;
        const float* gp = gate + (size_t)(u.pm >> 3) * NMOD + col0;
#pragma unroll
        for (int bj = 0; bj < 2; ++bj)
#pragma unroll
            for (int n = 0; n < 2; ++n) { const int o = bj * HALF + n * 16; const f32x4 gs = *(const f32x4*)(gp + o) * scale;
#pragma unroll
                for (int ai = 0; ai < 2; ++ai) { f32x4 bs[4];
#pragma unroll
                    for (int m = 0; m < 4; ++m) { const size_t off = (size_t)(row0 + ai * HALF + m * 16) * D + col0 + o;
                        if (BB) { const u32x2 w = *(const u32x2*)((const bf16_t*)base + off); bs[m][0] = bflo(w.x); bs[m][1] = bfhi(w.x); bs[m][2] = bflo(w.y); bs[m][3] = bfhi(w.y); }
                        else bs[m] = *(const f32x4*)((const float*)base + off); }
#pragma unroll
                    for (int m = 0; m < 4; ++m) { const size_t off = (size_t)(row0 + ai * HALF + m * 16) * D + col0 + o; const f32x4 v = bs[m] + gs * acc[ai][bj][m][n];
                        if (OB) { u32x2 w; w.x = cvt_pk_bf16(v[0], v[1]); w.y = cvt_pk_bf16(v[2], v[3]); *(u32x2*)((bf16_t*)out + off) = w; }
                        else *(f32x4*)((float*)out + off) = v; }
                    asm volatile("" ::: "memory"); } }
    }
};
template <bool BB, bool OB> struct EpiResidI8T {
    typedef i32x4 AccT; static constexpr bool PERM = false, AFTER_DRAIN = false;
    const void* base; void* out; const float* gate; float scale; const float* sa; const float* sb;
    __device__ __forceinline__ void operator()(const i32x4 (&acc)[2][2][4][2], const Unit& u, int wr, int wc, int fr, int fq) const {
        const int col0 = u.pn * BM + wc * 32 + 4 * fq, row0 = u.pm * BM + wr * 64 + fr;
        const float* gp = gate + (size_t)(u.pm >> 3) * NMOD + col0;
        float sr[2][4];
#pragma unroll
        for (int ai = 0; ai < 2; ++ai)
#pragma unroll
            for (int m = 0; m < 4; ++m) sr[ai][m] = sa[row0 + ai * HALF + m * 16] * scale;
#pragma unroll
        for (int bj = 0; bj < 2; ++bj)
#pragma unroll
            for (int n = 0; n < 2; ++n) { const int o = bj * HALF + n * 16; const f32x4 gs = *(const f32x4*)(sb + col0 + o) * *(const f32x4*)(gp + o);
#pragma unroll
                for (int ai = 0; ai < 2; ++ai) { f32x4 bs[4];
#pragma unroll
                    for (int m = 0; m < 4; ++m) { const size_t off = (size_t)(row0 + ai * HALF + m * 16) * D + col0 + o;
                        if (BB) { const u32x2 w = *(const u32x2*)((const bf16_t*)base + off); bs[m][0] = bflo(w.x); bs[m][1] = bfhi(w.x); bs[m][2] = bflo(w.y); bs[m][3] = bfhi(w.y); }
                        else bs[m] = *(const f32x4*)((const float*)base + off); }
#pragma unroll
                    for (int m = 0; m < 4; ++m) { const size_t off = (size_t)(row0 + ai * HALF + m * 16) * D + col0 + o; const i32x4 a = acc[ai][bj][m][n];
                        f32x4 v; v[0] = (float)a[0]; v[1] = (float)a[1]; v[2] = (float)a[2]; v[3] = (float)a[3];
                        v = bs[m] + (gs * sr[ai][m]) * v;
                        if (OB) { u32x2 w; w.x = cvt_pk_bf16(v[0], v[1]); w.y = cvt_pk_bf16(v[2], v[3]); *(u32x2*)((bf16_t*)out + off) = w; }
                        else *(f32x4*)((float*)out + off) = v; }
                    asm volatile("" ::: "memory"); } }
    }
};
struct SplitOrder {
    int NS, G, c;
    __device__ __forceinline__ bool next(int i, Unit& u) const { const int L = i * G + c; if (L >= 16 * NS) return false; const int tile = L / NS; u.pk = L - tile * NS; u.pm = 64 + (tile >> 3); u.pn = tile & 7; return true; }
    __device__ __forceinline__ void a_ready(const Unit&) const {}
    __device__ __forceinline__ void done(const Unit&) const {}
};
struct EpiSlab {
    typedef f32x4 AccT; static constexpr bool PERM = false, AFTER_DRAIN = false;
    float* slab;
    __device__ __forceinline__ void operator()(const f32x4 (&acc)[2][2][4][2], const Unit& u, int wr, int wc, int fr, int fq) const {
        const int col0 = u.pn * BM + wc * 32 + 4 * fq;
#pragma unroll
        for (int ai = 0; ai < 2; ++ai)
#pragma unroll
            for (int m = 0; m < 4; ++m) { const int row = (u.pm - 64) * BM + ai * HALF + wr * 64 + m * 16 + fr; float* op = slab + ((size_t)u.pk * MS + row) * D + col0;
#pragma unroll
                for (int bj = 0; bj < 2; ++bj)
#pragma unroll
                    for (int n = 0; n < 2; ++n) *(f32x4*)(op + bj * HALF + n * 16) = acc[ai][bj][m][n]; }
    }
};
struct EpiProj {
    typedef f32x4 AccT; static constexpr bool PERM = true, AFTER_DRAIN = false;
    bf16_t* PROJ; float* SMALL;
    __device__ __forceinline__ void operator()(const f32x4 (&acc)[2][2][4][2], const Unit& u, int wr, int wc, int fr, int fq) const {
        const int row0 = u.pm * BM + wr * 64 + fr;
        if (u.pn < 24) {
            const int col0 = u.pn * BM + wc * 32 + 8 * fq;
#pragma unroll
            for (int ai = 0; ai < 2; ++ai)
#pragma unroll
                for (int m = 0; m < 4; ++m) { bf16_t* rowp = PROJ + (size_t)(row0 + ai * HALF + m * 16) * PROJ_LD + col0;
#pragma unroll
                    for (int bj = 0; bj < 2; ++bj) { const f32x4 v0 = acc[ai][bj][m][0], v1 = acc[ai][bj][m][1];
                        u32x4 w; w.x = cvt_pk_bf16(v0[0], v0[1]); w.y = cvt_pk_bf16(v0[2], v0[3]); w.z = cvt_pk_bf16(v1[0], v1[1]); w.w = cvt_pk_bf16(v1[2], v1[3]);
                        *(u32x4*)(rowp + bj * HALF) = w; } }
        } else {
            const int col0 = wc * 32 + 8 * fq;
#pragma unroll
            for (int ai = 0; ai < 2; ++ai)
#pragma unroll
                for (int m = 0; m < 4; ++m) { float* rowp = SMALL + (size_t)(row0 + ai * HALF + m * 16) * SMALL_LD + col0;
                    *(f32x4*)rowp = acc[ai][0][m][0]; *(f32x4*)(rowp + 4) = acc[ai][0][m][1]; }
        }
    }
};

template <class T> struct Mma16;
template <> struct Mma16<f32x4> { static __device__ __forceinline__ f32x4 op(bf16x8 a, bf16x8 b, f32x4 c) { return __builtin_amdgcn_mfma_f32_16x16x32_bf16(a, b, c, 0, 0, 0); } };
template <> struct Mma16<i32x4> { static __device__ __forceinline__ i32x4 op(bf16x8 a, bf16x8 b, i32x4 c) { return __builtin_amdgcn_mfma_i32_16x16x64_i8(__builtin_bit_cast(i32x4, a), __builtin_bit_cast(i32x4, b), c, 0, 0, 0); } };
template <class Epi, class Sched, bool ALIGN_EPI = false, bool SP2 = false>
__device__ __forceinline__ void gemm_phase(PG8_LAS unsigned char* lds, const Gemm g, const Sched& S, const Epi& E) {
    int tid = threadIdx.x; asm volatile("" : "+v"(tid));
    const int wid = __builtin_amdgcn_readfirstlane(tid >> 6), lane = tid & 63, wr = wid >> 2, wc = wid & 3, fr = lane & 15, fq = lane >> 4;
    const int K = g.K, nt = g.KL / BK; const size_t kslice = (size_t)g.KL * 2;
    unsigned voffA[2], voffB[2];
#pragma unroll
    for (int i = 0; i < 2; ++i) { int R, C; stage_rc(tid * 16 + i * 8192, R, C); const int Rb = Epi::PERM ? ((R & ~31) + perm32(R & 31)) : R;
        voffA[i] = (unsigned)(R * K + C) * 2u; voffB[i] = (unsigned)(Rb * K + C) * 2u; }
    const size_t kstep = (size_t)(BK * 2);
    const size_t hstep = (size_t)HALF * K * 2;
    const size_t tstep = 2 * hstep;
    const unsigned ldsw = (unsigned)wid * 1024u;
    const int aoff = lds_byte(wr * 64 + fr, fq * 8), boff = lds_byte(wc * 32 + fr, fq * 8);
#define PG8_SA(b, h) (((b) * 2 + (h)) * HTB)
#define PG8_SB(b, h) ((4 + (b) * 2 + (h)) * HTB)
#define PG8_STAGE(bufoff, gbase, voff) do { _Pragma("unroll") for (int _i = 0; _i < 2; ++_i) \
        __builtin_amdgcn_global_load_lds((const unsigned*)((const char*)(gbase) + (voff)[_i]), (PG8_LAS unsigned*)(lds + (bufoff) + ldsw + _i * 8192), 16, 0, 0); } while (0)
#define PG8_LDA(dst, b, h) do { _Pragma("unroll") for (int m = 0; m < 4; ++m) _Pragma("unroll") for (int k = 0; k < 2; ++k) dst[m][k] = *(const PG8_LAS bf16x8*)(lds + PG8_SA(b, h) + aoff + m * 2048 + k * 1024); } while (0)
#define PG8_LDB(dst, b, h) do { _Pragma("unroll") for (int n = 0; n < 2; ++n) _Pragma("unroll") for (int k = 0; k < 2; ++k) dst[n][k] = *(const PG8_LAS bf16x8*)(lds + PG8_SB(b, h) + boff + n * 2048 + k * 1024); } while (0)
#define PG8_MMA(ai, bj, At, Bt) do { __builtin_amdgcn_s_setprio(1); _Pragma("unroll") for (int m = 0; m < 4; ++m) _Pragma("unroll") for (int n = 0; n < 2; ++n) _Pragma("unroll") for (int k = 0; k < 2; ++k) \
        acc[ai][bj][m][n] = Mma16<AccT>::op(Bt[n][k], At[m][k], acc[ai][bj][m][n]); __builtin_amdgcn_s_setprio(0); } while (0)
#define PG8_WAIT_V(n) asm volatile("s_waitcnt vmcnt(" #n ")" ::: "memory")
#define PG8_WAIT_L(n) asm volatile("s_waitcnt lgkmcnt(" #n ")" ::: "memory")
#define PG8_BAR __builtin_amdgcn_s_barrier()
#define PG8_SCHED __builtin_amdgcn_sched_barrier(0)
    Unit cur, nxt; int ui = 0;
    if (!S.next(0, cur)) return;
    typedef typename Epi::AccT AccT; AccT acc[2][2][4][2];
#pragma unroll
    for (int a = 0; a < 2; ++a)
#pragma unroll
        for (int b = 0; b < 2; ++b)
#pragma unroll
            for (int m = 0; m < 4; ++m)
#pragma unroll
                for (int n = 0; n < 2; ++n) acc[a][b][m][n] = AccT{};
    bf16x8 At[4][2], B0[2][2], B1[2][2];
    const char* cA = (const char*)g.A + (size_t)cur.pm * tstep + (size_t)cur.pk * kslice; const char* cB = (const char*)g.Bt + (size_t)cur.pn * tstep + (size_t)cur.pk * kslice;
    S.a_ready(cur);
    if constexpr (SP2) {
        PG8_STAGE(PG8_SB(0, 0), cB, voffB); PG8_STAGE(PG8_SB(0, 1), cB + hstep, voffB); PG8_STAGE(PG8_SA(0, 0), cA, voffA); PG8_STAGE(PG8_SA(0, 1), cA + hstep, voffA);
        if (wr == 1) PG8_BAR;
        PG8_WAIT_V(2); PG8_BAR;
        PG8_STAGE(PG8_SB(1, 0), cB + kstep, voffB); PG8_STAGE(PG8_SA(1, 0), cA + kstep, voffA); PG8_STAGE(PG8_SB(1, 1), cB + hstep + kstep, voffB);
        PG8_WAIT_V(6); PG8_BAR;
    } else {
        PG8_STAGE(PG8_SB(0, 0), cB, voffB); PG8_STAGE(PG8_SA(0, 0), cA, voffA); PG8_STAGE(PG8_SB(0, 1), cB + hstep, voffB); PG8_STAGE(PG8_SA(0, 1), cA + hstep, voffA);
        if (wr == 1) PG8_BAR;
        PG8_WAIT_V(4); PG8_BAR;
        PG8_STAGE(PG8_SB(1, 0), cB + kstep, voffB); PG8_STAGE(PG8_SA(1, 0), cA + kstep, voffA); PG8_STAGE(PG8_SB(1, 1), cB + hstep + kstep, voffB);
        PG8_WAIT_V(6); PG8_BAR;
    }
    for (;;) {
        const bool has_next = S.next(ui + 1, nxt);
        const char* nA = has_next ? (const char*)g.A + (size_t)nxt.pm * tstep + (size_t)nxt.pk * kslice : cA; const char* nB = has_next ? (const char*)g.Bt + (size_t)nxt.pn * tstep + (size_t)nxt.pk * kslice : cB;
        for (int t = 0; t < nt; t += 2) {
            const bool last = (t == nt - 2);
            const char* a1 = cA + (size_t)(t + 1) * kstep;
            const char* a2 = last ? nA : cA + (size_t)(t + 2) * kstep; const char* b2 = last ? nB : cB + (size_t)(t + 2) * kstep;
            const char* a3 = a2 + kstep; const char* b3 = b2 + kstep;
            if (last && has_next) S.a_ready(nxt);
            if constexpr (SP2) {
            PG8_LDB(B0, 0, 0); PG8_LDB(B1, 0, 1); PG8_SCHED; PG8_LDA(At, 0, 0); PG8_STAGE(PG8_SA(1, 1), a1 + hstep, voffA);
            PG8_WAIT_V(8); PG8_WAIT_L(0); PG8_BAR; PG8_MMA(0, 0, At, B0); PG8_MMA(0, 1, At, B1); PG8_BAR; PG8_SCHED;
            PG8_LDA(At, 0, 1); PG8_STAGE(PG8_SB(0, 0), b2, voffB); PG8_STAGE(PG8_SB(0, 1), b2 + hstep, voffB); PG8_STAGE(PG8_SA(0, 0), a2, voffA);
            PG8_WAIT_V(8); PG8_WAIT_L(0); PG8_BAR; PG8_MMA(1, 0, At, B0); PG8_MMA(1, 1, At, B1); PG8_BAR; PG8_SCHED;
            PG8_LDB(B0, 1, 0); PG8_LDB(B1, 1, 1); PG8_SCHED; PG8_LDA(At, 1, 0); PG8_STAGE(PG8_SA(0, 1), a2 + hstep, voffA);
            PG8_WAIT_V(8); PG8_WAIT_L(0); PG8_BAR; PG8_MMA(0, 0, At, B0); PG8_MMA(0, 1, At, B1); PG8_BAR; PG8_SCHED;
            PG8_LDA(At, 1, 1); PG8_STAGE(PG8_SB(1, 0), b3, voffB); PG8_STAGE(PG8_SB(1, 1), b3 + hstep, voffB); PG8_STAGE(PG8_SA(1, 0), a3, voffA);
            PG8_WAIT_V(8); PG8_WAIT_L(0); PG8_BAR; PG8_MMA(1, 0, At, B0); PG8_MMA(1, 1, At, B1); PG8_BAR; PG8_SCHED;
            } else {
            PG8_LDB(B0, 0, 0); PG8_SCHED; PG8_LDA(At, 0, 0); PG8_STAGE(PG8_SA(1, 1), a1 + hstep, voffA);
            PG8_WAIT_L(8); PG8_BAR; PG8_WAIT_L(0); PG8_MMA(0, 0, At, B0); PG8_BAR; PG8_SCHED;
            PG8_LDB(B1, 0, 1); PG8_STAGE(PG8_SB(0, 0), b2, voffB);
            PG8_BAR; PG8_WAIT_L(0); PG8_MMA(0, 1, At, B1); PG8_BAR;
            PG8_LDA(At, 0, 1); PG8_STAGE(PG8_SA(0, 0), a2, voffA);
            PG8_BAR; PG8_WAIT_L(0); PG8_MMA(1, 0, At, B0); PG8_BAR; PG8_SCHED;
            PG8_STAGE(PG8_SB(0, 1), b2 + hstep, voffB);
            PG8_WAIT_V(6); PG8_BAR; PG8_MMA(1, 1, At, B1); PG8_BAR;
            PG8_LDB(B0, 1, 0); PG8_SCHED; PG8_LDA(At, 1, 0); PG8_STAGE(PG8_SA(0, 1), a2 + hstep, voffA);
            PG8_WAIT_L(8); PG8_BAR; PG8_WAIT_L(0); PG8_MMA(0, 0, At, B0); PG8_BAR; PG8_SCHED;
            PG8_LDB(B1, 1, 1); PG8_STAGE(PG8_SB(1, 0), b3, voffB);
            PG8_BAR; PG8_WAIT_L(0); PG8_MMA(0, 1, At, B1); PG8_BAR;
            PG8_LDA(At, 1, 1); PG8_STAGE(PG8_SA(1, 0), a3, voffA);
            PG8_BAR; PG8_WAIT_L(0); PG8_MMA(1, 0, At, B0); PG8_BAR; PG8_SCHED;
            PG8_STAGE(PG8_SB(1, 1), b3 + hstep, voffB);
            PG8_WAIT_V(6); PG8_BAR; PG8_MMA(1, 1, At, B1); PG8_BAR;
            }
        }
        if constexpr (ALIGN_EPI) { if (wr == 0) PG8_BAR; }
        if constexpr (!Epi::AFTER_DRAIN) { E(acc, cur, wr, wc, fr, fq); S.done(cur); }
        if (!has_next) break;
#pragma unroll
        for (int a = 0; a < 2; ++a)
#pragma unroll
            for (int b = 0; b < 2; ++b)
#pragma unroll
                for (int m = 0; m < 4; ++m)
#pragma unroll
                    for (int n = 0; n < 2; ++n) acc[a][b][m][n] = AccT{};
        cur = nxt; cA = nA; cB = nB; ++ui;
        if constexpr (ALIGN_EPI) { if (wr == 1) PG8_BAR; }
    }
    PG8_WAIT_V(0);
    if constexpr (!ALIGN_EPI) { if (wr == 0) PG8_BAR; }
    PG8_BAR;
    if constexpr (Epi::AFTER_DRAIN) { E.fused(acc, cur, wr, wc, fr, fq, lds, wid, lane); S.done(cur); }
#undef PG8_SA
#undef PG8_SB
#undef PG8_STAGE
#undef PG8_LDA
#undef PG8_LDB
#undef PG8_MMA
#undef PG8_WAIT_V
#undef PG8_WAIT_L
#undef PG8_BAR
#undef PG8_SCHED
}
}

#define PG8_SP2 true
#define PG8_ALIGN true

#define XB_TMO      128
#define XB_XCNT(j)  (256  + 64 * (j))
#define XB_XSUB(j)  (1280 + 64 * (j))
#define XB_XGEN(j)  (2304 + 64 * (j))
#define XB_TOP      3328
#define XB_TOPGEN   3392
#define XCD_BAR_WORDS 3456
#define XB_SPIN_CAP (1u << 18)
#define LAS __attribute__((address_space(3)))

__device__ __forceinline__ unsigned xb_ld(unsigned* p)              { return __hip_atomic_load(p, __ATOMIC_RELAXED, __HIP_MEMORY_SCOPE_AGENT); }
__device__ __forceinline__ unsigned xb_add(unsigned* p, unsigned v) { return __hip_atomic_fetch_add(p, v, __ATOMIC_RELAXED, __HIP_MEMORY_SCOPE_AGENT); }
__device__ __forceinline__ unsigned xb_xcc_id() { return (unsigned)__builtin_amdgcn_s_getreg((3 << 11) | 20) & 0xFu; }
#define XB_SPIN(cond, bar) do { unsigned _sp = 0; while (cond) { __builtin_amdgcn_s_sleep(1); \
    if ((++_sp & 255u) == 0u) { if (xb_ld(&(bar)[XB_TMO])) break; if (_sp > XB_SPIN_CAP) { atomicAdd(&(bar)[XB_TMO], 1u); break; } } } } while (0)

struct XcdBarrier {
    unsigned* bar; unsigned x;
    volatile LAS unsigned* st;
};

__device__ __forceinline__ XcdBarrier xcd_barrier_post(unsigned* bar, volatile LAS unsigned* st) {
    XcdBarrier b; b.bar = bar; b.x = xb_xcc_id(); b.st = st;
    if (threadIdx.x == 0) (void)xb_add(&bar[XB_XCNT(b.x)], 1u);
    return b;
}
__device__ __forceinline__ void xcd_barrier_complete(unsigned* bar, unsigned x, unsigned& nloc, unsigned& nx) {
    const unsigned G = gridDim.x * gridDim.y * gridDim.z;
    unsigned sum, cnt, mine, sp = 0u;
    for (;;) {
        sum = 0u; cnt = 0u; mine = 0u;
#pragma unroll
        for (unsigned j = 0; j < 16; ++j) { const unsigned c = xb_ld(&bar[XB_XCNT(j)]); sum += c; cnt += (c > 0u) ? 1u : 0u; mine = (j == x) ? c : mine; }
        if (sum == G) break;
        __builtin_amdgcn_s_sleep(1);
        if ((++sp & 255u) == 0u) { if (xb_ld(&bar[XB_TMO])) break; if (sp > XB_SPIN_CAP) { atomicAdd(&bar[XB_TMO], 1u); break; } }
    }
    nloc = mine > 0u ? mine : 1u; nx = cnt > 0u ? cnt : 1u;
}

__device__ __forceinline__ void xcd_barrier(const XcdBarrier& b) {
    asm volatile("s_waitcnt vmcnt(0)" ::: "memory");
    __syncthreads();
    if (threadIdx.x == 0) {
        unsigned* bar = b.bar;
        __builtin_amdgcn_s_waitcnt(0);
        unsigned nloc = b.st[0], nx = b.st[1];
        if (nloc == 0u) { xcd_barrier_complete(bar, b.x, nloc, nx); b.st[0] = nloc; b.st[1] = nx; }
        const unsigned old = xb_add(&bar[XB_XSUB(b.x)], 1u);
        const unsigned gen = old / nloc;
        if (old + 1u == (gen + 1u) * nloc) {
            __builtin_amdgcn_fence(__ATOMIC_RELEASE, "agent");
            asm volatile("s_waitcnt vmcnt(0)" ::: "memory");
            const unsigned og = xb_add(&bar[XB_TOP], 1u);
            const unsigned tg = og / nx;
            if (og + 1u == (tg + 1u) * nx) xb_add(&bar[XB_TOPGEN], 1u);
            else XB_SPIN(xb_ld(&bar[XB_TOPGEN]) == tg, bar);
            __builtin_amdgcn_fence(__ATOMIC_ACQUIRE, "agent");
            xb_add(&bar[XB_XGEN(b.x)], 1u);
            asm volatile("s_waitcnt vmcnt(0)" ::: "memory");
        } else {
            XB_SPIN(xb_ld(&bar[XB_XGEN(b.x)]) == gen, bar);
            __builtin_amdgcn_fence(__ATOMIC_ACQUIRE, "agent");
            asm volatile("s_waitcnt vmcnt(0)" ::: "memory");
        }
    }
    __syncthreads();
}


constexpr int RING_OFF = 0, RING_BYTES = 131072, LDSCTL_OFF = 146432, MISC_OFF = LDSCTL_OFF + 320, LDS_BYTES = 147456;
constexpr int CW_BAR = 4096;
constexpr size_t CTL_CMAX = 65536;
constexpr size_t CTL_ZERO_BYTES = 1u << 20;
#define LDS_WAIT() asm volatile("s_waitcnt lgkmcnt(0)" ::: "memory")
typedef short bf16x8_t __attribute__((ext_vector_type(8)));
using pg8::cvt_pk_bf16;

__device__ __forceinline__ void tr_item(const float* colp, int ld, bf16_t* WT, int K, int k0, int n0, LAS float* scr, int lane, unsigned* cmaxp = nullptr) {
    float tv[32];
#pragma unroll
    for (int i = 0; i < 32; ++i) { const int kk = 2 * i + (lane >> 5); tv[i] = colp ? colp[(size_t)(k0 + kk) * ld] : 0.f; }
    if (cmaxp) { float mx = 0.f;
#pragma unroll
        for (int i = 0; i < 32; ++i) mx = fmaxf(mx, fabsf(tv[i]));
        mx = fmaxf(mx, __shfl_xor(mx, 32));
        if (lane < 32) atomicMax(cmaxp + n0 + lane, __float_as_uint(mx)); }
#pragma unroll
    for (int i = 0; i < 32; ++i) { const int kk = 2 * i + (lane >> 5); scr[kk * 33 + (lane & 31)] = tv[i]; }
    LDS_WAIT(); asm volatile("" ::: "memory");
    const int c = lane & 7;
#pragma unroll
    for (int j = 0; j < 4; ++j) { const int n = (lane >> 3) + 8 * j; const LAS float* s = scr + (8 * c) * 33 + n;
        u32x4 o; o.x = pk2(s[0 * 33], s[1 * 33]); o.y = pk2(s[2 * 33], s[3 * 33]); o.z = pk2(s[4 * 33], s[5 * 33]); o.w = pk2(s[6 * 33], s[7 * 33]);
        *(u32x4*)(WT + (size_t)(n0 + n) * K + k0 + 8 * c) = o; }
    LDS_WAIT(); asm volatile("" ::: "memory");
}
constexpr int IT_GU = 32 * 352, IT_D = 88 * 64, IT_IN = 32 * 200, IT_OUT = 32 * 64, IT_ALL = 2 * IT_GU + 2 * IT_D + IT_IN + IT_OUT;
__device__ __forceinline__ void convert_item(const Ptrs& p, int it, LAS float* scr, int lane) {
    int r = it; const int ln = lane & 31;
#pragma unroll
    for (int which = 0; which < 2; ++which) {
        if (r < IT_GU) { const int kb = r / 352, q32 = r % 352, n = 32 * q32 + ln, pn = n >> 8, rr = n & 255;
            const float* src = rr < 128 ? (which ? p.f2_wg : p.f1_wg) : (which ? p.f2_wu : p.f1_wu);
            tr_item(src + 128 * pn + (rr & 127), FF, (bf16_t*)(p.WS() + (which ? WS_W2GU : WS_W1GU)), D, 64 * kb, 32 * q32, scr, lane, (unsigned*)(p.WS() + WS_CTL + CTL_CMAX) + which * 2 * FF); return; }
        r -= IT_GU;
        if (r < IT_D) { const int kb = r / 64, q32 = r % 64;
            tr_item((which ? p.f2_wd : p.f1_wd) + 32 * q32 + ln, D, (bf16_t*)(p.WS() + (which ? WS_W2D : WS_W1D)), FF, 64 * kb, 32 * q32, scr, lane, (unsigned*)(p.WS() + WS_CTL + CTL_CMAX) + 4 * FF + which * D); return; }
        r -= IT_D;
    }
    if (r < IT_IN) { const int kb = r / 200, q32 = r % 200, n = 32 * q32 + ln; int col;
        if (n < 4096) col = n; else if (n < 6144) col = n + 8; else { const int j = n - 6144; col = j < 64 ? 6152 + j : j < 72 ? 4096 + (j - 64) : j < 80 ? 6216 + (j - 72) : -1; }
        tr_item(col >= 0 ? p.w_in + col : nullptr, PW, (bf16_t*)(p.WS() + WS_WIN), D, 64 * kb, 32 * q32, scr, lane); return; }
    r -= IT_IN;
    { const int kb = r / 64, q32 = r % 64; tr_item(p.w_out + 32 * q32 + ln, D, (bf16_t*)(p.WS() + WS_WOUT), D, 64 * kb, 32 * q32, scr, lane); }
}
constexpr int MW_PITCH = 528;
template <int MT0, int NMT> __device__ __forceinline__ void mods_wg_body(const Ptrs& p, LAS unsigned char* lds, const int slab, const int tid) {
    const int lane = tid & 63, r = lane & 15, q = lane >> 4, n0 = 32 * slab;
    f32x4 acc[NMT][2];
#pragma unroll
    for (int mt = 0; mt < NMT; ++mt) { acc[mt][0] = (f32x4){0.f, 0.f, 0.f, 0.f}; acc[mt][1] = (f32x4){0.f, 0.f, 0.f, 0.f}; }
    const float* wp = p.w_ada + n0 + r + (size_t)(8 * q) * NMOD;
    float ring[4][2][8];
#define MW_LOADW(slot_, g_) do { _Pragma("unroll") for (int nt = 0; nt < 2; ++nt) _Pragma("unroll") for (int j = 0; j < 8; ++j) ring[slot_][nt][j] = wp[(size_t)(32 * (g_) + j) * NMOD + 16 * nt]; } while (0)
    MW_LOADW(0, 0); MW_LOADW(1, 1); MW_LOADW(2, 2); MW_LOADW(3, 3);
    for (int c = 0; c < 8; ++c) {
        f32x4 cv[17];
#pragma unroll
        for (int i = 0; i < 17; ++i) { const int e = tid + 512 * i, row = e >> 6, c4 = e & 63;
            cv[i] = *(const f32x4*)((row < BP ? p.c_p + (size_t)row * D : p.c_s + (size_t)(row - BP) * D) + 256 * c + 4 * c4); }
        __syncthreads();
#pragma unroll
        for (int i = 0; i < 17; ++i) { const int e = tid + 512 * i, row = e >> 6, c4 = e & 63; u32x2 w; w.x = cvt_pk_bf16(cv[i][0], cv[i][1]); w.y = cvt_pk_bf16(cv[i][2], cv[i][3]);
            *(LAS u32x2*)(lds + row * MW_PITCH + c4 * 8) = w; }
        if (tid < 8 * 64) { const int row = 136 + (tid >> 6), c4 = tid & 63; u32x2 z; z.x = 0u; z.y = 0u; *(LAS u32x2*)(lds + row * MW_PITCH + c4 * 8) = z; }
        __syncthreads();
#pragma unroll
        for (int s = 0; s < 8; ++s) {
            bf16x8_t bfr[2];
#pragma unroll
            for (int nt = 0; nt < 2; ++nt) { const float* v = ring[s & 3][nt]; u32x4 w; w.x = cvt_pk_bf16(v[0], v[1]); w.y = cvt_pk_bf16(v[2], v[3]); w.z = cvt_pk_bf16(v[4], v[5]); w.w = cvt_pk_bf16(v[6], v[7]); bfr[nt] = __builtin_bit_cast(bf16x8_t, w); }
            if (8 * c + s + 4 < 64) MW_LOADW(s & 3, 8 * c + s + 4);
            bf16x8_t afr[NMT];
#pragma unroll
            for (int mt = 0; mt < NMT; ++mt) afr[mt] = *(LAS const bf16x8_t*)(lds + (16 * (MT0 + mt) + r) * MW_PITCH + (32 * s + 8 * q) * 2);
            LDS_WAIT();
#pragma unroll
            for (int mt = 0; mt < NMT; ++mt) { acc[mt][0] = __builtin_amdgcn_mfma_f32_16x16x32_bf16(afr[mt], bfr[0], acc[mt][0], 0, 0, 0); acc[mt][1] = __builtin_amdgcn_mfma_f32_16x16x32_bf16(afr[mt], bfr[1], acc[mt][1], 0, 0, 0); }
        }
    }
#undef MW_LOADW
    float* MODS = (float*)(p.WS() + WS_MODS);
#pragma unroll
    for (int nt = 0; nt < 2; ++nt) { const int n = n0 + 16 * nt + r; const float bb = p.b_ada[n];
#pragma unroll
        for (int mt = 0; mt < NMT; ++mt)
#pragma unroll
            for (int i = 0; i < 4; ++i) { const int row = 16 * (MT0 + mt) + 4 * q + i; if (row < NB) MODS[(size_t)row * NMOD + n] = acc[mt][nt][i] + bb; } }
    __syncthreads();
}
template <int MT0, int NMT> __device__ __forceinline__ void mods_item_t(const Ptrs& p, const int slab, const int lane) {
    const int r = lane & 15, q = lane >> 4, n0 = 32 * slab;
    f32x4 acc[NMT][2];
#pragma unroll
    for (int mt = 0; mt < NMT; ++mt) { acc[mt][0] = (f32x4){0.f, 0.f, 0.f, 0.f}; acc[mt][1] = (f32x4){0.f, 0.f, 0.f, 0.f}; }
    const float* wp = p.w_ada + n0 + r + (size_t)(8 * q) * NMOD;
    const float* cp[NMT];
#pragma unroll
    for (int mt = 0; mt < NMT; ++mt) { int row = 16 * (MT0 + mt) + r; if (row > NB - 1) row = NB - 1; cp[mt] = (row < BP ? p.c_p + (size_t)row * D : p.c_s + (size_t)(row - BP) * D) + 8 * q; }
    const bool vlast = (16 * (MT0 + NMT - 1) + r) < NB;
    float bv[2][8]; f32x4 av[NMT][2];
#define MODS_LOAD(k0_) do { _Pragma("unroll") for (int nt = 0; nt < 2; ++nt) _Pragma("unroll") for (int j = 0; j < 8; ++j) bv[nt][j] = wp[(size_t)((k0_) + j) * NMOD + 16 * nt]; \
        _Pragma("unroll") for (int mt = 0; mt < NMT; ++mt) { av[mt][0] = *(const f32x4*)(cp[mt] + (k0_)); av[mt][1] = *(const f32x4*)(cp[mt] + (k0_) + 4); } } while (0)
    MODS_LOAD(0);
    for (int k0 = 0; k0 < D; k0 += 32) {
        bf16x8_t bfr[2], afr[NMT];
#pragma unroll
        for (int nt = 0; nt < 2; ++nt) { u32x4 w; w.x = cvt_pk_bf16(bv[nt][0], bv[nt][1]); w.y = cvt_pk_bf16(bv[nt][2], bv[nt][3]); w.z = cvt_pk_bf16(bv[nt][4], bv[nt][5]); w.w = cvt_pk_bf16(bv[nt][6], bv[nt][7]); bfr[nt] = __builtin_bit_cast(bf16x8_t, w); }
#pragma unroll
        for (int mt = 0; mt < NMT; ++mt) { f32x4 a0 = av[mt][0], a1 = av[mt][1]; if (mt == NMT - 1 && !vlast) { a0 = (f32x4){0.f, 0.f, 0.f, 0.f}; a1 = a0; }
            u32x4 w; w.x = cvt_pk_bf16(a0[0], a0[1]); w.y = cvt_pk_bf16(a0[2], a0[3]); w.z = cvt_pk_bf16(a1[0], a1[1]); w.w = cvt_pk_bf16(a1[2], a1[3]); afr[mt] = __builtin_bit_cast(bf16x8_t, w); }
        if (k0 + 32 < D) MODS_LOAD(k0 + 32);
#pragma unroll
        for (int mt = 0; mt < NMT; ++mt) { acc[mt][0] = __builtin_amdgcn_mfma_f32_16x16x32_bf16(afr[mt], bfr[0], acc[mt][0], 0, 0, 0); acc[mt][1] = __builtin_amdgcn_mfma_f32_16x16x32_bf16(afr[mt], bfr[1], acc[mt][1], 0, 0, 0); }
    }
#undef MODS_LOAD
    float* MODS = (float*)(p.WS() + WS_MODS);
#pragma unroll
    for (int nt = 0; nt < 2; ++nt) { const int n = n0 + 16 * nt + r; const float bb = p.b_ada[n];
#pragma unroll
        for (int mt = 0; mt < NMT; ++mt)
#pragma unroll
            for (int i = 0; i < 4; ++i) { const int row = 16 * (MT0 + mt) + 4 * q + i; if (row < NB) MODS[(size_t)row * NMOD + n] = acc[mt][nt][i] + bb; } }
}

template <int O0, int O1, int O2, int O3, int O4, int O5, int O6, int O7> __device__ __forceinline__ void tr_read8(u32x2 (&o)[8], const unsigned addr) {
    asm volatile("ds_read_b64_tr_b16 %0, %8 offset:%9\n\tds_read_b64_tr_b16 %1, %8 offset:%10\n\tds_read_b64_tr_b16 %2, %8 offset:%11\n\tds_read_b64_tr_b16 %3, %8 offset:%12\n\t"
                 "ds_read_b64_tr_b16 %4, %8 offset:%13\n\tds_read_b64_tr_b16 %5, %8 offset:%14\n\tds_read_b64_tr_b16 %6, %8 offset:%15\n\tds_read_b64_tr_b16 %7, %8 offset:%16\n\ts_waitcnt lgkmcnt(0)"
                 : "=&v"(o[0]), "=&v"(o[1]), "=&v"(o[2]), "=&v"(o[3]), "=&v"(o[4]), "=&v"(o[5]), "=&v"(o[6]), "=&v"(o[7])
                 : "v"(addr), "n"(O0), "n"(O1), "n"(O2), "n"(O3), "n"(O4), "n"(O5), "n"(O6), "n"(O7) : "memory");
}
__device__ __forceinline__ bf16x8_t frag2(const u32x2 a, const u32x2 b) { u32x4 v; v.x = a.x; v.y = a.y; v.z = b.x; v.w = b.y; return __builtin_bit_cast(bf16x8_t, v); }
constexpr int ML_QC = 0, ML_KC = 33792, ML_KW = 67584, ML_VR = 101376, ML_CB = 109056, ML_N = 142848, ML_SC = 144896, ML_END = 145920; __device__ __forceinline__ void mlstm_mfma_unit(const Ptrs& p, LAS unsigned char* lds, const int unit, const int tid) {
    const int lane = tid & 63, wv = __builtin_amdgcn_readfirstlane(tid >> 6), r = lane & 15, q = lane >> 4;
    const int bh = unit >> 3, sl = unit & 7, b = bh >> 2, h = bh & 3, e0 = 32 * sl;
    const bf16_t* QM = (const bf16_t*)(p.WS() + WS_QM); const bf16_t* KM = (const bf16_t*)(p.WS() + WS_KM); const bf16_t* PROJ = (const bf16_t*)(p.WS() + WS_PROJ);
    const float* BC = (const float*)(p.WS() + WS_BC) + (size_t)bh * 2048; const float* IG = (const float*)(p.WS() + WS_IG) + (size_t)bh * 2048; const float* MMa = (const float*)(p.WS() + WS_MM) + (size_t)bh * 2048;
    float* HM = (float*)(p.WS() + WS_HM);
    const int srow = tid >> 3, sd = (tid & 7) * 32, se = (tid & 7) * 4;
    LAS float* su = (LAS float*)(lds + ML_SC); LAS float* sv = su + 64; LAS float* ssw = su + 128; LAS float* smm = su + 192;
    for (int i = tid; i < 16896 / 4; i += 512) ((LAS unsigned*)(lds + ML_CB))[i] = 0u;
    if (tid < 256) ((LAS float*)(lds + ML_N))[tid] = 0.f;
    f32x4 accC[4][2];
#pragma unroll
    for (int k = 0; k < 4; ++k) { accC[k][0] = (f32x4){0.f, 0.f, 0.f, 0.f}; accC[k][1] = (f32x4){0.f, 0.f, 0.f, 0.f}; }
    u32x4 pq[4], pk[4]; u32x2 pv; float pbc, pig, pmm, pbL, pmL, pm0;
#define ML_PREFETCH(cc) do { const size_t rr_ = (size_t)b * 2048 + 64 * (cc) + srow; const bf16_t* qp_ = QM + rr_ * 1024 + h * 256 + sd; const bf16_t* kp_ = KM + rr_ * 1024 + h * 256 + sd; \
        _Pragma("unroll") for (int j_ = 0; j_ < 4; ++j_) { pq[j_] = *(const u32x4*)(qp_ + 8 * j_); pk[j_] = *(const u32x4*)(kp_ + 8 * j_); } \
        pv = *(const u32x2*)(PROJ + rr_ * PROJ_LD + PC_VM + h * 256 + e0 + se); pbc = BC[64 * (cc) + srow]; pig = IG[64 * (cc) + srow]; pmm = MMa[64 * (cc) + srow]; \
        pbL = BC[64 * (cc) + 63]; pmL = MMa[64 * (cc) + 63]; pm0 = (cc) ? MMa[64 * (cc) - 1] : 0.f; } while (0)
    ML_PREFETCH(0);
    for (int c = 0; c < 32; ++c) {
        const int cur = c & 1, nxt = cur ^ 1;
        const float bL = pbL, mL = pmL, m0 = pm0;
        {
            const float wl = __expf(bL - pbc + pig - mL);
#pragma unroll
            for (int j = 0; j < 4; ++j) { *(LAS u32x4*)(lds + ML_QC + srow * 528 + (sd + 8 * j) * 2) = pq[j]; *(LAS u32x4*)(lds + ML_KC + srow * 528 + (sd + 8 * j) * 2) = pk[j]; }
#pragma unroll
            for (int j = 0; j < 4; ++j) { u32x4 ws_;
#pragma unroll
                for (int e2 = 0; e2 < 4; ++e2) { const unsigned w = pk[j][e2]; ws_[e2] = cvt_pk_bf16(bflo(w) * wl, bfhi(w) * wl); }
                *(LAS u32x4*)(lds + ML_KW + srow * 528 + (sd + 8 * j) * 2) = ws_; }
            *(LAS u32x2*)(lds + ML_VR + srow * 96 + se * 2) = pv;
            if ((tid & 7) == 0) { su[srow] = pbc - pmm; sv[srow] = pig - pbc; ssw[srow] = __expf(pbc + m0 - pmm); smm[srow] = pmm; }
        }
        __syncthreads();
        if (c < 31) ML_PREFETCH(c + 1);
        if (wv < 4) {
            const int tt = wv; const size_t r0 = (size_t)b * 2048 + 64 * c;
            bf16x8_t qf[8];
            { LAS const unsigned char* qrow = lds + ML_QC + (16 * tt + r) * 528 + q * 16;
#pragma unroll
              for (int kk = 0; kk < 8; ++kk) qf[kk] = *(LAS const bf16x8_t*)(qrow + kk * 64); }
            const float ut = su[16 * tt + r]; float rs = 0.f; unsigned pw[4][2];
#pragma unroll
            for (int a = 0; a < 4; ++a) {
                if (a <= tt) {
                    LAS const unsigned char* krow = lds + ML_KC + (16 * a + r) * 528 + q * 16;
                    const f32x4 vs4 = *(LAS const f32x4*)(sv + 16 * a + 4 * q);
                    f32x4 S0 = (f32x4){0.f, 0.f, 0.f, 0.f}, S1 = S0;
#pragma unroll
                    for (int hf = 0; hf < 2; ++hf) { bf16x8_t kf[4];
#pragma unroll
                        for (int k4 = 0; k4 < 4; ++k4) kf[k4] = *(LAS const bf16x8_t*)(krow + (4 * hf + k4) * 64);
                        LDS_WAIT();
#pragma unroll
                        for (int k4 = 0; k4 < 4; k4 += 2) { S0 = __builtin_amdgcn_mfma_f32_16x16x32_bf16(kf[k4], qf[4 * hf + k4], S0, 0, 0, 0); S1 = __builtin_amdgcn_mfma_f32_16x16x32_bf16(kf[k4 + 1], qf[4 * hf + k4 + 1], S1, 0, 0, 0); } }
                    const f32x4 S = S0 + S1; float pe[4];
#pragma unroll
                    for (int i = 0; i < 4; ++i) { float x = S[i] * __expf(ut + vs4[i]); if (a == tt && (4 * q + i) > r) x = 0.f; pe[i] = x; rs += x; }
                    pw[a][0] = cvt_pk_bf16(pe[0], pe[1]); pw[a][1] = cvt_pk_bf16(pe[2], pe[3]);
                } else { pw[a][0] = 0u; pw[a][1] = 0u; }
            }
            rs = x32_sum(x16_sum(rs));
            u32x4 pf0, pf1; pf0.x = pw[0][0]; pf0.y = pw[0][1]; pf0.z = pw[1][0]; pf0.w = pw[1][1]; pf1.x = pw[2][0]; pf1.y = pw[2][1]; pf1.z = pw[3][0]; pf1.w = pw[3][1];
            f32x4 accn[2], accq[2];
            u32x2 vtr[8];
            tr_read8<0, 16 * 96, 32 * 96, 48 * 96, 32, 32 + 16 * 96, 32 + 32 * 96, 32 + 48 * 96>(vtr, (unsigned)(size_t)(lds + ML_VR) + (unsigned)((4 * q + (r >> 2)) * 96 + 8 * (r & 3)));
#pragma unroll
            for (int et = 0; et < 2; ++et) {
                LAS const unsigned char* crow = lds + ML_CB + cur * 16896 + (16 * et + r) * 528 + q * 16;
                bf16x8_t cf[4];
#pragma unroll
                for (int kk = 0; kk < 4; ++kk) cf[kk] = *(LAS const bf16x8_t*)(crow + kk * 64);
                LDS_WAIT();
                accn[et] = __builtin_amdgcn_mfma_f32_16x16x32_bf16(__builtin_bit_cast(bf16x8_t, pf0), frag2(vtr[4 * et + 0], vtr[4 * et + 1]), (f32x4){0.f, 0.f, 0.f, 0.f}, 0, 0, 0);
                if (tt >= 2) accn[et] = __builtin_amdgcn_mfma_f32_16x16x32_bf16(__builtin_bit_cast(bf16x8_t, pf1), frag2(vtr[4 * et + 2], vtr[4 * et + 3]), accn[et], 0, 0, 0);
                f32x4 q0 = (f32x4){0.f, 0.f, 0.f, 0.f}, q1 = q0;
#pragma unroll
                for (int kk = 0; kk < 4; kk += 2) { q0 = __builtin_amdgcn_mfma_f32_16x16x32_bf16(qf[kk], cf[kk], q0, 0, 0, 0); q1 = __builtin_amdgcn_mfma_f32_16x16x32_bf16(qf[kk + 1], cf[kk + 1], q1, 0, 0, 0); }
#pragma unroll
                for (int kk = 0; kk < 4; ++kk) cf[kk] = *(LAS const bf16x8_t*)(crow + (4 + kk) * 64);
                LDS_WAIT();
#pragma unroll
                for (int kk = 0; kk < 4; kk += 2) { q0 = __builtin_amdgcn_mfma_f32_16x16x32_bf16(qf[4 + kk], cf[kk], q0, 0, 0, 0); q1 = __builtin_amdgcn_mfma_f32_16x16x32_bf16(qf[4 + kk + 1], cf[kk + 1], q1, 0, 0, 0); }
                accq[et] = q0 + q1;
            }
            float qn = 0.f;
            { LAS const float* nrow = (LAS const float*)(lds + ML_N + cur * 1024) + 64 * q; LAS const unsigned char* qrow2 = lds + ML_QC + (16 * tt + r) * 528 + 128 * q;
#pragma unroll
              for (int hf = 0; hf < 2; ++hf) { u32x4 wq[4]; f32x4 n0[4], n1[4];
#pragma unroll
                  for (int c4 = 0; c4 < 4; ++c4) { const int c8 = 4 * hf + c4; wq[c4] = *(LAS const u32x4*)(qrow2 + c8 * 16); n0[c4] = *(LAS const f32x4*)(nrow + 8 * c8); n1[c4] = *(LAS const f32x4*)(nrow + 8 * c8 + 4); }
                  LDS_WAIT();
#pragma unroll
                  for (int c4 = 0; c4 < 4; ++c4) { const u32x4 w = wq[c4];
                      qn += (bflo(w.x) * n0[c4][0] + bfhi(w.x) * n0[c4][1]) + (bflo(w.y) * n0[c4][2] + bfhi(w.y) * n0[c4][3]) + (bflo(w.z) * n1[c4][0] + bfhi(w.z) * n1[c4][1]) + (bflo(w.w) * n1[c4][2] + bfhi(w.w) * n1[c4][3]); } } }
            qn = x32_sum(x16_sum(qn));
            const float swt = ssw[16 * tt + r], mmt = smm[16 * tt + r];
            const float inv = 1.0f / fmaxf(fabsf(rs + swt * qn), __expf(-mmt));
#pragma unroll
            for (int i = 0; i < 4; ++i) { const float invv = __shfl(inv, 4 * q + i), swv = __shfl(swt, 4 * q + i);
                float* hp = HM + (r0 + 16 * tt + 4 * q + i) * 1024 + h * 256 + e0 + r;
                hp[0] = (accn[0][i] + swv * accq[0][i]) * invv; hp[16] = (accn[1][i] + swv * accq[1][i]) * invv; }
        } else {
            const int sw4 = wv - 4; const float decay = __expf(bL + m0 - mL);
#pragma unroll
            for (int k = 0; k < 4; ++k) { accC[k][0] = accC[k][0] * decay; accC[k][1] = accC[k][1] * decay; }
            u32x2 vt2[8], ka[8], kb[8];
            tr_read8<0, 4 * 96, 32 * 96, 36 * 96, 32, 32 + 4 * 96, 32 + 32 * 96, 32 + 36 * 96>(vt2, (unsigned)(size_t)(lds + ML_VR) + (unsigned)((8 * q + (r >> 2)) * 96 + 8 * (r & 3)));
            const unsigned kaddr = (unsigned)(size_t)(lds + ML_KW) + (unsigned)((8 * q + (r >> 2)) * 528 + 8 * (r & 3) + sw4 * 128);
            tr_read8<0, 4 * 528, 32 * 528, 36 * 528, 32, 32 + 4 * 528, 32 + 32 * 528, 32 + 36 * 528>(ka, kaddr);
            tr_read8<64, 64 + 4 * 528, 64 + 32 * 528, 64 + 36 * 528, 96, 96 + 4 * 528, 96 + 32 * 528, 96 + 36 * 528>(kb, kaddr);
            float nsum[4];
#pragma unroll
            for (int k = 0; k < 4; ++k) { const int dt = 4 * sw4 + k; float ns_ = 0.f;
#pragma unroll
                for (int kk2 = 0; kk2 < 2; ++kk2) { const u32x2 a0 = (k < 2 ? ka : kb)[4 * (k & 1) + 2 * kk2], a1 = (k < 2 ? ka : kb)[4 * (k & 1) + 2 * kk2 + 1]; const bf16x8_t af = frag2(a0, a1);
                    ns_ += (bflo(a0.x) + bfhi(a0.x)) + (bflo(a0.y) + bfhi(a0.y)) + (bflo(a1.x) + bfhi(a1.x)) + (bflo(a1.y) + bfhi(a1.y));
#pragma unroll
                    for (int et = 0; et < 2; ++et) accC[k][et] = __builtin_amdgcn_mfma_f32_16x16x32_bf16(af, frag2(vt2[4 * et + 2 * kk2], vt2[4 * et + 2 * kk2 + 1]), accC[k][et], 0, 0, 0); }
                nsum[k] = x32_sum(x16_sum(ns_));
#pragma unroll
                for (int et = 0; et < 2; ++et) { u32x2 o; o.x = cvt_pk_bf16(accC[k][et][0], accC[k][et][1]); o.y = cvt_pk_bf16(accC[k][et][2], accC[k][et][3]);
                    *(LAS u32x2*)(lds + ML_CB + nxt * 16896 + (16 * et + r) * 528 + (16 * dt + 4 * q) * 2) = o; } }
            if (q == 0) { LAS float* nb = (LAS float*)(lds + ML_N);
#pragma unroll
                for (int k = 0; k < 4; ++k) { const int d = 16 * (4 * sw4 + k) + r; nb[nxt * 256 + d] = decay * nb[cur * 256 + d] + nsum[k]; } }
        }
        __syncthreads();
    }
#undef ML_PREFETCH
    if (wv >= 4) { const int sw4 = wv - 4;
#pragma unroll
        for (int k = 0; k < 4; ++k)
#pragma unroll
            for (int et = 0; et < 2; ++et)
#pragma unroll
                for (int i = 0; i < 4; ++i) p.out[O_CP + ((size_t)bh * 256 + 16 * (4 * sw4 + k) + 4 * q + i) * 256 + e0 + 16 * et + r] = accC[k][et][i]; }
    if (sl == 0 && tid < 256) { p.out[O_NP + (size_t)bh * 256 + tid] = ((LAS const float*)(lds + ML_N))[tid]; if (tid == 0) p.out[O_MP + bh] = MMa[2047]; }
    __syncthreads();
}

__device__ __forceinline__ void scores_seg(const Ptrs& p, const int b, const int qt, const int klo, const int khi, const int lane) {
    const int r = lane & 15, q = lane >> 4;
    const bf16_t* PROJ = (const bf16_t*)(p.WS() + WS_PROJ); const float* SMALL = (const float*)(p.WS() + WS_SMALL); const bf16_t* KI = (const bf16_t*)(p.WS() + WS_KI) + (size_t)b * 2048 * 64; float* SC = (float*)(p.WS() + WS_SC);
    const size_t row = (size_t)b * 2048 + 16 * qt + r;
    bf16x8_t qa[8][2]; float w8[8];
#pragma unroll
    for (int j = 0; j < 8; ++j) { qa[j][0] = *(const bf16x8_t*)(PROJ + row * PROJ_LD + PC_QI + 64 * j + 8 * q); qa[j][1] = *(const bf16x8_t*)(PROJ + row * PROJ_LD + PC_QI + 64 * j + 32 + 8 * q); w8[j] = SMALL[row * SMALL_LD + 72 + j] * (0.35355339059327373f * 0.125f); }
    float* scrow = SC + row * 2048 + 4 * q;
#pragma unroll 2
    for (int kt = klo; kt < khi; ++kt) {
        const bf16_t* kp = KI + (size_t)(16 * kt + r) * 64 + 8 * q;
        const bf16x8_t k0 = *(const bf16x8_t*)kp, k1 = *(const bf16x8_t*)(kp + 32);
        f32x4 sc = (f32x4){0.f, 0.f, 0.f, 0.f};
#pragma unroll
        for (int j = 0; j < 8; ++j) { f32x4 S = __builtin_amdgcn_mfma_f32_16x16x32_bf16(k0, qa[j][0], (f32x4){0.f, 0.f, 0.f, 0.f}, 0, 0, 0); S = __builtin_amdgcn_mfma_f32_16x16x32_bf16(k1, qa[j][1], S, 0, 0, 0);
#pragma unroll
            for (int i = 0; i < 4; ++i) sc[i] += w8[j] * fmaxf(S[i], 0.f); }
        *(f32x4*)(scrow + 16 * kt) = sc;
    }
}
__device__ __forceinline__ void scores_mfma_prompt(const Ptrs& p, const int u, const int lane) {
    const int b = u >> 8, rem = u & 255, pair = rem >> 2, part = rem & 3;
    const int qtA = pair, qtB = 127 - pair, nA = qtA + 1, ntot = 129;
    const int j0 = part * 33, j1 = (j0 + 33 < ntot) ? j0 + 33 : ntot;
    if (j0 < nA) scores_seg(p, b, qtA, j0, j1 < nA ? j1 : nA, lane);
    if (j1 > nA) scores_seg(p, b, qtB, (j0 > nA ? j0 : nA) - nA, j1 - nA, lane);
}

constexpr int SS_PITCH = 8208;
__device__ __forceinline__ void scores_select_unit(const Ptrs& p, LAS unsigned char* lds, const int b, const int qt, const int tid) {
    const int lane = tid & 63, wv = __builtin_amdgcn_readfirstlane(tid >> 6), r = lane & 15, q = lane >> 4;
    const bf16_t* PROJ = (const bf16_t*)(p.WS() + WS_PROJ); const float* SMALL = (const float*)(p.WS() + WS_SMALL); const bf16_t* KI = (const bf16_t*)(p.WS() + WS_KI) + (size_t)b * 2048 * 64;
    const size_t row = (size_t)b * 2048 + 16 * qt + r;
    bf16x8_t qa[8][2]; float w8[8];
#pragma unroll
    for (int j = 0; j < 8; ++j) { qa[j][0] = *(const bf16x8_t*)(PROJ + row * PROJ_LD + PC_QI + 64 * j + 8 * q); qa[j][1] = *(const bf16x8_t*)(PROJ + row * PROJ_LD + PC_QI + 64 * j + 32 + 8 * q); w8[j] = SMALL[row * SMALL_LD + 72 + j] * (0.35355339059327373f * 0.125f); }
    __syncthreads();
#pragma unroll 2
    for (int kt = wv; kt <= qt; kt += 8) {
        const bf16_t* kp = KI + (size_t)(16 * kt + r) * 64 + 8 * q;
        const bf16x8_t k0 = *(const bf16x8_t*)kp, k1 = *(const bf16x8_t*)(kp + 32);
        f32x4 sc = (f32x4){0.f, 0.f, 0.f, 0.f};
#pragma unroll
        for (int j = 0; j < 8; ++j) { f32x4 S = __builtin_amdgcn_mfma_f32_16x16x32_bf16(k0, qa[j][0], (f32x4){0.f, 0.f, 0.f, 0.f}, 0, 0, 0); S = __builtin_amdgcn_mfma_f32_16x16x32_bf16(k1, qa[j][1], S, 0, 0, 0);
#pragma unroll
            for (int i = 0; i < 4; ++i) sc[i] += w8[j] * fmaxf(S[i], 0.f); }
        *(LAS f32x4*)(lds + r * SS_PITCH + (16 * kt + 4 * q) * 4) = sc;
    }
    __syncthreads();
#pragma unroll
    for (int rr = 0; rr < 2; ++rr) { const int tl = 2 * wv + rr, nvalid = 16 * qt + tl + 1; float raw[32];
#pragma unroll
        for (int i = 0; i < 32; ++i) raw[i] = *(LAS const float*)(lds + tl * SS_PITCH + (64 * i + lane) * 4);
        select_compute<32>(raw, nvalid, (u64*)(p.WS() + WS_MASK) + ((size_t)b * 2048 + 16 * qt + tl) * 32, lane); }
}

template <int DT0> __device__ __forceinline__ void v_tr_read8(u32x2 (&o)[2][2][2]  , const unsigned addr) {
    asm volatile("ds_read_b64_tr_b16 %0, %8 offset:%9\n\tds_read_b64_tr_b16 %1, %8 offset:%10\n\tds_read_b64_tr_b16 %2, %8 offset:%11\n\tds_read_b64_tr_b16 %3, %8 offset:%12\n\t"
                 "ds_read_b64_tr_b16 %4, %8 offset:%13\n\tds_read_b64_tr_b16 %5, %8 offset:%14\n\tds_read_b64_tr_b16 %6, %8 offset:%15\n\tds_read_b64_tr_b16 %7, %8 offset:%16\n\ts_waitcnt lgkmcnt(0)"
                 : "=&v"(o[0][0][0]), "=&v"(o[0][0][1]), "=&v"(o[0][1][0]), "=&v"(o[0][1][1]), "=&v"(o[1][0][0]), "=&v"(o[1][0][1]), "=&v"(o[1][1][0]), "=&v"(o[1][1][1])
                 : "v"(addr), "n"(DT0 * 32), "n"(DT0 * 32 + 16 * 288), "n"(DT0 * 32 + 32 * 288), "n"(DT0 * 32 + 48 * 288),
                   "n"(DT0 * 32 + 32), "n"(DT0 * 32 + 32 + 16 * 288), "n"(DT0 * 32 + 32 + 32 * 288), "n"(DT0 * 32 + 32 + 48 * 288) : "memory");
}
constexpr int AT_BUF = 35840, AT_KC = 0, AT_VT = 17408, AT_MASK = 71680, AT_BIAS = 88064, AT_END = 96256;
__device__ __forceinline__ void attn_mfma_block(const Ptrs& p, LAS unsigned char* lds, const int b, const int qb, const int g, const int tid) {
    const int lane = tid & 63, wv = __builtin_amdgcn_readfirstlane(tid >> 6), r = lane & 15, q = lane >> 4, hh = 4 * g + (wv & 3), mh = wv >> 2;
    const int t0 = 64 * qb, ntile = qb + 1; const size_t row0 = (size_t)b * 2048 + t0;
    const bf16_t* QA = (const bf16_t*)(p.WS() + WS_QA); const bf16_t* KA = (const bf16_t*)(p.WS() + WS_KA); const bf16_t* PROJ = (const bf16_t*)(p.WS() + WS_PROJ); const u64* MASK = (const u64*)(p.WS() + WS_MASK);
    LAS u64* maskL = (LAS u64*)(lds + AT_MASK); LAS const float* biasn = (LAS const float*)(lds + AT_BIAS);
    __syncthreads();
    for (int i = tid; i < 2048; i += 512) maskL[i] = MASK[(row0 + (i >> 5)) * 32 + (i & 31)];
    bf16x8_t qf[2][4];
#pragma unroll
    for (int m2 = 0; m2 < 2; ++m2)
#pragma unroll
        for (int kk = 0; kk < 4; ++kk) qf[m2][kk] = *(const bf16x8_t*)(QA + (row0 + 16 * (2 * mh + m2) + r) * 1024 + hh * 128 + 32 * kk + 8 * q);
    f32x4 O[2][8]; float mrun[2], lrun[2];
#pragma unroll
    for (int m2 = 0; m2 < 2; ++m2) { mrun[m2] = -INFINITY; lrun[m2] = 0.f;
#pragma unroll
        for (int dt = 0; dt < 8; ++dt) O[m2][dt] = (f32x4){0.f, 0.f, 0.f, 0.f}; }
    const float bfar = p.t5[31 * 8 + hh];
    const int srow = tid >> 3, sp = tid & 7;
    u32x4 pk[2], pv[2];
#define AT_PREFETCH(kt_) do { const size_t kr_ = (size_t)b * 2048 + 64 * (kt_) + srow; const bf16_t* kp_ = KA + kr_ * 256 + g * 128 + sp * 16; const bf16_t* vp_ = PROJ + kr_ * PROJ_LD + PC_VA + g * 128 + sp * 16; \
        pk[0] = *(const u32x4*)kp_; pk[1] = *(const u32x4*)(kp_ + 8); pv[0] = *(const u32x4*)vp_; pv[1] = *(const u32x4*)(vp_ + 8); } while (0)
#define AT_STAGE(buf_) do { LAS unsigned char* bb_ = lds + (buf_) * AT_BUF; \
        *(LAS u32x4*)(bb_ + AT_KC + srow * 272 + sp * 32) = pk[0]; *(LAS u32x4*)(bb_ + AT_KC + srow * 272 + sp * 32 + 16) = pk[1]; \
        *(LAS u32x4*)(bb_ + AT_VT + srow * 288 + sp * 32) = pv[0]; *(LAS u32x4*)(bb_ + AT_VT + srow * 288 + sp * 32 + 16) = pv[1]; } while (0)
    AT_PREFETCH(0); AT_STAGE(0); if (ntile > 1) AT_PREFETCH(1);
    __syncthreads();
    for (int kt = 0; kt < ntile; ++kt) {
        const int buf = kt & 1; LAS const unsigned char* bb = lds + buf * AT_BUF;
        f32x4 S[2][4];
#pragma unroll
        for (int a = 0; a < 4; ++a) { bf16x8_t kf[4];
#pragma unroll
            for (int kk = 0; kk < 4; ++kk) kf[kk] = *(LAS const bf16x8_t*)(bb + AT_KC + (16 * a + r) * 272 + kk * 64 + q * 16);
            LDS_WAIT();
            S[0][a] = (f32x4){0.f, 0.f, 0.f, 0.f}; S[1][a] = (f32x4){0.f, 0.f, 0.f, 0.f};
#pragma unroll
            for (int kk = 0; kk < 4; ++kk) { S[0][a] = __builtin_amdgcn_mfma_f32_16x16x32_bf16(kf[kk], qf[0][kk], S[0][a], 0, 0, 0); S[1][a] = __builtin_amdgcn_mfma_f32_16x16x32_bf16(kf[kk], qf[1][kk], S[1][a], 0, 0, 0); } }
        u32x4 pf[2][2];
#pragma unroll
        for (int m2 = 0; m2 < 2; ++m2) {
            const int mt = 2 * mh + m2, t = t0 + 16 * mt + r; const u64 mwq = maskL[(16 * mt + r) * 32 + kt] >> (4 * q);
            const unsigned mlo = (unsigned)mwq, mhi = (unsigned)(mwq >> 32);
            const bool far = (t0 + 16 * mt - 64 * kt - 63) >= 128;
            float bia[4][4];
            if (far) {
#pragma unroll
                for (int a = 0; a < 4; ++a)
#pragma unroll
                    for (int i = 0; i < 4; ++i) bia[a][i] = bfar;
            } else {
                const int dbase = t - 64 * kt - 4 * q;
#pragma unroll
                for (int a = 0; a < 4; ++a)
#pragma unroll
                    for (int i = 0; i < 4; ++i) { int dist = dbase - (16 * a + i); dist = dist < 0 ? 0 : (dist > 255 ? 255 : dist); bia[a][i] = biasn[dist * 8 + hh]; }
                LDS_WAIT();
            }
            float mx = -INFINITY;
#pragma unroll
            for (int a = 0; a < 4; ++a)
#pragma unroll
                for (int i = 0; i < 4; ++i) { const bool on = (((a < 2) ? mlo : mhi) >> (16 * (a & 1) + i)) & 1u; const float lg = on ? S[m2][a][i] + bia[a][i] : -INFINITY; S[m2][a][i] = lg; mx = fmaxf(mx, lg); }
            mx = x32_max(x16_max(mx));
            const float mnew = fmaxf(mrun[m2], mx), muse = (mnew == -INFINITY) ? 0.f : mnew; const float alpha = __expf(mrun[m2] - muse); mrun[m2] = mnew;
            float psum = 0.f; unsigned pw[4][2];
#pragma unroll
            for (int a = 0; a < 4; ++a) { float pe[4];
#pragma unroll
                for (int i = 0; i < 4; ++i) { pe[i] = __expf(S[m2][a][i] - muse); psum += pe[i]; }
                pw[a][0] = cvt_pk_bf16(pe[0], pe[1]); pw[a][1] = cvt_pk_bf16(pe[2], pe[3]); }
            psum = x32_sum(x16_sum(psum));
            lrun[m2] = lrun[m2] * alpha + psum;
            pf[m2][0].x = pw[0][0]; pf[m2][0].y = pw[0][1]; pf[m2][0].z = pw[1][0]; pf[m2][0].w = pw[1][1]; pf[m2][1].x = pw[2][0]; pf[m2][1].y = pw[2][1]; pf[m2][1].z = pw[3][0]; pf[m2][1].w = pw[3][1];
#pragma unroll
            for (int i = 0; i < 4; ++i) { const float al = __shfl(alpha, 4 * q + i);
#pragma unroll
                for (int dt = 0; dt < 8; ++dt) O[m2][dt][i] *= al; }
        }
        {
            const unsigned vaddr = (unsigned)(size_t)(bb + AT_VT) + (unsigned)((4 * q + (r >> 2)) * 288 + 8 * (r & 3));
#define AT_PV2(DT0_) do { u32x2 vt_[2][2][2]; v_tr_read8<DT0_>(vt_, vaddr); \
            _Pragma("unroll") for (int a2 = 0; a2 < 2; ++a2) _Pragma("unroll") for (int d2 = 0; d2 < 2; ++d2) { u32x4 vf; vf.x = vt_[d2][a2][0].x; vf.y = vt_[d2][a2][0].y; vf.z = vt_[d2][a2][1].x; vf.w = vt_[d2][a2][1].y; \
                O[0][(DT0_) + d2] = __builtin_amdgcn_mfma_f32_16x16x32_bf16(__builtin_bit_cast(bf16x8_t, pf[0][a2]), __builtin_bit_cast(bf16x8_t, vf), O[0][(DT0_) + d2], 0, 0, 0); \
                O[1][(DT0_) + d2] = __builtin_amdgcn_mfma_f32_16x16x32_bf16(__builtin_bit_cast(bf16x8_t, pf[1][a2]), __builtin_bit_cast(bf16x8_t, vf), O[1][(DT0_) + d2], 0, 0, 0); } } while (0)
            AT_PV2(0); AT_PV2(2); AT_PV2(4); AT_PV2(6);
#undef AT_PV2
        }
        if (kt + 1 < ntile) { AT_STAGE(buf ^ 1); if (kt + 2 < ntile) AT_PREFETCH(kt + 2); }
        __syncthreads();
    }
#undef AT_PREFETCH
#undef AT_STAGE
    bf16_t* CAT = (bf16_t*)(p.WS() + WS_CAT);
#pragma unroll
    for (int m2 = 0; m2 < 2; ++m2) { const float invl = 1.0f / lrun[m2];
#pragma unroll
        for (int i = 0; i < 4; ++i) { const float iv = __shfl(invl, 4 * q + i); bf16_t* cp = CAT + (row0 + 16 * (2 * mh + m2) + 4 * q + i) * D + 1024 + hh * 128 + r;
#pragma unroll
            for (int dt = 0; dt < 8; ++dt) cp[16 * dt] = f2bf(O[m2][dt][i] * iv); } }
}

__device__ __forceinline__ void scores_mfma_sample(const Ptrs& p, const int u, const int lane) {
    const int r = lane & 15, q = lane >> 4, b = u >> 4, part = u & 15;
    const bf16_t* PROJ = (const bf16_t*)(p.WS() + WS_PROJ); const float* SMALL = (const float*)(p.WS() + WS_SMALL); float* SCS = (float*)(p.WS() + WS_SCS);
    bf16x8_t qa[2][2]; float w4[2][4];
#pragma unroll
    for (int mtl = 0; mtl < 2; ++mtl) { const size_t row = (size_t)MP + 4 * b + 2 * mtl + (r >> 3);
        qa[mtl][0] = *(const bf16x8_t*)(PROJ + row * PROJ_LD + PC_QI + 64 * (r & 7) + 8 * q); qa[mtl][1] = *(const bf16x8_t*)(PROJ + row * PROJ_LD + PC_QI + 64 * (r & 7) + 32 + 8 * q);
        const size_t wrow = (size_t)MP + 4 * b + 2 * mtl + (q >> 1);
#pragma unroll
        for (int i = 0; i < 4; ++i) w4[mtl][i] = SMALL[wrow * SMALL_LD + 72 + 4 * (q & 1) + i] * (0.35355339059327373f * 0.125f); }
    const int tlo = 8 * part, thi = (part == 15) ? 129 : 8 * part + 8;
    for (int kt = tlo; kt < thi; ++kt) {
        const int s = 16 * kt + r; f32x4 k0a, k0b, k1a, k1b;
        if (s < 2052) { const float* kr = s < 2048 ? p.cache_ik + ((size_t)p.page_table[b * 16 + (s >> 7)] * 128 + (s & 127)) * 64 : SMALL + (size_t)(MP + 4 * b + (s - 2048)) * SMALL_LD;
            k0a = *(const f32x4*)(kr + 8 * q); k0b = *(const f32x4*)(kr + 8 * q + 4); k1a = *(const f32x4*)(kr + 32 + 8 * q); k1b = *(const f32x4*)(kr + 32 + 8 * q + 4); }
        else { k0a = (f32x4){0.f, 0.f, 0.f, 0.f}; k0b = k0a; k1a = k0a; k1b = k0a; }
        u32x4 w0, w1; w0.x = cvt_pk_bf16(k0a[0], k0a[1]); w0.y = cvt_pk_bf16(k0a[2], k0a[3]); w0.z = cvt_pk_bf16(k0b[0], k0b[1]); w0.w = cvt_pk_bf16(k0b[2], k0b[3]);
        w1.x = cvt_pk_bf16(k1a[0], k1a[1]); w1.y = cvt_pk_bf16(k1a[2], k1a[3]); w1.z = cvt_pk_bf16(k1b[0], k1b[1]); w1.w = cvt_pk_bf16(k1b[2], k1b[3]);
        const bf16x8_t kb0 = __builtin_bit_cast(bf16x8_t, w0), kb1 = __builtin_bit_cast(bf16x8_t, w1);
#pragma unroll
        for (int mtl = 0; mtl < 2; ++mtl) {
            f32x4 S = __builtin_amdgcn_mfma_f32_16x16x32_bf16(qa[mtl][0], kb0, (f32x4){0.f, 0.f, 0.f, 0.f}, 0, 0, 0); S = __builtin_amdgcn_mfma_f32_16x16x32_bf16(qa[mtl][1], kb1, S, 0, 0, 0);
            float sc = (w4[mtl][0] * fmaxf(S[0], 0.f) + w4[mtl][1] * fmaxf(S[1], 0.f)) + (w4[mtl][2] * fmaxf(S[2], 0.f) + w4[mtl][3] * fmaxf(S[3], 0.f));
            sc = x16_sum(sc);
            if ((q & 1) == 0) SCS[(size_t)(4 * b + 2 * mtl + (q >> 1)) * SCS_LD + s] = sc;
        }
    }
}

constexpr int SA_LS = 96256, SA_LP = 104960, SA_SEL = 113664, SA_N = 115840;
__device__ __forceinline__ void attn_mfma_sample(const Ptrs& p, LAS unsigned char* lds, const int b, const int g, const int tid) {
    const int lane = tid & 63, wv = __builtin_amdgcn_readfirstlane(tid >> 6), r = lane & 15, q = lane >> 4;
    const bf16_t* QA = (const bf16_t*)(p.WS() + WS_QA); const bf16_t* KA = (const bf16_t*)(p.WS() + WS_KA); const bf16_t* PROJ = (const bf16_t*)(p.WS() + WS_PROJ); const u64* MASKS = (const u64*)(p.WS() + WS_MASKS);
    LAS int* listS = (LAS int*)(lds + SA_LS); LAS int* listP = (LAS int*)(lds + SA_LP); LAS unsigned char* sel = lds + SA_SEL; LAS int* nk = (LAS int*)(lds + SA_N); LAS const float* biasn = (LAS const float*)(lds + AT_BIAS);
    __syncthreads();
    LAS u64* mk4 = (LAS u64*)(lds + SA_N + 64);
    if (wv < 4) {
        float raw[33]; select_load<33>(raw, (const float*)(p.WS() + WS_SCS) + (size_t)(4 * b + wv) * SCS_LD, lane);
        select_compute<33>(raw, 2049 + wv, (u64*)(mk4 + wv * 33), lane);
    }
    __syncthreads();
    if (wv == 0) {
        int base = 0;
        for (int w = 0; w < 33; ++w) {
            const u64 m0 = mk4[w], m1 = mk4[33 + w], m2 = mk4[66 + w], m3 = mk4[99 + w];
            const unsigned s4 = (unsigned)((m0 >> lane) & 1ull) | ((unsigned)((m1 >> lane) & 1ull) << 1) | ((unsigned)((m2 >> lane) & 1ull) << 2) | ((unsigned)((m3 >> lane) & 1ull) << 3);
            const bool on = s4 != 0u; const u64 bal = __ballot(on);
            if (on) { const int pos = base + __popcll(bal & ((1ull << lane) - 1ull)); listS[pos] = 64 * w + lane; sel[pos] = (unsigned char)s4; }
            base += __popcll(bal);
        }
        const int npad = (base + 63) & ~63;
        for (int i = base + lane; i < npad; i += 64) { listS[i] = 0; sel[i] = 0; }
        if (lane == 0) { nk[0] = base; nk[1] = npad; }
    }
    __syncthreads();
    const int npad = nk[1], ntile = npad >> 6;
    for (int i = tid; i < npad; i += 512) { const int s = listS[i]; listP[i] = s < 2048 ? p.page_table[b * 16 + (s >> 7)] * 128 + (s & 127) : -(1 + (s - 2048)); }
    bf16x8_t qf[4];
    { const size_t qrow = (size_t)MP + 4 * b + (r >> 2); const int hh = 4 * g + (r & 3);
#pragma unroll
      for (int kk = 0; kk < 4; ++kk) qf[kk] = *(const bf16x8_t*)(QA + qrow * 1024 + hh * 128 + 32 * kk + 8 * q); }
    const int trow = r >> 2, hrow = 4 * g + (r & 3), qpos = 2048 + trow;
    f32x4 O = (f32x4){0.f, 0.f, 0.f, 0.f}; float mrun = -INFINITY, lrun = 0.f;
    const int srow = tid >> 3, sp = tid & 7;
    f32x4 pkf[4], pvf[4];
    __syncthreads();
#define SA_PREFETCH(kt_) do { const int e_ = listP[64 * (kt_) + srow]; \
        if (e_ >= 0) { const float* kp_ = p.cache_k + ((size_t)e_ * 2 + g) * 128 + sp * 16; const float* vp_ = p.cache_v + ((size_t)e_ * 2 + g) * 128 + sp * 16; \
            _Pragma("unroll") for (int j_ = 0; j_ < 4; ++j_) { pkf[j_] = *(const f32x4*)(kp_ + 4 * j_); pvf[j_] = *(const f32x4*)(vp_ + 4 * j_); } } \
        else { const size_t nr_ = (size_t)MP + 4 * b + (-e_ - 1); const bf16_t* kp_ = KA + nr_ * 256 + g * 128 + sp * 16; const bf16_t* vp_ = PROJ + nr_ * PROJ_LD + PC_VA + g * 128 + sp * 16; \
            const u32x4 a0_ = *(const u32x4*)kp_, a1_ = *(const u32x4*)(kp_ + 8), c0_ = *(const u32x4*)vp_, c1_ = *(const u32x4*)(vp_ + 8); \
            pkf[0] = (f32x4){bflo(a0_.x), bfhi(a0_.x), bflo(a0_.y), bfhi(a0_.y)}; pkf[1] = (f32x4){bflo(a0_.z), bfhi(a0_.z), bflo(a0_.w), bfhi(a0_.w)}; pkf[2] = (f32x4){bflo(a1_.x), bfhi(a1_.x), bflo(a1_.y), bfhi(a1_.y)}; pkf[3] = (f32x4){bflo(a1_.z), bfhi(a1_.z), bflo(a1_.w), bfhi(a1_.w)}; \
            pvf[0] = (f32x4){bflo(c0_.x), bfhi(c0_.x), bflo(c0_.y), bfhi(c0_.y)}; pvf[1] = (f32x4){bflo(c0_.z), bfhi(c0_.z), bflo(c0_.w), bfhi(c0_.w)}; pvf[2] = (f32x4){bflo(c1_.x), bfhi(c1_.x), bflo(c1_.y), bfhi(c1_.y)}; pvf[3] = (f32x4){bflo(c1_.z), bfhi(c1_.z), bflo(c1_.w), bfhi(c1_.w)}; } } while (0)
#define SA_STAGE(buf_) do { LAS unsigned char* bb_ = lds + (buf_) * AT_BUF; u32x4 w0_, w1_; \
        w0_.x = cvt_pk_bf16(pkf[0][0], pkf[0][1]); w0_.y = cvt_pk_bf16(pkf[0][2], pkf[0][3]); w0_.z = cvt_pk_bf16(pkf[1][0], pkf[1][1]); w0_.w = cvt_pk_bf16(pkf[1][2], pkf[1][3]); \
        w1_.x = cvt_pk_bf16(pkf[2][0], pkf[2][1]); w1_.y = cvt_pk_bf16(pkf[2][2], pkf[2][3]); w1_.z = cvt_pk_bf16(pkf[3][0], pkf[3][1]); w1_.w = cvt_pk_bf16(pkf[3][2], pkf[3][3]); \
        *(LAS u32x4*)(bb_ + AT_KC + srow * 272 + sp * 32) = w0_; *(LAS u32x4*)(bb_ + AT_KC + srow * 272 + sp * 32 + 16) = w1_; \
        _Pragma("unroll") for (int j_ = 0; j_ < 4; ++j_) _Pragma("unroll") for (int e_ = 0; e_ < 4; e_ += 2) { const unsigned w_ = cvt_pk_bf16(pvf[j_][e_], pvf[j_][e_ + 1]); const int d_ = sp * 16 + 4 * j_ + e_; \
            *(LAS bf16_t*)(bb_ + AT_VT + d_ * 144 + srow * 2) = (bf16_t)(w_ & 0xffffu); *(LAS bf16_t*)(bb_ + AT_VT + (d_ + 1) * 144 + srow * 2) = (bf16_t)(w_ >> 16); } } while (0)
    SA_PREFETCH(0); SA_STAGE(0); if (ntile > 1) SA_PREFETCH(1);
    __syncthreads();
    for (int kt = 0; kt < ntile; ++kt) {
        const int buf = kt & 1; LAS const unsigned char* bb = lds + buf * AT_BUF;
        if (kt + 1 < ntile) { SA_STAGE(buf ^ 1); if (kt + 2 < ntile) SA_PREFETCH(kt + 2); }
        f32x4 S[4];
#pragma unroll
        for (int a = 0; a < 4; ++a) { S[a] = (f32x4){0.f, 0.f, 0.f, 0.f};
#pragma unroll
            for (int kk = 0; kk < 4; ++kk) S[a] = __builtin_amdgcn_mfma_f32_16x16x32_bf16(*(LAS const bf16x8_t*)(bb + AT_KC + (16 * a + r) * 272 + kk * 64 + q * 16), qf[kk], S[a], 0, 0, 0); }
        float mx = -INFINITY;
#pragma unroll
        for (int a = 0; a < 4; ++a) { const int i0 = 64 * kt + 16 * a + 4 * q; const unsigned s4w = *(LAS const unsigned*)(sel + i0);
            const int ks0 = listS[i0], ks1 = listS[i0 + 1], ks2 = listS[i0 + 2], ks3 = listS[i0 + 3]; const int ksv[4] = {ks0, ks1, ks2, ks3};
#pragma unroll
            for (int i = 0; i < 4; ++i) { const bool on = (s4w >> (8 * i + trow)) & 1u; int dist = qpos - ksv[i]; dist = dist < 0 ? 0 : (dist > 255 ? 255 : dist);
                const float lg = on ? S[a][i] + biasn[dist * 8 + hrow] : -INFINITY; S[a][i] = lg; mx = fmaxf(mx, lg); } }
        mx = x32_max(x16_max(mx));
        const float mnew = fmaxf(mrun, mx), muse = (mnew == -INFINITY) ? 0.f : mnew; const float alpha = __expf(mrun - muse); mrun = mnew;
        float psum = 0.f; unsigned pw[4][2];
#pragma unroll
        for (int a = 0; a < 4; ++a) { float pe[4];
#pragma unroll
            for (int i = 0; i < 4; ++i) { pe[i] = __expf(S[a][i] - muse); psum += pe[i]; }
            pw[a][0] = cvt_pk_bf16(pe[0], pe[1]); pw[a][1] = cvt_pk_bf16(pe[2], pe[3]); }
        psum = x32_sum(x16_sum(psum));
        lrun = lrun * alpha + psum;
        u32x4 pf[2]; pf[0].x = pw[0][0]; pf[0].y = pw[0][1]; pf[0].z = pw[1][0]; pf[0].w = pw[1][1]; pf[1].x = pw[2][0]; pf[1].y = pw[2][1]; pf[1].z = pw[3][0]; pf[1].w = pw[3][1];
#pragma unroll
        for (int i = 0; i < 4; ++i) O[i] *= __shfl(alpha, 4 * q + i);
        { LAS const unsigned char* vrow = bb + AT_VT + (16 * wv + r) * 144;
#pragma unroll
          for (int a2 = 0; a2 < 2; ++a2) { const u32x2 lo = *(LAS const u32x2*)(vrow + (32 * a2 + 4 * q) * 2), hi = *(LAS const u32x2*)(vrow + (32 * a2 + 16 + 4 * q) * 2); u32x4 vf; vf.x = lo.x; vf.y = lo.y; vf.z = hi.x; vf.w = hi.y;
              O = __builtin_amdgcn_mfma_f32_16x16x32_bf16(__builtin_bit_cast(bf16x8_t, pf[a2]), __builtin_bit_cast(bf16x8_t, vf), O, 0, 0, 0); } }
        __syncthreads();
    }
#undef SA_PREFETCH
#undef SA_STAGE
    bf16_t* CAT = (bf16_t*)(p.WS() + WS_CAT); const float invl = 1.0f / lrun;
#pragma unroll
    for (int i = 0; i < 4; ++i) { const float iv = __shfl(invl, 4 * q + i); CAT[((size_t)MP + 4 * b + q) * D + 1024 + (4 * g + i) * 128 + 16 * wv + r] = f2bf(O[i] * iv); }
}

struct MkArgs { Ptrs p; int ph_lo, ph_hi, sub, pad; };
__global__ void __launch_bounds__(512, 2) mk_fwd(MkArgs a) {
    extern __shared__ __attribute__((aligned(16))) unsigned char lds_raw[];
    LAS unsigned char* lds = (LAS unsigned char*)lds_raw;
    const int lo_ = a.ph_lo, hi_ = a.ph_hi;
    const Ptrs& p = a.p;
    { unsigned char* w = p.ws_; asm volatile("" :: "s"(w), "s"(lo_), "s"(hi_)); }
    const int tid0 = threadIdx.x;
#define PART_ENV int tid = tid0; asm volatile("" : "+v"(tid)); const int lane = tid & 63, wave = __builtin_amdgcn_readfirstlane(tid >> 6), gw = vcu * 8 + wave; (void)lane; (void)wave; (void)gw;
    const int tid = tid0, lane = tid & 63, wave = __builtin_amdgcn_readfirstlane(tid >> 6);
    const int G = gridDim.x; const int bx = blockIdx.x; const int vcu = (G % 8 == 0) ? (bx % 8) * (G / 8) + bx / 8 : bx;
    const int gw = vcu * 8 + wave, NGW = G * 8;
    for (int u = tid; u < (LDS_BYTES - LDSCTL_OFF) / 4; u += 512) ((LAS unsigned*)(lds + LDSCTL_OFF))[u] = 0u;
    __syncthreads();
    const bool one_launch = (hi_ - lo_) > 1;
    XcdBarrier bar; bar.bar = (unsigned*)(p.WS() + WS_CTL) + CW_BAR; bar.x = 0; bar.st = nullptr;
    if (one_launch) bar = xcd_barrier_post((unsigned*)(p.WS() + WS_CTL) + CW_BAR, (volatile LAS unsigned*)(lds + MISC_OFF) + 8);
    const int lo = lo_, hi = hi_;
#define IN(k) (lo <= (k) && (k) < hi)
#define SEAM(k) do { if (IN(k) && IN((k) + 1)) xcd_barrier(bar); } while (0)
    const float* mods = (const float*)(p.WS() + WS_MODS);
    bf16_t* Hb = (bf16_t*)(p.WS() + WS_H); bf16_t* ACT = (bf16_t*)(p.WS() + WS_ACT); bf16_t* CAT = (bf16_t*)(p.WS() + WS_CAT);
    float* X = p.out + O_Y;

    if (IN(0)) {
        if (G == 256) {
            if (vcu < 144) { PART_ENV const int wi = 8 * vcu + wave; if (wi & 1) mods_wg_body<5, 4>(p, lds, wi >> 1, tid); else mods_wg_body<0, 5>(p, lds, wi >> 1, tid); }
            { PART_ENV LAS float* scr = (LAS float*)(lds + RING_OFF + wave * 16384);
              constexpr int NM = 12, NMW = 1152, IT_M = NM * NMW;
              if (vcu < 144) { const int mw = vcu * 8 + wave; for (int k = 0; k < NM; ++k) convert_item(p, mw + k * NMW, scr, lane); }
              else { const int ow = (vcu - 144) * 8 + wave; for (int it = IT_M + ow; it < IT_ALL; it += 896) convert_item(p, it, scr, lane); } }
        } else {
            { PART_ENV if ((gw & 15) < 9) { const int it = (gw >> 4) * 9 + (gw & 15); if (it < 2 * (NMOD / 32)) { if (it & 1) mods_item_t<5, 4>(p, it >> 1, lane); else mods_item_t<0, 5>(p, it >> 1, lane); } } }
            { PART_ENV LAS float* scr = (LAS float*)(lds + RING_OFF + wave * 16384); for (int it = gw; it < IT_ALL; it += NGW) convert_item(p, it, scr, lane); }
        }
    }
    SEAM(0);
    if (IN(1)) { PART_ENV for (int row = gw; row < M; row += NGW) { const float* mr = mods + (size_t)row_bm(row) * NMOD;
        normmod_q8(row < MP ? p.x_p + (size_t)row * D : p.x_s + (size_t)(row - MP) * D, p.f1_g, mr + D, mr, p.WS() + WS_H8 + (size_t)row * D, (float*)(p.WS() + WS_SA) + row, lane); }
        for (int n = gw; n < 4 * FF; n += NGW) { const int which = n >= 2 * FF, nn = which ? n - 2 * FF : n;
            quant_wrow<D>((const bf16_t*)(p.WS() + (which ? WS_W2GU : WS_W1GU)) + (size_t)nn * D, p.WS() + (which ? WS_W2GU8 : WS_W1GU8) + (size_t)nn * D, (unsigned*)(p.WS() + WS_CTL + CTL_CMAX) + n, lane); }
        for (int n = gw; n < 2 * D; n += NGW) { const int which = n >= D, nn = which ? n - D : n;
            quant_wrow<FF>((const bf16_t*)(p.WS() + (which ? WS_W2D : WS_W1D)) + (size_t)nn * FF, p.WS() + (which ? WS_W2D8 : WS_W1D8) + (size_t)nn * FF, (unsigned*)(p.WS() + WS_CTL + CTL_CMAX) + 4 * FF + n, lane); } }
    SEAM(1);
    if (IN(2)) { PART_ENV pg8::Gemm g{(const bf16_t*)(p.WS() + WS_H8), (const bf16_t*)(p.WS() + WS_W1GU8), M, 2 * FF, D / 2, D / 2}; pg8::StaticOrder S; S.init(MP, 2 * FF, G, bx);
        pg8::EpiSwigluI8 E{ACT, (const float*)(p.WS() + WS_SA), (const float*)(p.WS() + WS_CTL + CTL_CMAX), (float*)(p.WS() + WS_RMAXP), p.WS() + WS_ACT8};
        pg8::gemm_phase<pg8::EpiSwigluI8, pg8::StaticOrder, PG8_ALIGN, PG8_SP2>(lds + RING_OFF, g, S, E); }
    if (IN(2) && IN(15)) xcd_barrier(bar);
    if (IN(15)) { PART_ENV
        const int ngemm = G > 88 ? 88 : G, nreq = G > 88 ? G - 88 : G, creq = G > 88 ? bx - 88 : bx;
        if (bx < ngemm) { pg8::Gemm g{(const bf16_t*)(p.WS() + WS_H8), (const bf16_t*)(p.WS() + WS_W1GU8), M, 2 * FF, D / 2, D / 2}; pg8::SampleOrder S; S.init(2 * FF, ngemm, bx);
            pg8::EpiSwigluI8 E{ACT, (const float*)(p.WS() + WS_SA), (const float*)(p.WS() + WS_CTL + CTL_CMAX), (float*)(p.WS() + WS_RMAXP), p.WS() + WS_ACT8};
            pg8::gemm_phase<pg8::EpiSwigluI8, pg8::SampleOrder, PG8_ALIGN, PG8_SP2>(lds + RING_OFF, g, S, E); }
        if (creq >= 0) for (int row = creq * 8 + wave; row < MP; row += nreq * 8) requant_act_row(p.WS() + WS_ACT8 + (size_t)row * FF, (const float*)(p.WS() + WS_RMAXP) + (size_t)row * 176, (float*)(p.WS() + WS_SA2) + row, lane); }
    if (IN(15) && IN(3)) xcd_barrier(bar);
    if (IN(3)) { PART_ENV
#pragma nounroll
      for (int s_ = 0; s_ < 2; ++s_) {
        if ((s_ == 0) != ((bx & 1) != 0)) { pg8::Gemm g{(const bf16_t*)(p.WS() + WS_ACT8), (const bf16_t*)(p.WS() + WS_W1D8), MP, D, FF / 2, FF / 2}; pg8::StaticOrder S; S.init(MP, D, G, bx, 4);
        pg8::EpiResidI8T<false, true> E{p.x_p, (bf16_t*)(p.WS() + WS_XB), mods + 2 * D, 0.5f, (const float*)(p.WS() + WS_SA2), (const float*)(p.WS() + WS_CTL + CTL_CMAX) + 4 * FF};
        pg8::gemm_phase<pg8::EpiResidI8T<false, true>, pg8::StaticOrder, PG8_ALIGN, PG8_SP2>(lds + RING_OFF, g, S, E); }
        else { pg8::Gemm g{ACT, (const bf16_t*)(p.WS() + WS_W1D), M, D, FF, 512}; pg8::SplitOrder S{11, G, (bx & 1) ? (bx >> 1) : (G >> 1) + (bx >> 1)}; pg8::EpiSlab E{(float*)(p.WS() + WS_SLAB)};
        pg8::gemm_phase<pg8::EpiSlab, pg8::SplitOrder, PG8_ALIGN, PG8_SP2>(lds + RING_OFF, g, S, E); }
        __syncthreads(); } }
    SEAM(3);
    if (IN(4)) { PART_ENV const int nit = fix_rows_n(gw, NGW); for (int it = 0; it < nit; ++it) { const int row = fix_row_at(gw, NGW, it); const float* mr = mods + (size_t)row_bm(row) * NMOD + 3 * D;
        bf16_t* xb = (bf16_t*)(p.WS() + WS_XB) + (size_t)row * D; f32x4 v[8];
        if (row < MP) row_load_b(v, xb, lane);
        else { row_load(v, p.x_s + (size_t)(row - MP) * D, lane); fix_add<11>(v, (const float*)(p.WS() + WS_SLAB) + (size_t)(row - MP) * D, mr - D, 0.5f, lane); row_store_b(v, xb, lane); }
        normmod_vals(v, p.mix_g, mr + D, mr, Hb + (size_t)row * D, lane); } }
    SEAM(4);
    if (IN(5)) { PART_ENV pg8::Gemm g{Hb, (const bf16_t*)(p.WS() + WS_WIN), M, 6400, D, D}; pg8::StaticOrder S; S.init(M, 6400, G, bx); pg8::EpiProj E{(bf16_t*)(p.WS() + WS_PROJ), (float*)(p.WS() + WS_SMALL)};
        pg8::gemm_phase<pg8::EpiProj, pg8::StaticOrder, PG8_ALIGN, PG8_SP2>(lds + RING_OFF, g, S, E); }
    SEAM(5);
    if (IN(6)) { const bool spread = G >= 64; const int NGI = spread ? NGW - 32 : NGW;
        { PART_ENV const bool scanw = spread ? (wave == 7 && vcu < 32) : (gw < 32); const int gi = !spread ? gw : (vcu < 32 ? vcu * 7 + wave : 224 + (vcu - 32) * 8 + wave);
          if (scanw) scan_bh(p, spread ? vcu : gw, lane);
          if (!(spread && scanw)) for (int row = gi; row < M; row += NGI) post_row(p, row, lane); }
        { PART_ENV constexpr int NU = (MP / 8) * 8; const bool scanw = spread && wave == 7 && vcu < 32; const int gi = !spread ? gw : (vcu < 32 ? vcu * 7 + wave : 224 + (vcu - 32) * 8 + wave);
          if (scanw) {}
          else if ((NGI & 7) == 0 && gi < NU) { f32x4 w[4];
#pragma unroll
              for (int k = 0; k < 4; ++k) w[k] = *(const f32x4*)(p.conv_w + (size_t)k * 2048 + 256 * (gi & 7) + 4 * lane);
              u32x2 cur[11], nxt[11]; conv_load(cur, p, gi, lane);
              for (int u = gi; u < NU; u += NGI) { const bool more = u + NGI < NU; if (more) conv_load(nxt, p, u + NGI, lane); conv_compute(cur, w, p, u, lane);
                  if (more) {
#pragma unroll
                      for (int i = 0; i < 11; ++i) cur[i] = nxt[i]; } } }
          else if ((NGI & 7) != 0) { for (int u = gi; u < NU; u += NGI) { f32x4 w[4];
#pragma unroll
              for (int k = 0; k < 4; ++k) w[k] = *(const f32x4*)(p.conv_w + (size_t)k * 2048 + 256 * (u & 7) + 4 * lane);
              u32x2 cur[11]; conv_load(cur, p, u, lane); conv_compute(cur, w, p, u, lane); } } } }
    SEAM(6);
    if (IN(7)) {
#pragma nounroll
      for (int s_ = 0; s_ < 2; ++s_) {
        if ((s_ == 0) == ((vcu & 1) != 0)) { if (a.sub & 8) { PART_ENV mlstm_sample_items(p, lds_raw, vcu, G, tid); } }
        else {
        if (a.sub & 1) { PART_ENV for (int u = vcu; u < 256; u += G) { const int b = u >> 5;
            for (int k = 0; k < 2; ++k) { const int pi = 2 * (u & 31) + k; scores_select_unit(p, lds, b, pi, tid); scores_select_unit(p, lds, b, 127 - pi, tid); } }
          __syncthreads(); }
        if (a.sub & 2) { PART_ENV for (int u = gw; u < 2048; u += NGW) scores_mfma_sample(p, u, lane); }
        if (a.sub & 4) { PART_ENV for (int unit = vcu; unit < 256; unit += G) mlstm_mfma_unit(p, lds, unit, tid); } }
        __syncthreads(); }
    }
    SEAM(7);
    if (IN(9)) {
        { PART_ENV for (int i = tid; i < 2048; i += 512) ((LAS float*)(lds + AT_BIAS))[i] = p.t5[t5_bucket(i >> 3) * 8 + (i & 7)]; }
        __syncthreads();
#pragma nounroll
      for (int s_ = 0; s_ < 2; ++s_) {
        if ((s_ == 0) == ((vcu & 1) != 0)) { if (a.sub & 32) { PART_ENV for (int u = vcu; u < 256; u += G) attn_mfma_sample(p, lds, u >> 1, u & 1, tid); } }
        else { if (a.sub & 16) { PART_ENV for (int u = vcu; u < 256; u += G) { const int b = u >> 5, g = (u >> 4) & 1, qb = u & 15; attn_mfma_block(p, lds, b, qb, g, tid); attn_mfma_block(p, lds, b, 31 - qb, g, tid); } } }
        __syncthreads(); }
        if (a.sub & 64) { PART_ENV for (int row = gw; row < M; row += 2 * NGW) { mlstm_out_row(p, row, lane); if (row + NGW < M) mlstm_out_row(p, row + NGW, lane); } }
    }
    SEAM(9);
    if (IN(10)) { PART_ENV { pg8::Gemm g{CAT, (const bf16_t*)(p.WS() + WS_WOUT), MP, D, D, D}; pg8::StaticOrder S; S.init(MP, D, G, bx, 4); pg8::EpiResidT<true, true> E{(bf16_t*)(p.WS() + WS_XB), (bf16_t*)(p.WS() + WS_XB), mods + 5 * D, 1.0f};
        pg8::gemm_phase<pg8::EpiResidT<true, true>, pg8::StaticOrder, PG8_ALIGN, PG8_SP2>(lds + RING_OFF, g, S, E); }
        __syncthreads();
        { pg8::Gemm g{CAT, (const bf16_t*)(p.WS() + WS_WOUT), M, D, D, 256}; pg8::SplitOrder S{8, G, bx}; pg8::EpiSlab E{(float*)(p.WS() + WS_SLAB)};
        pg8::gemm_phase<pg8::EpiSlab, pg8::SplitOrder, PG8_ALIGN, PG8_SP2>(lds + RING_OFF, g, S, E); } }
    SEAM(10);
    if (IN(11)) { PART_ENV const int nit = fix_rows_n(gw, NGW); for (int it = 0; it < nit; ++it) { const int row = fix_row_at(gw, NGW, it); const float* mr = mods + (size_t)row_bm(row) * NMOD + 6 * D;
        bf16_t* xb = (bf16_t*)(p.WS() + WS_XB) + (size_t)row * D; f32x4 v[8]; row_load_b(v, xb, lane);
        if (row >= MP) { fix_add<8>(v, (const float*)(p.WS() + WS_SLAB) + (size_t)(row - MP) * D, mr - D, 1.0f, lane); row_store_b(v, xb, lane); }
        normmod_q8_vals(v, p.f2_g, mr + D, mr, p.WS() + WS_H8 + (size_t)row * D, (float*)(p.WS() + WS_SA) + row, lane); } }
    SEAM(11);
    if (IN(12)) { PART_ENV pg8::Gemm g{(const bf16_t*)(p.WS() + WS_H8), (const bf16_t*)(p.WS() + WS_W2GU8), M, 2 * FF, D / 2, D / 2}; pg8::StaticOrder S; S.init(MP, 2 * FF, G, bx);
        pg8::EpiSwigluI8 E{ACT, (const float*)(p.WS() + WS_SA), (const float*)(p.WS() + WS_CTL + CTL_CMAX) + 2 * FF, (float*)(p.WS() + WS_RMAXP), p.WS() + WS_ACT8};
        pg8::gemm_phase<pg8::EpiSwigluI8, pg8::StaticOrder, PG8_ALIGN, PG8_SP2>(lds + RING_OFF, g, S, E); }
    if (IN(12) && IN(16)) xcd_barrier(bar);
    if (IN(16)) { PART_ENV
        const int ngemm = G > 88 ? 88 : G, nreq = G > 88 ? G - 88 : G, creq = G > 88 ? bx - 88 : bx;
        if (bx < ngemm) { pg8::Gemm g{(const bf16_t*)(p.WS() + WS_H8), (const bf16_t*)(p.WS() + WS_W2GU8), M, 2 * FF, D / 2, D / 2}; pg8::SampleOrder S; S.init(2 * FF, ngemm, bx);
            pg8::EpiSwigluI8 E{ACT, (const float*)(p.WS() + WS_SA), (const float*)(p.WS() + WS_CTL + CTL_CMAX) + 2 * FF, (float*)(p.WS() + WS_RMAXP), p.WS() + WS_ACT8};
            pg8::gemm_phase<pg8::EpiSwigluI8, pg8::SampleOrder, PG8_ALIGN, PG8_SP2>(lds + RING_OFF, g, S, E); }
        if (creq >= 0) for (int row = creq * 8 + wave; row < MP; row += nreq * 8) requant_act_row(p.WS() + WS_ACT8 + (size_t)row * FF, (const float*)(p.WS() + WS_RMAXP) + (size_t)row * 176, (float*)(p.WS() + WS_SA2) + row, lane); }
    if (IN(16) && IN(13)) xcd_barrier(bar);
    if (IN(13)) { PART_ENV
#pragma nounroll
      for (int s_ = 0; s_ < 2; ++s_) {
        if ((s_ == 0) != ((bx & 1) != 0)) { pg8::Gemm g{(const bf16_t*)(p.WS() + WS_ACT8), (const bf16_t*)(p.WS() + WS_W2D8), MP, D, FF / 2, FF / 2}; pg8::StaticOrder S; S.init(MP, D, G, bx, 4);
        pg8::EpiResidI8T<true, false> E{(bf16_t*)(p.WS() + WS_XB), X, mods + 8 * D, 0.5f, (const float*)(p.WS() + WS_SA2), (const float*)(p.WS() + WS_CTL + CTL_CMAX) + 4 * FF + D};
        pg8::gemm_phase<pg8::EpiResidI8T<true, false>, pg8::StaticOrder, PG8_ALIGN, PG8_SP2>(lds + RING_OFF, g, S, E); }
        else { pg8::Gemm g{ACT, (const bf16_t*)(p.WS() + WS_W2D), M, D, FF, 512}; pg8::SplitOrder S{11, G, (bx & 1) ? (bx >> 1) : (G >> 1) + (bx >> 1)}; pg8::EpiSlab E{(float*)(p.WS() + WS_SLAB)};
        pg8::gemm_phase<pg8::EpiSlab, pg8::SplitOrder, PG8_ALIGN, PG8_SP2>(lds + RING_OFF, g, S, E); }
        __syncthreads(); } }
    SEAM(13);
    if (IN(14)) { PART_ENV for (int t = gw; t < 4 * MS; t += NGW) { int ln = lane; asm volatile("" : "+v"(ln)); const int row = MP + (t >> 2), j0 = 2 * (t & 3);
        const float* mr = mods + (size_t)row_bm(row) * NMOD + 8 * D; const bf16_t* xr = (const bf16_t*)(p.WS() + WS_XB) + (size_t)row * D; const float* slab = (const float*)(p.WS() + WS_SLAB) + (size_t)(row - MP) * D;
        f32x4 v[2], a[2];
#pragma unroll
        for (int jj = 0; jj < 2; ++jj) { const u32x2 w = *(const u32x2*)(xr + 256 * (j0 + jj) + 4 * ln); v[jj][0] = bflo(w.x); v[jj][1] = bfhi(w.x); v[jj][2] = bflo(w.y); v[jj][3] = bfhi(w.y); a[jj] = (f32x4){0.f, 0.f, 0.f, 0.f};
#pragma unroll
            for (int k = 0; k < 11; ++k) a[jj] += ((const f32x4*)(slab + (size_t)k * MS * D))[64 * (j0 + jj) + ln]; }
#pragma unroll
        for (int jj = 0; jj < 2; ++jj) ((f32x4*)(X + (size_t)row * D))[64 * (j0 + jj) + ln] = v[jj] + (((const f32x4*)mr)[64 * (j0 + jj) + ln] * 0.5f) * a[jj]; } }
#undef IN
#undef SEAM
}

extern "C" void kernel_launch(void* const* d_in, const int* in_sizes, int n_in, void* d_out, int out_size, void* d_ws, size_t ws_size, hipStream_t stream) {
    static int ok = 0, grid = 0;
    if (ok == 0) {
        if (n_in != 31 || out_size != (int)O_END || ws_size < WS_END) { fprintf(stderr, "kernel_launch: unexpected shapes: n_in %d out %d ws %zu (need %zu)\n", n_in, out_size, ws_size, (size_t)WS_END); ok = -1; return; }
        if (hipFuncSetAttribute((const void*)mk_fwd, hipFuncAttributeMaxDynamicSharedMemorySize, LDS_BYTES) != hipSuccess) { fprintf(stderr, "kernel_launch: hipFuncSetAttribute(mk_fwd) failed\n"); ok = -1; return; }
        int dev = 0, cus = 0; if (hipGetDevice(&dev) != hipSuccess || hipDeviceGetAttribute(&cus, hipDeviceAttributeMultiprocessorCount, dev) != hipSuccess || cus < 8) { fprintf(stderr, "kernel_launch: device query failed\n"); ok = -1; return; }
        grid = cus;
        ok = 1;
    }
    if (ok < 0) return;
    Ptrs p{};
    const float* const* f = (const float* const*)d_in;
    p.x_p = f[0]; p.x_s = f[1]; p.c_p = f[2]; p.c_s = f[3]; p.cache_k = f[4]; p.cache_v = f[5]; p.cache_ik = f[6]; p.page_table = (const int*)d_in[7];
    p.state_C = f[8]; p.state_n = f[9]; p.state_m = f[10]; p.state_conv = f[11];
    p.f1_g = f[12]; p.f1_wg = f[13]; p.f1_wu = f[14]; p.f1_wd = f[15]; p.mix_g = f[16]; p.w_in = f[17]; p.conv_w = f[18]; p.gate_b = f[19]; p.out_g = f[20]; p.qn_g = f[21]; p.kn_g = f[22]; p.t5 = f[23];
    p.w_out = f[24]; p.f2_g = f[25]; p.f2_wg = f[26]; p.f2_wu = f[27]; p.f2_wd = f[28]; p.w_ada = f[29]; p.b_ada = f[30];
    p.out = (float*)d_out; p.ws_ = (unsigned char*)d_ws;
    if (hipMemsetAsync((char*)d_ws + WS_CTL, 0, CTL_ZERO_BYTES, stream) != hipSuccess) { fprintf(stderr, "kernel_launch: memset failed\n"); return; }
    MkArgs a{}; a.p = p;
    a.sub = 127; a.pad = 0;
#ifdef MK_SEQ
    { static const int seq[] = {MK_SEQ}; for (unsigned i = 0; i < sizeof(seq) / sizeof(seq[0]); ++i) { a.ph_lo = seq[i] & 255; a.ph_hi = a.ph_lo + 1; a.sub = (seq[i] >> 8) ? (seq[i] >> 8) : 127; hipLaunchKernelGGL(mk_fwd, dim3(grid), dim3(512), LDS_BYTES, stream, a); } }
#else
    a.ph_lo = 0; a.ph_hi = 17; hipLaunchKernelGGL(mk_fwd, dim3(grid), dim3(512), LDS_BYTES, stream, a);
#endif
}
```

```cpp
#include <hip/hip_runtime.h>
#include <stdint.h>
#include <stdio.h>

typedef unsigned short bf16_t;
typedef float f32x4 __attribute__((ext_vector_type(4)));
typedef unsigned u32x2 __attribute__((ext_vector_type(2)));
typedef unsigned u32x4 __attribute__((ext_vector_type(4)));
typedef unsigned long long u64;

constexpr int D = 2048, BP = 8, TP = 2048, BS = 128, TS = 4;
constexpr int MP = BP * TP, MS = BS * TS, M = MP + MS;
constexpr int FF = 5632, NMOD = 9 * D, NB = BP + BS;
constexpr int PW = 6224;
constexpr int PROJ_LD = 6144, SMALL_LD = 128;
constexpr int SCS_LD = 2112;
constexpr float EPS = 1e-6f;
constexpr int PC_QM = 0, PC_KM = 1024, PC_VM = 2048, PC_OM = 3072, PC_QA = 4096, PC_KA = 5120, PC_VA = 5376, PC_QI = 5632;

constexpr size_t O_Y = 0;
constexpr size_t O_KP = O_Y + (size_t)M * D;
constexpr size_t O_VP = O_KP + (size_t)MP * 256;
constexpr size_t O_IKP = O_VP + (size_t)MP * 256;
constexpr size_t O_CP = O_IKP + (size_t)MP * 64;
constexpr size_t O_NP = O_CP + (size_t)BP * 4 * 65536;
constexpr size_t O_MP = O_NP + (size_t)BP * 4 * 256;
constexpr size_t O_CVP = O_MP + (size_t)BP * 4;
constexpr size_t O_KS = O_CVP + (size_t)BP * 3 * 2048;
constexpr size_t O_VS = O_KS + (size_t)MS * 256;
constexpr size_t O_IKS = O_VS + (size_t)MS * 256;
constexpr size_t O_CS = O_IKS + (size_t)MS * 64;
constexpr size_t O_NS = O_CS + (size_t)BS * 4 * 65536;
constexpr size_t O_MS = O_NS + (size_t)BS * 4 * 256;
constexpr size_t O_CVS = O_MS + (size_t)BS * 4;
constexpr size_t O_END = O_CVS + (size_t)BS * 3 * 2048;
static_assert(O_END == 80962080, "output size");

constexpr size_t al256(size_t x) { return (x + 255) & ~(size_t)255; }
constexpr size_t WS_CTL = 0;
constexpr size_t WS_MODS = 1u << 20;
constexpr size_t WS_H = al256(WS_MODS + (size_t)NB * NMOD * 4);
constexpr size_t WS_ACT = al256(WS_H + (size_t)M * D * 2);
constexpr size_t WS_PROJ = al256(WS_ACT + (size_t)M * FF * 2);
constexpr size_t WS_SMALL = al256(WS_PROJ + (size_t)M * PROJ_LD * 2);
constexpr size_t WS_QA = al256(WS_SMALL + (size_t)M * SMALL_LD * 4);
constexpr size_t WS_KA = al256(WS_QA + (size_t)M * 1024 * 2);
constexpr size_t WS_QM = al256(WS_KA + (size_t)M * 256 * 2);
constexpr size_t WS_KM = al256(WS_QM + (size_t)M * 1024 * 2);
constexpr size_t WS_HM = al256(WS_KM + (size_t)M * 1024 * 2);
constexpr size_t WS_CAT = al256(WS_HM + (size_t)M * 1024 * 4);
constexpr size_t WS_BC = al256(WS_CAT + (size_t)M * D * 2);
constexpr size_t WS_IG = al256(WS_BC + (size_t)32 * 2048 * 4);
constexpr size_t WS_MM = al256(WS_IG + (size_t)32 * 2048 * 4);
constexpr size_t WS_SC = al256(WS_MM + (size_t)32 * 2048 * 4);
constexpr size_t WS_SCS = al256(WS_SC + (size_t)MP * 2048 * 4);
constexpr size_t WS_MASK = al256(WS_SCS + (size_t)MS * SCS_LD * 4);
constexpr size_t WS_MASKS = al256(WS_MASK + (size_t)MP * 32 * 8);
constexpr size_t WS_KI = al256(WS_MASKS + (size_t)MS * 33 * 8);
constexpr size_t WS_SLAB = al256(WS_KI + (size_t)M * 64 * 2);
constexpr size_t WS_XB = al256(WS_SLAB + (size_t)11 * MS * D * 4);
constexpr size_t WS_H8 = al256(WS_XB + (size_t)M * D * 2);
constexpr size_t WS_SA = al256(WS_H8 + (size_t)M * D);
constexpr size_t WS_W1GU8 = al256(WS_SA + (size_t)M * 4);
constexpr size_t WS_W2GU8 = al256(WS_W1GU8 + (size_t)2 * FF * D);
constexpr size_t WS_ACT8 = al256(WS_W2GU8 + (size_t)2 * FF * D);
constexpr size_t WS_SA2 = al256(WS_ACT8 + (size_t)M * FF);
constexpr size_t WS_RMAXP = al256(WS_SA2 + (size_t)M * 4);
constexpr size_t WS_W1D8 = al256(WS_RMAXP + (size_t)M * 176 * 4);
constexpr size_t WS_W2D8 = al256(WS_W1D8 + (size_t)D * FF);
constexpr size_t WS_W1GU = al256(WS_W2D8 + (size_t)D * FF);
constexpr size_t WS_W1D = al256(WS_W1GU + (size_t)2 * FF * D * 2);
constexpr size_t WS_WIN = al256(WS_W1D + (size_t)D * FF * 2);
constexpr size_t WS_WOUT = al256(WS_WIN + (size_t)6400 * D * 2);
constexpr size_t WS_W2GU = al256(WS_WOUT + (size_t)D * D * 2);
constexpr size_t WS_W2D = al256(WS_W2GU + (size_t)2 * FF * D * 2);
constexpr size_t WS_END = al256(WS_W2D + (size_t)D * FF * 2);

struct Ptrs {
    const float *x_p, *x_s, *c_p, *c_s, *cache_k, *cache_v, *cache_ik; const int* page_table;
    const float *state_C, *state_n, *state_m, *state_conv;
    const float *f1_g, *f1_wg, *f1_wu, *f1_wd, *mix_g, *w_in, *conv_w, *gate_b, *out_g, *qn_g, *kn_g, *t5, *w_out, *f2_g, *f2_wg, *f2_wu, *f2_wd, *w_ada, *b_ada;
    float* out; unsigned char* ws_;
    __device__ __forceinline__ unsigned char* WS() const { const unsigned long long w = (unsigned long long)ws_; unsigned w0 = (unsigned)w, w1 = (unsigned)(w >> 32); asm volatile("" : "+v"(w0), "+v"(w1));
        return (unsigned char*)(__attribute__((address_space(1))) unsigned char*)(((unsigned long long)(unsigned)__builtin_amdgcn_readfirstlane(w1) << 32) | (unsigned)__builtin_amdgcn_readfirstlane(w0)); }
};

__device__ __forceinline__ float bf2f(bf16_t v) { return __uint_as_float(((unsigned)v) << 16); }
__device__ __forceinline__ bf16_t f2bf(float f) { unsigned u = __float_as_uint(f); u += 0x7fffu + ((u >> 16) & 1u); return (bf16_t)(u >> 16); }
__device__ __forceinline__ unsigned pk2(float lo, float hi) { return (unsigned)f2bf(lo) | ((unsigned)f2bf(hi) << 16); }
__device__ __forceinline__ float bflo(unsigned w) { return __uint_as_float(w << 16); }
__device__ __forceinline__ float bfhi(unsigned w) { return __uint_as_float(w & 0xffff0000u); }
__device__ __forceinline__ float wave_sum(float v) {
#pragma unroll
    for (int o = 1; o < 64; o <<= 1) v += __shfl_xor(v, o);
    return v;
}
__device__ __forceinline__ float wave_max(float v) {
#pragma unroll
    for (int o = 1; o < 64; o <<= 1) v = fmaxf(v, __shfl_xor(v, o));
    return v;
}
__device__ __forceinline__ float x16_max(float x) { const auto r = __builtin_amdgcn_permlane16_swap(__float_as_uint(x), __float_as_uint(x), false, false); return fmaxf(__uint_as_float(r[0]), __uint_as_float(r[1])); }
__device__ __forceinline__ float x32_max(float x) { const auto r = __builtin_amdgcn_permlane32_swap(__float_as_uint(x), __float_as_uint(x), false, false); return fmaxf(__uint_as_float(r[0]), __uint_as_float(r[1])); }
__device__ __forceinline__ float x16_sum(float x) { const auto r = __builtin_amdgcn_permlane16_swap(__float_as_uint(x), __float_as_uint(x), false, false); return __uint_as_float(r[0]) + __uint_as_float(r[1]); }
__device__ __forceinline__ float x32_sum(float x) { const auto r = __builtin_amdgcn_permlane32_swap(__float_as_uint(x), __float_as_uint(x), false, false); return __uint_as_float(r[0]) + __uint_as_float(r[1]); }
__device__ __forceinline__ float silu_f(float x) { return x / (1.0f + __expf(-x)); }
__device__ __forceinline__ int row_bm(int row) { return row < MP ? (row >> 11) : BP + ((row - MP) >> 2); }
__device__ __forceinline__ int t5_bucket(int dist) {
    if (dist < 16) return dist;
    const float ratio = logf((float)dist / 16.0f) / 2.0794415416798357f;
    int large = 16 + (int)(ratio * 16.0f);
    return large < 31 ? large : 31;
}

__device__ __forceinline__ void normmod_vals(const f32x4 (&v)[8], const float* g, const float* sc, const float* sh, bf16_t* hr, int lane);
__device__ __forceinline__ void normmod_row(const float* xr, const float* g, const float* sc, const float* sh, bf16_t* hr, int lane) {
    f32x4 v[8];
#pragma unroll
    for (int j = 0; j < 8; ++j) v[j] = ((const f32x4*)xr)[64 * j + lane];
    normmod_vals(v, g, sc, sh, hr, lane);
}
template <int NS> __device__ __forceinline__ void normmod_fix_row(const float* base, const float* slab, const float* gate, const float scale, float* xo, const float* g, const float* sc, const float* sh, bf16_t* hr, int lane) {
    f32x4 v[8];
#pragma unroll
    for (int j = 0; j < 8; ++j) { f32x4 a = (f32x4){0.f, 0.f, 0.f, 0.f};
#pragma unroll
        for (int k = 0; k < NS; ++k) a += ((const f32x4*)(slab + (size_t)k * MS * D))[64 * j + lane];
        v[j] = ((const f32x4*)base)[64 * j + lane] + (((const f32x4*)gate)[64 * j + lane] * scale) * a; ((f32x4*)xo)[64 * j + lane] = v[j]; }
    if (hr) normmod_vals(v, g, sc, sh, hr, lane);
}
__device__ __forceinline__ void normmod_vals(const f32x4 (&v)[8], const float* g, const float* sc, const float* sh, bf16_t* hr, int lane) {
    float ss = 0.f;
#pragma unroll
    for (int j = 0; j < 8; ++j) ss += (v[j][0] * v[j][0] + v[j][1] * v[j][1]) + (v[j][2] * v[j][2] + v[j][3] * v[j][3]);
    ss = wave_sum(ss);
    const float r = 1.0f / sqrtf(ss * (1.0f / D) + EPS);
#pragma unroll
    for (int j = 0; j < 8; ++j) {
        const int col = 256 * j + 4 * lane;
        const f32x4 gg = *(const f32x4*)(g + col), s = *(const f32x4*)(sc + col), h = *(const f32x4*)(sh + col);
        const f32x4 o = v[j] * r * gg * (1.0f + s) + h;
        u32x2 w; w[0] = pk2(o[0], o[1]); w[1] = pk2(o[2], o[3]);
        *(u32x2*)(hr + col) = w;
    }
}

__device__ __forceinline__ void row_load(f32x4 (&v)[8], const float* xr, int lane) {
#pragma unroll
    for (int j = 0; j < 8; ++j) v[j] = ((const f32x4*)xr)[64 * j + lane];
}
__device__ __forceinline__ void row_load_b(f32x4 (&v)[8], const bf16_t* xr, int lane) {
#pragma unroll
    for (int j = 0; j < 8; ++j) { const u32x2 w = *(const u32x2*)(xr + 256 * j + 4 * lane); v[j][0] = bflo(w.x); v[j][1] = bfhi(w.x); v[j][2] = bflo(w.y); v[j][3] = bfhi(w.y); }
}
__device__ __forceinline__ void row_store_b(const f32x4 (&v)[8], bf16_t* xr, int lane) {
#pragma unroll
    for (int j = 0; j < 8; ++j) { u32x2 w; w.x = pk2(v[j][0], v[j][1]); w.y = pk2(v[j][2], v[j][3]); *(u32x2*)(xr + 256 * j + 4 * lane) = w; }
}
template <int NS> __device__ __forceinline__ void fix_add(f32x4 (&v)[8], const float* slab, const float* gate, const float scale, int lane) {
#pragma unroll
    for (int j = 0; j < 8; j += 2) { f32x4 a = (f32x4){0.f, 0.f, 0.f, 0.f}, b = a;
#pragma unroll
        for (int k = 0; k < NS; ++k) { a += ((const f32x4*)(slab + (size_t)k * MS * D))[64 * j + lane]; b += ((const f32x4*)(slab + (size_t)k * MS * D))[64 * (j + 1) + lane]; }
        v[j] += (((const f32x4*)gate)[64 * j + lane] * scale) * a; v[j + 1] += (((const f32x4*)gate)[64 * (j + 1) + lane] * scale) * b;
        asm volatile("" : "+v"(v[j]), "+v"(v[j + 1]) :: "memory"); }
}
__device__ __forceinline__ int fix_rows_n(int gw, int NGW) { return NGW == 2048 ? (gw < 512 ? 6 : 9) : (M - gw + NGW - 1) / NGW; }
__device__ __forceinline__ int fix_row_at(int gw, int NGW, int it) {
    if (NGW != 2048) return gw + it * NGW;
    if (gw < 512) return it == 0 ? MP + gw : gw + (it - 1) * 2048;
    return it < 8 ? gw + it * 2048 : ((gw - 512) & 511) + (5 + ((gw - 512) >> 9)) * 2048;
}
__device__ __forceinline__ unsigned q8x4(float a, float b, float c, float d, float inv) {
    const int qa = (int)rintf(fminf(fmaxf(a * inv, -127.f), 127.f)), qb = (int)rintf(fminf(fmaxf(b * inv, -127.f), 127.f)), qc = (int)rintf(fminf(fmaxf(c * inv, -127.f), 127.f)), qd = (int)rintf(fminf(fmaxf(d * inv, -127.f), 127.f));
    return (unsigned)(qa & 0xff) | ((unsigned)(qb & 0xff) << 8) | ((unsigned)(qc & 0xff) << 16) | ((unsigned)(qd & 0xff) << 24);
}
template <int KW> __device__ __forceinline__ void quant_wrow(const bf16_t* wrow, unsigned char* orow, unsigned* cm, int lane) {
    const float mx = fmaxf(__uint_as_float(*cm), 1e-30f), inv = 127.0f / mx;
#pragma unroll
    for (int j = 0; j < KW / 512; ++j) { const u32x4 w = *(const u32x4*)(wrow + 8 * lane + 512 * j); u32x2 o;
        o.x = q8x4(bflo(w.x), bfhi(w.x), bflo(w.y), bfhi(w.y), inv); o.y = q8x4(bflo(w.z), bfhi(w.z), bflo(w.w), bfhi(w.w), inv);
        *(u32x2*)(orow + 8 * lane + 512 * j) = o; }
    if (lane == 0) *(float*)cm = mx * (1.0f / 127.0f);
}
__device__ __forceinline__ void requant_act_row(unsigned char* arow, const float* rmp, float* sa2, int lane) {
    float mx = fmaxf(rmp[lane], rmp[64 + lane]); if (lane < 48) mx = fmaxf(mx, rmp[128 + lane]);
    mx = fmaxf(wave_max(mx), 1e-30f); const float rinv = 1.0f / mx;
    u32x2 w[11]; float f[11];
#pragma unroll
    for (int j = 0; j < 11; ++j) { w[j] = *(const u32x2*)(arow + 8 * lane + 512 * j); f[j] = rmp[16 * j + (lane >> 2)] * rinv; }
#pragma unroll
    for (int j = 0; j < 11; ++j) { unsigned b[8];
#pragma unroll
        for (int e = 0; e < 4; ++e) { b[e] = __float_as_uint(__builtin_fmaf((float)((w[j].x >> (8 * e)) & 255u) - 128.0f, f[j], 12582912.0f)); b[4 + e] = __float_as_uint(__builtin_fmaf((float)((w[j].y >> (8 * e)) & 255u) - 128.0f, f[j], 12582912.0f)); }
        u32x2 o; o.x = __builtin_amdgcn_perm(b[1], b[0], 0x0c0c0400u) | __builtin_amdgcn_perm(b[3], b[2], 0x04000c0cu); o.y = __builtin_amdgcn_perm(b[5], b[4], 0x0c0c0400u) | __builtin_amdgcn_perm(b[7], b[6], 0x04000c0cu);
        *(u32x2*)(arow + 8 * lane + 512 * j) = o; }
    if (lane == 0) *sa2 = mx * (1.0f / 127.0f);
}
__device__ __forceinline__ void normmod_q8_vals(f32x4 (&v)[8], const float* g, const float* sc, const float* sh, unsigned char* hr, float* sa, int lane) {
    float ss = 0.f;
#pragma unroll
    for (int j = 0; j < 8; ++j) ss += (v[j][0] * v[j][0] + v[j][1] * v[j][1]) + (v[j][2] * v[j][2] + v[j][3] * v[j][3]);
    ss = wave_sum(ss);
    const float r = 1.0f / sqrtf(ss * (1.0f / D) + EPS); float amax = 0.f;
#pragma unroll
    for (int j = 0; j < 8; ++j) { const int col = 256 * j + 4 * lane; const f32x4 gg = *(const f32x4*)(g + col), s = *(const f32x4*)(sc + col), h = *(const f32x4*)(sh + col);
        v[j] = v[j] * r * gg * (1.0f + s) + h; amax = fmaxf(amax, fmaxf(fmaxf(fabsf(v[j][0]), fabsf(v[j][1])), fmaxf(fabsf(v[j][2]), fabsf(v[j][3])))); }
    amax = fmaxf(wave_max(amax), 1e-30f); const float inv = 127.0f / amax;
#pragma unroll
    for (int j = 0; j < 8; ++j) *(unsigned*)(hr + 256 * j + 4 * lane) = q8x4(v[j][0], v[j][1], v[j][2], v[j][3], inv);
    if (lane == 0) *sa = amax * (1.0f / 127.0f);
}
__device__ __forceinline__ void normmod_q8(const float* xr, const float* g, const float* sc, const float* sh, unsigned char* hr, float* sa, int lane) {
    f32x4 v[8];
#pragma unroll
    for (int j = 0; j < 8; ++j) v[j] = ((const f32x4*)xr)[64 * j + lane];
    normmod_q8_vals(v, g, sc, sh, hr, sa, lane);
}
template <int NS> __device__ __forceinline__ void fix_row_vals(f32x4 (&v)[8], const float* base, const float* slab, const float* gate, const float scale, float* xo, int lane) {
#pragma unroll
    for (int j = 0; j < 8; ++j) { f32x4 a = (f32x4){0.f, 0.f, 0.f, 0.f};
#pragma unroll
        for (int k = 0; k < NS; ++k) a += ((const f32x4*)(slab + (size_t)k * MS * D))[64 * j + lane];
        v[j] = ((const f32x4*)base)[64 * j + lane] + (((const f32x4*)gate)[64 * j + lane] * scale) * a; ((f32x4*)xo)[64 * j + lane] = v[j]; }
}

__device__ __forceinline__ void post_row(const Ptrs& p, int row, int lane) {
    const bf16_t* PROJ = (const bf16_t*)(p.WS() + WS_PROJ); const float* SMALL = (const float*)(p.WS() + WS_SMALL);
    const bf16_t* pr = PROJ + (size_t)row * PROJ_LD; const float* sm = SMALL + (size_t)row * SMALL_LD;
    const bool prompt = row < MP; const int b = prompt ? row >> 11 : (row - MP) >> 2, t = prompt ? row & 2047 : (row - MP) & 3;
    const int rrel = prompt ? row : row - MP;
    {
        const u32x4 w0 = *(const u32x4*)(pr + PC_QA + 16 * lane), w1 = *(const u32x4*)(pr + PC_QA + 16 * lane + 8);
        float q[16];
#pragma unroll
        for (int i = 0; i < 4; ++i) { q[2 * i] = bflo(w0[i]); q[2 * i + 1] = bfhi(w0[i]); q[8 + 2 * i] = bflo(w1[i]); q[8 + 2 * i + 1] = bfhi(w1[i]); }
        float ss = 0.f;
#pragma unroll
        for (int i = 0; i < 16; ++i) ss += q[i] * q[i];
        ss += __shfl_xor(ss, 1); ss += __shfl_xor(ss, 2); ss += __shfl_xor(ss, 4);
        const float r = (1.0f / sqrtf(ss * (1.0f / 128.0f) + EPS)) * 0.08838834764831845f;
        const float* gq = p.qn_g + ((16 * lane) & 127);
        u32x4 o0, o1;
#pragma unroll
        for (int i = 0; i < 4; ++i) { o0[i] = pk2(q[2 * i] * r * gq[2 * i], q[2 * i + 1] * r * gq[2 * i + 1]); o1[i] = pk2(q[8 + 2 * i] * r * gq[8 + 2 * i], q[8 + 2 * i + 1] * r * gq[8 + 2 * i + 1]); }
        bf16_t* qa = (bf16_t*)(p.WS() + WS_QA) + (size_t)row * 1024 + 16 * lane;
        *(u32x4*)qa = o0; *(u32x4*)(qa + 8) = o1;
    }
    {
        const u32x2 w = *(const u32x2*)(pr + PC_KA + 4 * lane);
        float k[4] = {bflo(w[0]), bfhi(w[0]), bflo(w[1]), bfhi(w[1])};
        float ss = (k[0] * k[0] + k[1] * k[1]) + (k[2] * k[2] + k[3] * k[3]);
        ss += __shfl_xor(ss, 1); ss += __shfl_xor(ss, 2); ss += __shfl_xor(ss, 4); ss += __shfl_xor(ss, 8); ss += __shfl_xor(ss, 16);
        const float r = 1.0f / sqrtf(ss * (1.0f / 128.0f) + EPS);
        const f32x4 gk = *(const f32x4*)(p.kn_g + ((4 * lane) & 127));
        f32x4 o; o[0] = k[0] * r * gk[0]; o[1] = k[1] * r * gk[1]; o[2] = k[2] * r * gk[2]; o[3] = k[3] * r * gk[3];
        *(f32x4*)(p.out + (prompt ? O_KP : O_KS) + (size_t)rrel * 256 + 4 * lane) = o;
        u32x2 ob; ob[0] = pk2(o[0], o[1]); ob[1] = pk2(o[2], o[3]);
        *(u32x2*)((bf16_t*)(p.WS() + WS_KA) + (size_t)row * 256 + 4 * lane) = ob;
        const u32x2 wv = *(const u32x2*)(pr + PC_VA + 4 * lane);
        f32x4 ov; ov[0] = bflo(wv[0]); ov[1] = bfhi(wv[0]); ov[2] = bflo(wv[1]); ov[3] = bfhi(wv[1]);
        *(f32x4*)(p.out + (prompt ? O_VP : O_VS) + (size_t)rrel * 256 + 4 * lane) = ov;
    }
    { const float kv = sm[lane]; p.out[(prompt ? O_IKP : O_IKS) + (size_t)rrel * 64 + lane] = kv; ((bf16_t*)(p.WS() + WS_KI))[(size_t)row * 64 + lane] = f2bf(kv); }
    if (!prompt) {
        bf16_t* QM = (bf16_t*)(p.WS() + WS_QM); bf16_t* KM = (bf16_t*)(p.WS() + WS_KM);
#pragma unroll
        for (int j = 0; j < 4; ++j) {
            const int c = 8 * lane + 512 * j;
            float xs[4][8];
#pragma unroll
            for (int k = 0; k < 4; ++k) {
                if (t - k >= 0) { const u32x4 w = *(const u32x4*)(pr - (size_t)k * PROJ_LD + c);
#pragma unroll
                    for (int i = 0; i < 4; ++i) { xs[k][2 * i] = bflo(w[i]); xs[k][2 * i + 1] = bfhi(w[i]); } }
                else if (prompt) {
#pragma unroll
                    for (int i = 0; i < 8; ++i) xs[k][i] = 0.f; }
                else { const float* sb = p.state_conv + ((size_t)b * 3 + (3 + t - k)) * 2048 + c; const f32x4 a0 = *(const f32x4*)sb, a1 = *(const f32x4*)(sb + 4);
#pragma unroll
                    for (int i = 0; i < 4; ++i) { xs[k][i] = a0[i]; xs[k][4 + i] = a1[i]; } }
            }
            float y[8];
#pragma unroll
            for (int i = 0; i < 8; ++i) y[i] = 0.f;
#pragma unroll
            for (int k = 0; k < 4; ++k) { const float* wk = p.conv_w + (size_t)(3 - k) * 2048 + c; const f32x4 a0 = *(const f32x4*)wk, a1 = *(const f32x4*)(wk + 4);
#pragma unroll
                for (int i = 0; i < 4; ++i) { y[i] += a0[i] * xs[k][i]; y[4 + i] += a1[i] * xs[k][4 + i]; } }
            const float scl = c < 1024 ? 1.0f : 0.0625f;
            u32x4 o;
#pragma unroll
            for (int i = 0; i < 4; ++i) o[i] = pk2(silu_f(y[2 * i]) * scl, silu_f(y[2 * i + 1]) * scl);
            if (c < 1024) *(u32x4*)(QM + (size_t)row * 1024 + c) = o; else *(u32x4*)(KM + (size_t)row * 1024 + (c - 1024)) = o;
            const int slot = prompt ? t - (TP - 3) : t - 1;
            if (slot >= 0) { float* cv = p.out + (prompt ? O_CVP : O_CVS) + ((size_t)b * 3 + slot) * 2048 + c;
                f32x4 a0, a1;
#pragma unroll
                for (int i = 0; i < 4; ++i) { a0[i] = xs[0][i]; a1[i] = xs[0][4 + i]; }
                *(f32x4*)cv = a0; *(f32x4*)(cv + 4) = a1; }
        }
    }
}
__device__ __forceinline__ void conv_load(u32x2 (&xr)[11], const Ptrs& p, const int unit, const int lane) {
    const bf16_t* PROJ = (const bf16_t*)(p.WS() + WS_PROJ);
    const int rg = unit >> 3, slab = unit & 7, row0 = 8 * rg, t0 = row0 & 2047, c = 256 * slab + 4 * lane;
#pragma unroll
    for (int i = 0; i < 11; ++i) { if (t0 + i - 3 >= 0) xr[i] = *(const u32x2*)(PROJ + (size_t)(row0 + i - 3) * PROJ_LD + c); else { xr[i].x = 0u; xr[i].y = 0u; } }
}
__device__ __forceinline__ void conv_compute(const u32x2 (&xr)[11], const f32x4 (&w)[4], const Ptrs& p, const int unit, const int lane) {
    bf16_t* QM = (bf16_t*)(p.WS() + WS_QM); bf16_t* KM = (bf16_t*)(p.WS() + WS_KM);
    const int rg = unit >> 3, slab = unit & 7, row0 = 8 * rg, t0 = row0 & 2047, b = row0 >> 11, c = 256 * slab + 4 * lane;
    const float scl = c < 1024 ? 1.0f : 0.0625f; bf16_t* dst = c < 1024 ? QM + c : KM + (c - 1024);
#pragma unroll
    for (int i = 0; i < 8; ++i) {
        f32x4 y = (f32x4){0.f, 0.f, 0.f, 0.f};
#pragma unroll
        for (int k = 0; k < 4; ++k) { const u32x2 x = xr[i + k]; f32x4 xv; xv[0] = bflo(x.x); xv[1] = bfhi(x.x); xv[2] = bflo(x.y); xv[3] = bfhi(x.y); y += w[k] * xv; }
        u32x2 o; o.x = pk2(silu_f(y[0]) * scl, silu_f(y[1]) * scl); o.y = pk2(silu_f(y[2]) * scl, silu_f(y[3]) * scl);
        *(u32x2*)(dst + (size_t)(row0 + i) * 1024) = o;
        const int slot = t0 + i - (TP - 3);
        if (slot >= 0) { const u32x2 x = xr[i + 3]; f32x4 xv; xv[0] = bflo(x.x); xv[1] = bfhi(x.x); xv[2] = bflo(x.y); xv[3] = bfhi(x.y); *(f32x4*)(p.out + O_CVP + ((size_t)b * 3 + slot) * 2048 + c) = xv; }
    }
}
__device__ __forceinline__ float logsigmoid_f(float x) { return fminf(x, 0.f) - log1pf(expf(-fabsf(x))); }
__device__ __forceinline__ void scan_bh(const Ptrs& p, int bh, int lane) {
    const float* SMALL = (const float*)(p.WS() + WS_SMALL);
    float* BC = (float*)(p.WS() + WS_BC) + (size_t)bh * 2048; float* IG = (float*)(p.WS() + WS_IG) + (size_t)bh * 2048; float* MMa = (float*)(p.WS() + WS_MM) + (size_t)bh * 2048;
    const int b = bh >> 2, h = bh & 3; const float bi = p.gate_b[h], bfv = p.gate_b[4 + h];
    float lf[32], ig[32];
    float A = 0.f, Bv = -INFINITY;
#pragma unroll
    for (int i = 0; i < 32; ++i) { const float* sm = SMALL + ((size_t)b * 2048 + 32 * lane + i) * SMALL_LD; ig[i] = sm[64 + h] + bi; lf[i] = logsigmoid_f(sm[68 + h] + bfv); A += lf[i]; Bv = fmaxf(Bv + lf[i], ig[i]); }
    const float Aown = A;
#pragma unroll
    for (int off = 1; off < 64; off <<= 1) { const float Ap = __shfl_up(A, off), Bp = __shfl_up(Bv, off); if (lane >= off) { Bv = fmaxf(Bp + A, Bv); A = Ap + A; } }
    float Aex = __shfl_up(A, 1), Bex = __shfl_up(Bv, 1); if (lane == 0) { Aex = 0.f; Bex = -INFINITY; }
    float m = fmaxf(0.0f + Aex, Bex);
    float c = __shfl_up(Aown, 1); if ((lane & 1) == 0) c = 0.f;
#pragma unroll
    for (int i = 0; i < 32; ++i) { m = fmaxf(m + lf[i], ig[i]); c += lf[i]; const int t = 32 * lane + i; MMa[t] = m; BC[t] = c; IG[t] = ig[i]; }
}

__device__ __forceinline__ void mlstm_sample_items(const Ptrs& p, unsigned char* lds, const int first, const int stride, const int tid) {
    float (*qf)[256] = (float (*)[256])(lds); float (*kf)[256] = (float (*)[256])(lds + 4096); float (*vf)[256] = (float (*)[256])(lds + 8192);
    float (*red)[4][256] = (float (*)[4][256])(lds + 12288);
    float* bc = (float*)(lds + 12288 + 32768); float* ig = bc + 4; float* mm = bc + 8; float* sw = bc + 12; float* wl = bc + 16; float (*Pm)[4] = (float (*)[4])(bc + 20); float* qn = bc + 36; float* sc2 = bc + 40;
    const int lane = tid & 63, wv = tid >> 6;
    const bf16_t* QM = (const bf16_t*)(p.WS() + WS_QM); const bf16_t* KM = (const bf16_t*)(p.WS() + WS_KM); const bf16_t* PROJ = (const bf16_t*)(p.WS() + WS_PROJ); const float* SMALL = (const float*)(p.WS() + WS_SMALL);
    float* HM = (float*)(p.WS() + WS_HM);
    for (int item = first; item < BS * 4; item += stride) {
        const int b = item >> 2, h = item & 3; const size_t r0 = (size_t)MP + 4 * b;
        for (int i = tid; i < 1024; i += 512) { const int t = i >> 8, d = i & 255;
            qf[t][d] = bf2f(QM[(r0 + t) * 1024 + h * 256 + d]); kf[t][d] = bf2f(KM[(r0 + t) * 1024 + h * 256 + d]); vf[t][d] = bf2f(PROJ[(r0 + t) * PROJ_LD + PC_VM + h * 256 + d]); }
        if (tid == 0) {
            const float m0 = p.state_m[item]; float m = m0, c = 0.f;
            for (int t = 0; t < 4; ++t) { const float* sm = SMALL + (r0 + t) * SMALL_LD; const float igt = sm[64 + h] + p.gate_b[h], lft = logsigmoid_f(sm[68 + h] + p.gate_b[4 + h]);
                m = fmaxf(m + lft, igt); c += lft; bc[t] = c; ig[t] = igt; mm[t] = m; sw[t] = expf(c + m0 - m); }
            for (int t = 0; t < 4; ++t) wl[t] = expf(bc[3] - bc[t] + ig[t] - mm[3]);
            sc2[0] = expf(bc[3] + m0 - mm[3]);
        }
        __syncthreads();
        if (wv < 4) {
            const int t = wv; float a = 0.f, d0 = 0.f, d1 = 0.f, d2 = 0.f, d3 = 0.f;
            for (int i = 0; i < 4; ++i) { const int d = lane + 64 * i; const float qv = qf[t][d]; a += qv * p.state_n[(size_t)item * 256 + d]; d0 += qv * kf[0][d]; d1 += qv * kf[1][d]; d2 += qv * kf[2][d]; d3 += qv * kf[3][d]; }
            a = wave_sum(a); d0 = wave_sum(d0); d1 = wave_sum(d1); d2 = wave_sum(d2); d3 = wave_sum(d3);
            if (lane == 0) { qn[t] = a; const float dd[4] = {d0, d1, d2, d3};
                for (int s = 0; s < 4; ++s) Pm[t][s] = s <= t ? dd[s] * expf(bc[t] - bc[s] + ig[s] - mm[t]) : 0.f; }
        }
        __syncthreads();
        {
            const int e = 4 * lane; const float decay = sc2[0];
            f32x4 qc[4]; for (int t = 0; t < 4; ++t) qc[t] = (f32x4){0.f, 0.f, 0.f, 0.f};
            f32x4 vv[4]; for (int s = 0; s < 4; ++s) vv[s] = *(const f32x4*)&vf[s][e];
            const float* Cin = p.state_C + (size_t)item * 65536; float* Cout = p.out + O_CS + (size_t)item * 65536;
            for (int i0 = 0; i0 < 32; i0 += 8) { f32x4 c8[8];
#pragma unroll
                for (int ii = 0; ii < 8; ++ii) c8[ii] = *(const f32x4*)(Cin + (size_t)(wv + 8 * (i0 + ii)) * 256 + e);
#pragma unroll
                for (int ii = 0; ii < 8; ++ii) { const int d = wv + 8 * (i0 + ii); const f32x4 c0 = c8[ii];
                    f32x4 cn = c0 * decay;
#pragma unroll
                    for (int s = 0; s < 4; ++s) cn += (wl[s] * kf[s][d]) * vv[s];
                    *(f32x4*)(Cout + (size_t)d * 256 + e) = cn;
#pragma unroll
                    for (int t = 0; t < 4; ++t) qc[t] += qf[t][d] * c0; } }
#pragma unroll
            for (int t = 0; t < 4; ++t) *(f32x4*)&red[wv][t][e] = qc[t];
        }
        __syncthreads();
        for (int i = tid; i < 1024; i += 512) { const int t = i >> 8, e = i & 255; float QC = 0.f;
#pragma unroll
            for (int w = 0; w < 8; ++w) QC += red[w][t][e];
            float num = sw[t] * QC, rs = 0.f;
            for (int s = 0; s <= t; ++s) { num += Pm[t][s] * vf[s][e]; rs += Pm[t][s]; }
            const float den = rs + sw[t] * qn[t];
            HM[(r0 + t) * 1024 + h * 256 + e] = num / fmaxf(fabsf(den), expf(-mm[t])); }
        if (tid < 256) { const int d = tid; float a = sc2[0] * p.state_n[(size_t)item * 256 + d]; for (int s = 0; s < 4; ++s) a += wl[s] * kf[s][d]; p.out[O_NS + (size_t)item * 256 + d] = a; }
        if (tid == 0) p.out[O_MS + item] = mm[3];
        __syncthreads();
    }
}

__device__ __forceinline__ void mlstm_out_row(const Ptrs& p, const int row, const int lane) {
    const float* HM = (const float*)(p.WS() + WS_HM); const bf16_t* PROJ = (const bf16_t*)(p.WS() + WS_PROJ); bf16_t* CAT = (bf16_t*)(p.WS() + WS_CAT);
    {
        const float* hr = HM + (size_t)row * 1024 + 16 * lane; float hv[16];
#pragma unroll
        for (int i = 0; i < 4; ++i) { const f32x4 a = *(const f32x4*)(hr + 4 * i); hv[4 * i] = a[0]; hv[4 * i + 1] = a[1]; hv[4 * i + 2] = a[2]; hv[4 * i + 3] = a[3]; }
        float ss = 0.f;
#pragma unroll
        for (int i = 0; i < 16; ++i) ss += hv[i] * hv[i];
        ss += __shfl_xor(ss, 1); ss += __shfl_xor(ss, 2); ss += __shfl_xor(ss, 4); ss += __shfl_xor(ss, 8);
        const float r = 1.0f / sqrtf(ss * (1.0f / 256.0f) + EPS);
        const bf16_t* orow = PROJ + (size_t)row * PROJ_LD + PC_OM + 16 * lane; const u32x4 w0 = *(const u32x4*)orow, w1 = *(const u32x4*)(orow + 8);
        float ov[16];
#pragma unroll
        for (int i = 0; i < 4; ++i) { ov[2 * i] = bflo(w0[i]); ov[2 * i + 1] = bfhi(w0[i]); ov[8 + 2 * i] = bflo(w1[i]); ov[8 + 2 * i + 1] = bfhi(w1[i]); }
        const float* g = p.out_g + 16 * lane; u32x4 o0, o1;
#pragma unroll
        for (int i = 0; i < 4; ++i) {
            const float a0 = hv[2 * i] * r * g[2 * i] / (1.0f + __expf(-ov[2 * i])), a1 = hv[2 * i + 1] * r * g[2 * i + 1] / (1.0f + __expf(-ov[2 * i + 1]));
            const float b0 = hv[8 + 2 * i] * r * g[8 + 2 * i] / (1.0f + __expf(-ov[8 + 2 * i])), b1 = hv[8 + 2 * i + 1] * r * g[8 + 2 * i + 1] / (1.0f + __expf(-ov[8 + 2 * i + 1]));
            o0[i] = pk2(a0, a1); o1[i] = pk2(b0, b1); }
        bf16_t* cr = CAT + (size_t)row * D + 16 * lane; *(u32x4*)cr = o0; *(u32x4*)(cr + 8) = o1;
    }
}

__device__ __forceinline__ unsigned order_key(float x) { const unsigned bts = __float_as_uint(x); return (bts & 0x80000000u) ? ~bts : (bts | 0x80000000u); }
template <int NREG> __device__ __forceinline__ void select_load(float (&raw)[NREG], const float* sc, int lane) {
#pragma unroll
    for (int i = 0; i < NREG; ++i) raw[i] = sc[64 * i + lane];
}
template <int NREG> __device__ __forceinline__ void select_compute(const float (&raw)[NREG], int nvalid, u64* mask, int lane) {
    unsigned u[NREG];
#pragma unroll
    for (int i = 0; i < NREG; ++i) { const int s = 64 * i + lane; u[i] = s < nvalid ? order_key(raw[i]) : 0u; }
    if (nvalid <= 256) {
#pragma unroll
        for (int i = 0; i < NREG; ++i) { const u64 mk = __ballot(64 * i + lane < nvalid); if (lane == 0) mask[i] = mk; }
        return;
    }
    unsigned T = 0u; bool exact = false;
    for (int bit = 31; bit >= 0; --bit) {
        const unsigned cand = T | (1u << bit);
        int cnt = 0;
#pragma unroll
        for (int i = 0; i + 3 < NREG; i += 4) if (64 * i < nvalid) { u64 m0, m1, m2, m3;
            asm volatile("v_cmp_ge_u32_e64 %0, %4, %8\n\tv_cmp_ge_u32_e64 %1, %5, %8\n\tv_cmp_ge_u32_e64 %2, %6, %8\n\tv_cmp_ge_u32_e64 %3, %7, %8\n\ts_nop 4"
                         : "=&s"(m0), "=&s"(m1), "=&s"(m2), "=&s"(m3) : "v"(u[i]), "v"(u[i + 1]), "v"(u[i + 2]), "v"(u[i + 3]), "s"(cand));
            cnt += (__popcll(m0) + __popcll(m1)) + (__popcll(m2) + __popcll(m3)); }
#pragma unroll
        for (int i = NREG & ~3; i < NREG; ++i) cnt += __popcll(__ballot(u[i] >= cand));
        if (cnt >= 256) T = cand;
        if (cnt == 256) { exact = true; break; }
    }
    if (exact) {
#pragma unroll
        for (int i = 0; i < NREG; ++i) { const u64 mk = __ballot(u[i] >= T); if (lane == 0) mask[i] = mk; }
        return;
    }
    int G = 0;
#pragma unroll
    for (int i = 0; i < NREG; ++i) G += __popcll(__ballot(u[i] > T));
    int need = 256 - G;
#pragma unroll
    for (int i = 0; i < NREG; ++i) {
        const u64 gt = __ballot(u[i] > T), eq = __ballot(u[i] == T); const int c = __popcll(eq); u64 take;
        if (c <= need) { take = eq; need -= c; }
        else { u64 mrem = eq; take = 0ull; for (int k = 0; k < need; ++k) { const u64 low = mrem & (~mrem + 1ull); take |= low; mrem ^= low; } need = 0; }
        if (lane == 0) mask[i] = gt | take;
    }
}

namespace pg8 {
#define PG8_LAS __attribute__((address_space(3)))
typedef unsigned short bf16_t;
typedef short bf16x8 __attribute__((ext_vector_type(8)));
typedef float f32x4 __attribute__((ext_vector_type(4)));
typedef unsigned u32x4 __attribute__((ext_vector_type(4)));
typedef int i32x4 __attribute__((ext_vector_type(4)));
constexpr int BM = 256, BK = 64, HALF = 128, HTB = HALF * BK * 2  , STAGE_BYTES = 8 * HTB, NXCD = 8, WGM = 8;

__host__ __device__ __forceinline__ int lds_byte(int r, int c) { const int st = (r >> 4) * 2 + (c >> 5), rr = r & 15, cc = c & 31, ob = rr * 64 + cc * 2; return st * 1024 + (ob ^ (((ob >> 9) & 1) << 5)); }
__host__ __device__ __forceinline__ void stage_rc(int b, int& R, int& C) { const int st = b / 1024, sb = b % 1024, swz = sb ^ (((sb >> 9) & 1) << 5); R = (st >> 1) * 16 + swz / 64; C = (st & 1) * 32 + (swz % 64) / 2; }
__host__ __device__ __forceinline__ int perm32(int rho) { const int n = rho >> 4, i = rho & 15; return 8 * (i >> 2) + 4 * n + (i & 3); }

struct Unit { int pm, pn, pk; };
struct Gemm { const bf16_t* A; const bf16_t* Bt; int M, N, K, KL; };

struct StaticOrder {
    int nM, nN, nwg, G, c, wgm;
    __host__ __device__ void init(int M, int N, int G_, int c_, int wgm_ = WGM) { nM = M / BM; nN = N / BM; nwg = nM * nN; G = G_; c = c_; wgm = wgm_; }
    __host__ __device__ bool next(int i, Unit& u) const {
        const long L = (long)i * G + c; if (L >= nwg) return false;
        int wgid = (int)L; { const int q = nwg / NXCD, r = nwg % NXCD, xcd = wgid % NXCD, off = wgid / NXCD; wgid = (xcd < r ? xcd * (q + 1) : r * (q + 1) + (xcd - r) * q) + off; }
        const int nig = wgm * nN, gid = wgid / nig, fm = gid * wgm, gsz = (nM - fm) < wgm ? (nM - fm) : wgm;
        u.pm = fm + ((wgid % nig) % gsz); u.pn = (wgid % nig) / gsz; u.pk = 0; return true;
    }
    __device__ __forceinline__ void a_ready(const Unit&) const {}
    __device__ __forceinline__ void done(const Unit&) const {}
};
struct SampleOrder {
    StaticOrder S;
    __host__ __device__ void init(int N, int G_, int c_) { S.init(MS, N, G_, c_); }
    __host__ __device__ bool next(int i, Unit& u) const { if (!S.next(i, u)) return false; u.pm += MP / BM; return true; }
    __device__ __forceinline__ void a_ready(const Unit&) const {}
    __device__ __forceinline__ void done(const Unit&) const {}
};


typedef float f32x2_t __attribute__((ext_vector_type(2)));
typedef __bf16 bf16x2_t __attribute__((ext_vector_type(2)));
__device__ __forceinline__ unsigned cvt_pk_bf16(float lo, float hi) { const f32x2_t v = {lo, hi}; const bf16x2_t b = __builtin_convertvector(v, bf16x2_t); return __builtin_bit_cast(unsigned, b); }
__device__ __forceinline__ float silu_fast(float x) { return x * __builtin_amdgcn_rcpf(1.0f + __expf(-x)); }

struct EpiSwiglu {
    typedef f32x4 AccT; static constexpr bool PERM = true, AFTER_DRAIN = false;
    bf16_t* O;
    __device__ __forceinline__ void operator()(const f32x4 (&acc)[2][2][4][2], const Unit& u, int wr, int wc, int fr, int fq) const {
        const int row0 = u.pm * BM + wr * 64 + fr, col0 = u.pn * HALF + wc * 32 + 8 * fq;
#pragma unroll
        for (int ai = 0; ai < 2; ++ai)
#pragma unroll
            for (int m = 0; m < 4; ++m) { bf16_t* rowp = O + (size_t)(row0 + ai * HALF + m * 16) * FF + col0;
                const f32x4 g0 = acc[ai][0][m][0], g1 = acc[ai][0][m][1], u0 = acc[ai][1][m][0], u1 = acc[ai][1][m][1];
                u32x4 w; w.x = cvt_pk_bf16(silu_fast(g0[0]) * u0[0], silu_fast(g0[1]) * u0[1]); w.y = cvt_pk_bf16(silu_fast(g0[2]) * u0[2], silu_fast(g0[3]) * u0[3]);
                w.z = cvt_pk_bf16(silu_fast(g1[0]) * u1[0], silu_fast(g1[1]) * u1[1]); w.w = cvt_pk_bf16(silu_fast(g1[2]) * u1[2], silu_fast(g1[3]) * u1[3]);
                *(u32x4*)rowp = w; }
    }
};
struct EpiSwigluI8 {
    typedef i32x4 AccT; static constexpr bool PERM = true, AFTER_DRAIN = false;
    bf16_t* O; const float* sa; const float* sb; float* rmaxp; unsigned char* O8;
    __device__ __forceinline__ void operator()(const i32x4 (&acc)[2][2][4][2], const Unit& u, int wr, int wc, int fr, int fq) const {
        const int row0 = u.pm * BM + wr * 64 + fr, col0 = u.pn * HALF + wc * 32 + 8 * fq, brow = u.pn * BM + wc * 32 + 8 * fq;
        const f32x4 sg0 = *(const f32x4*)(sb + brow), sg1 = *(const f32x4*)(sb + brow + 4), su0 = *(const f32x4*)(sb + brow + HALF), su1 = *(const f32x4*)(sb + brow + HALF + 4);
#pragma unroll
        for (int ai = 0; ai < 2; ++ai)
#pragma unroll
            for (int m = 0; m < 4; ++m) { const int row = row0 + ai * HALF + m * 16; const float sr = sa[row]; bf16_t* rowp = O + (size_t)row * FF + col0;
                const i32x4 g0 = acc[ai][0][m][0], g1 = acc[ai][0][m][1], u0 = acc[ai][1][m][0], u1 = acc[ai][1][m][1];
                float o[8];
#pragma unroll
                for (int e = 0; e < 4; ++e) { o[e] = silu_fast((float)g0[e] * (sr * sg0[e])) * ((float)u0[e] * (sr * su0[e])); o[4 + e] = silu_fast((float)g1[e] * (sr * sg1[e])) * ((float)u1[e] * (sr * su1[e])); }
                float mx = fmaxf(fmaxf(fmaxf(fabsf(o[0]), fabsf(o[1])), fmaxf(fabsf(o[2]), fabsf(o[3]))), fmaxf(fmaxf(fabsf(o[4]), fabsf(o[5])), fmaxf(fabsf(o[6]), fabsf(o[7]))));
                mx = x32_max(x16_max(mx));
                if (u.pm < MP / BM) {
                    const float inv = 127.0f / fmaxf(mx, 1e-30f); unsigned b[8];
#pragma unroll
                    for (int e = 0; e < 8; ++e) b[e] = __float_as_uint(__builtin_fmaf(o[e], inv, 12583040.0f));
                    u32x2 w8; w8.x = __builtin_amdgcn_perm(b[1], b[0], 0x0c0c0400u) | __builtin_amdgcn_perm(b[3], b[2], 0x04000c0cu); w8.y = __builtin_amdgcn_perm(b[5], b[4], 0x0c0c0400u) | __builtin_amdgcn_perm(b[7], b[6], 0x04000c0cu);
                    *(u32x2*)(O8 + (size_t)row * FF + col0) = w8;
                    if (fq == 0) rmaxp[(size_t)row * 176 + u.pn * 4 + wc] = mx;
                } else { u32x4 w; w.x = cvt_pk_bf16(o[0], o[1]); w.y = cvt_pk_bf16(o[2], o[3]); w.z = cvt_pk_bf16(o[4], o[5]); w.w = cvt_pk_bf16(o[6], o[7]); *(u32x4*)rowp = w; } }
    }
};
struct EpiResid {
    typedef f32x4 AccT; static constexpr bool PERM = false, AFTER_DRAIN = false;
    const float* base_p; const float* base_s; float* out; const float* gate; float scale;
    __device__ __forceinline__ void operator()(const f32x4 (&acc)[2][2][4][2], const Unit& u, int wr, int wc, int fr, int fq) const {
        const int col0 = u.pn * BM + wc * 32 + 4 * fq;
#pragma unroll
        for (int ai = 0; ai < 2; ++ai)
#pragma unroll
            for (int m = 0; m < 4; ++m) { const int row = u.pm * BM + ai * HALF + wr * 64 + m * 16 + fr;
                const float* bp = (row < MP ? base_p + (size_t)row * D : base_s + (size_t)(row - MP) * D) + col0;
                const float* gp = gate + (size_t)row_bm(row) * NMOD + col0; float* op = out + (size_t)row * D + col0;
#pragma unroll
                for (int bj = 0; bj < 2; ++bj)
#pragma unroll
                    for (int n = 0; n < 2; ++n) { const int o = bj * HALF + n * 16; const f32x4 bs = *(const f32x4*)(bp + o), g = *(const f32x4*)(gp + o);
                        *(f32x4*)(op + o) = bs + (g * scale) * acc[ai][bj][m][n]; } }
    }
};
template <bool BB, bool OB> struct EpiResidT {
    typedef f32x4 AccT; static constexpr bool PERM = false, AFTER_DRAIN = false;
    const void* base; void* out; const float* gate; float scale;
    __device__ __forceinline__ void operator()(const f32x4 (&acc)[2][2][4][2], const Unit& u, int wr, int wc, int fr, int fq) const {
        const int col0 = u.pn * BM + wc * 32 + 4 * fq, row0 = u.pm * BM + wr * 64 + fr;
        const float* gp = gate + (size_t)(u.pm >> 3) * NMOD + col0;
#pragma unroll
        for (int bj = 0; bj < 2; ++bj)
#pragma unroll
            for (int n = 0; n < 2; ++n) { const int o = bj * HALF + n * 16; const f32x4 gs = *(const f32x4*)(gp + o) * scale;
#pragma unroll
                for (int ai = 0; ai < 2; ++ai) { f32x4 bs[4];
#pragma unroll
                    for (int m = 0; m < 4; ++m) { const size_t off = (size_t)(row0 + ai * HALF + m * 16) * D + col0 + o;
                        if (BB) { const u32x2 w = *(const u32x2*)((const bf16_t*)base + off); bs[m][0] = bflo(w.x); bs[m][1] = bfhi(w.x); bs[m][2] = bflo(w.y); bs[m][3] = bfhi(w.y); }
                        else bs[m] = *(const f32x4*)((const float*)base + off); }
#pragma unroll
                    for (int m = 0; m < 4; ++m) { const size_t off = (size_t)(row0 + ai * HALF + m * 16) * D + col0 + o; const f32x4 v = bs[m] + gs * acc[ai][bj][m][n];
                        if (OB) { u32x2 w; w.x = cvt_pk_bf16(v[0], v[1]); w.y = cvt_pk_bf16(v[2], v[3]); *(u32x2*)((bf16_t*)out + off) = w; }
                        else *(f32x4*)((float*)out + off) = v; }
                    asm volatile("" ::: "memory"); } }
    }
};
template <bool BB, bool OB> struct EpiResidI8T {
    typedef i32x4 AccT; static constexpr bool PERM = false, AFTER_DRAIN = false;
    const void* base; void* out; const float* gate; float scale; const float* sa; const float* sb;
    __device__ __forceinline__ void operator()(const i32x4 (&acc)[2][2][4][2], const Unit& u, int wr, int wc, int fr, int fq) const {
        const int col0 = u.pn * BM + wc * 32 + 4 * fq, row0 = u.pm * BM + wr * 64 + fr;
        const float* gp = gate + (size_t)(u.pm >> 3) * NMOD + col0;
        float sr[2][4];
#pragma unroll
        for (int ai = 0; ai < 2; ++ai)
#pragma unroll
            for (int m = 0; m < 4; ++m) sr[ai][m] = sa[row0 + ai * HALF + m * 16] * scale;
#pragma unroll
        for (int bj = 0; bj < 2; ++bj)
#pragma unroll
            for (int n = 0; n < 2; ++n) { const int o = bj * HALF + n * 16; const f32x4 gs = *(const f32x4*)(sb + col0 + o) * *(const f32x4*)(gp + o);
#pragma unroll
                for (int ai = 0; ai < 2; ++ai) { f32x4 bs[4];
#pragma unroll
                    for (int m = 0; m < 4; ++m) { const size_t off = (size_t)(row0 + ai * HALF + m * 16) * D + col0 + o;
                        if (BB) { const u32x2 w = *(const u32x2*)((const bf16_t*)base + off); bs[m][0] = bflo(w.x); bs[m][1] = bfhi(w.x); bs[m][2] = bflo(w.y); bs[m][3] = bfhi(w.y); }
                        else bs[m] = *(const f32x4*)((const float*)base + off); }
#pragma unroll
                    for (int m = 0; m < 4; ++m) { const size_t off = (size_t)(row0 + ai * HALF + m * 16) * D + col0 + o; const i32x4 a = acc[ai][bj][m][n];
                        f32x4 v; v[0] = (float)a[0]; v[1] = (float)a[1]; v[2] = (float)a[2]; v[3] = (float)a[3];
                        v = bs[m] + (gs * sr[ai][m]) * v;
                        if (OB) { u32x2 w; w.x = cvt_pk_bf16(v[0], v[1]); w.y = cvt_pk_bf16(v[2], v[3]); *(u32x2*)((bf16_t*)out + off) = w; }
                        else *(f32x4*)((float*)out + off) = v; }
                    asm volatile("" ::: "memory"); } }
    }
};
struct SplitOrder {
    int NS, G, c;
    __device__ __forceinline__ bool next(int i, Unit& u) const { const int L = i * G + c; if (L >= 16 * NS) return false; const int tile = L / NS; u.pk = L - tile * NS; u.pm = 64 + (tile >> 3); u.pn = tile & 7; return true; }
    __device__ __forceinline__ void a_ready(const Unit&) const {}
    __device__ __forceinline__ void done(const Unit&) const {}
};
struct EpiSlab {
    typedef f32x4 AccT; static constexpr bool PERM = false, AFTER_DRAIN = false;
    float* slab;
    __device__ __forceinline__ void operator()(const f32x4 (&acc)[2][2][4][2], const Unit& u, int wr, int wc, int fr, int fq) const {
        const int col0 = u.pn * BM + wc * 32 + 4 * fq;
#pragma unroll
        for (int ai = 0; ai < 2; ++ai)
#pragma unroll
            for (int m = 0; m < 4; ++m) { const int row = (u.pm - 64) * BM + ai * HALF + wr * 64 + m * 16 + fr; float* op = slab + ((size_t)u.pk * MS + row) * D + col0;
#pragma unroll
                for (int bj = 0; bj < 2; ++bj)
#pragma unroll
                    for (int n = 0; n < 2; ++n) *(f32x4*)(op + bj * HALF + n * 16) = acc[ai][bj][m][n]; }
    }
};
struct EpiProj {
    typedef f32x4 AccT; static constexpr bool PERM = true, AFTER_DRAIN = false;
    bf16_t* PROJ; float* SMALL;
    __device__ __forceinline__ void operator()(const f32x4 (&acc)[2][2][4][2], const Unit& u, int wr, int wc, int fr, int fq) const {
        const int row0 = u.pm * BM + wr * 64 + fr;
        if (u.pn < 24) {
            const int col0 = u.pn * BM + wc * 32 + 8 * fq;
#pragma unroll
            for (int ai = 0; ai < 2; ++ai)
#pragma unroll
                for (int m = 0; m < 4; ++m) { bf16_t* rowp = PROJ + (size_t)(row0 + ai * HALF + m * 16) * PROJ_LD + col0;
#pragma unroll
                    for (int bj = 0; bj < 2; ++bj) { const f32x4 v0 = acc[ai][bj][m][0], v1 = acc[ai][bj][m][1];
                        u32x4 w; w.x = cvt_pk_bf16(v0[0], v0[1]); w.y = cvt_pk_bf16(v0[2], v0[3]); w.z = cvt_pk_bf16(v1[0], v1[1]); w.w = cvt_pk_bf16(v1[2], v1[3]);
                        *(u32x4*)(rowp + bj * HALF) = w; } }
        } else {
            const int col0 = wc * 32 + 8 * fq;
#pragma unroll
            for (int ai = 0; ai < 2; ++ai)
#pragma unroll
                for (int m = 0; m < 4; ++m) { float* rowp = SMALL + (size_t)(row0 + ai * HALF + m * 16) * SMALL_LD + col0;
                    *(f32x4*)rowp = acc[ai][0][m][0]; *(f32x4*)(rowp + 4) = acc[ai][0][m][1]; }
        }
    }
};

template <class T> struct Mma16;
template <> struct Mma16<f32x4> { static __device__ __forceinline__ f32x4 op(bf16x8 a, bf16x8 b, f32x4 c) { return __builtin_amdgcn_mfma_f32_16x16x32_bf16(a, b, c, 0, 0, 0); } };
template <> struct Mma16<i32x4> { static __device__ __forceinline__ i32x4 op(bf16x8 a, bf16x8 b, i32x4 c) { return __builtin_amdgcn_mfma_i32_16x16x64_i8(__builtin_bit_cast(i32x4, a), __builtin_bit_cast(i32x4, b), c, 0, 0, 0); } };
template <class Epi, class Sched, bool ALIGN_EPI = false, bool SP2 = false>
__device__ __forceinline__ void gemm_phase(PG8_LAS unsigned char* lds, const Gemm g, const Sched& S, const Epi& E) {
    int tid = threadIdx.x; asm volatile("" : "+v"(tid));
    const int wid = __builtin_amdgcn_readfirstlane(tid >> 6), lane = tid & 63, wr = wid >> 2, wc = wid & 3, fr = lane & 15, fq = lane >> 4;
    const int K = g.K, nt = g.KL / BK; const size_t kslice = (size_t)g.KL * 2;
    unsigned voffA[2], voffB[2];
#pragma unroll
    for (int i = 0; i < 2; ++i) { int R, C; stage_rc(tid * 16 + i * 8192, R, C); const int Rb = Epi::PERM ? ((R & ~31) + perm32(R & 31)) : R;
        voffA[i] = (unsigned)(R * K + C) * 2u; voffB[i] = (unsigned)(Rb * K + C) * 2u; }
    const size_t kstep = (size_t)(BK * 2);
    const size_t hstep = (size_t)HALF * K * 2;
    const size_t tstep = 2 * hstep;
    const unsigned ldsw = (unsigned)wid * 1024u;
    const int aoff = lds_byte(wr * 64 + fr, fq * 8), boff = lds_byte(wc * 32 + fr, fq * 8);
#define PG8_SA(b, h) (((b) * 2 + (h)) * HTB)
#define PG8_SB(b, h) ((4 + (b) * 2 + (h)) * HTB)
#define PG8_STAGE(bufoff, gbase, voff) do { _Pragma("unroll") for (int _i = 0; _i < 2; ++_i) \
        __builtin_amdgcn_global_load_lds((const unsigned*)((const char*)(gbase) + (voff)[_i]), (PG8_LAS unsigned*)(lds + (bufoff) + ldsw + _i * 8192), 16, 0, 0); } while (0)
#define PG8_LDA(dst, b, h) do { _Pragma("unroll") for (int m = 0; m < 4; ++m) _Pragma("unroll") for (int k = 0; k < 2; ++k) dst[m][k] = *(const PG8_LAS bf16x8*)(lds + PG8_SA(b, h) + aoff + m * 2048 + k * 1024); } while (0)
#define PG8_LDB(dst, b, h) do { _Pragma("unroll") for (int n = 0; n < 2; ++n) _Pragma("unroll") for (int k = 0; k < 2; ++k) dst[n][k] = *(const PG8_LAS bf16x8*)(lds + PG8_SB(b, h) + boff + n * 2048 + k * 1024); } while (0)
#define PG8_MMA(ai, bj, At, Bt) do { __builtin_amdgcn_s_setprio(1); _Pragma("unroll") for (int m = 0; m < 4; ++m) _Pragma("unroll") for (int n = 0; n < 2; ++n) _Pragma("unroll") for (int k = 0; k < 2; ++k) \
        acc[ai][bj][m][n] = Mma16<AccT>::op(Bt[n][k], At[m][k], acc[ai][bj][m][n]); __builtin_amdgcn_s_setprio(0); } while (0)
#define PG8_WAIT_V(n) asm volatile("s_waitcnt vmcnt(" #n ")" ::: "memory")
#define PG8_WAIT_L(n) asm volatile("s_waitcnt lgkmcnt(" #n ")" ::: "memory")
#define PG8_BAR __builtin_amdgcn_s_barrier()
#define PG8_SCHED __builtin_amdgcn_sched_barrier(0)
    Unit cur, nxt; int ui = 0;
    if (!S.next(0, cur)) return;
    typedef typename Epi::AccT AccT; AccT acc[2][2][4][2];
#pragma unroll
    for (int a = 0; a < 2; ++a)
#pragma unroll
        for (int b = 0; b < 2; ++b)
#pragma unroll
            for (int m = 0; m < 4; ++m)
#pragma unroll
                for (int n = 0; n < 2; ++n) acc[a][b][m][n] = AccT{};
    bf16x8 At[4][2], B0[2][2], B1[2][2];
    const char* cA = (const char*)g.A + (size_t)cur.pm * tstep + (size_t)cur.pk * kslice; const char* cB = (const char*)g.Bt + (size_t)cur.pn * tstep + (size_t)cur.pk * kslice;
    S.a_ready(cur);
    if constexpr (SP2) {
        PG8_STAGE(PG8_SB(0, 0), cB, voffB); PG8_STAGE(PG8_SB(0, 1), cB + hstep, voffB); PG8_STAGE(PG8_SA(0, 0), cA, voffA); PG8_STAGE(PG8_SA(0, 1), cA + hstep, voffA);
        if (wr == 1) PG8_BAR;
        PG8_WAIT_V(2); PG8_BAR;
        PG8_STAGE(PG8_SB(1, 0), cB + kstep, voffB); PG8_STAGE(PG8_SA(1, 0), cA + kstep, voffA); PG8_STAGE(PG8_SB(1, 1), cB + hstep + kstep, voffB);
        PG8_WAIT_V(6); PG8_BAR;
    } else {
        PG8_STAGE(PG8_SB(0, 0), cB, voffB); PG8_STAGE(PG8_SA(0, 0), cA, voffA); PG8_STAGE(PG8_SB(0, 1), cB + hstep, voffB); PG8_STAGE(PG8_SA(0, 1), cA + hstep, voffA);
        if (wr == 1) PG8_BAR;
        PG8_WAIT_V(4); PG8_BAR;
        PG8_STAGE(PG8_SB(1, 0), cB + kstep, voffB); PG8_STAGE(PG8_SA(1, 0), cA + kstep, voffA); PG8_STAGE(PG8_SB(1, 1), cB + hstep + kstep, voffB);
        PG8_WAIT_V(6); PG8_BAR;
    }
    for (;;) {
        const bool has_next = S.next(ui + 1, nxt);
        const char* nA = has_next ? (const char*)g.A + (size_t)nxt.pm * tstep + (size_t)nxt.pk * kslice : cA; const char* nB = has_next ? (const char*)g.Bt + (size_t)nxt.pn * tstep + (size_t)nxt.pk * kslice : cB;
        for (int t = 0; t < nt; t += 2) {
            const bool last = (t == nt - 2);
            const char* a1 = cA + (size_t)(t + 1) * kstep;
            const char* a2 = last ? nA : cA + (size_t)(t + 2) * kstep; const char* b2 = last ? nB : cB + (size_t)(t + 2) * kstep;
            const char* a3 = a2 + kstep; const char* b3 = b2 + kstep;
            if (last && has_next) S.a_ready(nxt);
            if constexpr (SP2) {
            PG8_LDB(B0, 0, 0); PG8_LDB(B1, 0, 1); PG8_SCHED; PG8_LDA(At, 0, 0); PG8_STAGE(PG8_SA(1, 1), a1 + hstep, voffA);
            PG8_WAIT_V(8); PG8_WAIT_L(0); PG8_BAR; PG8_MMA(0, 0, At, B0); PG8_MMA(0, 1, At, B1); PG8_BAR; PG8_SCHED;
            PG8_LDA(At, 0, 1); PG8_STAGE(PG8_SB(0, 0), b2, voffB); PG8_STAGE(PG8_SB(0, 1), b2 + hstep, voffB); PG8_STAGE(PG8_SA(0, 0), a2, voffA);
            PG8_WAIT_V(8); PG8_WAIT_L(0); PG8_BAR; PG8_MMA(1, 0, At, B0); PG8_MMA(1, 1, At, B1); PG8_BAR; PG8_SCHED;
            PG8_LDB(B0, 1, 0); PG8_LDB(B1, 1, 1); PG8_SCHED; PG8_LDA(At, 1, 0); PG8_STAGE(PG8_SA(0, 1), a2 + hstep, voffA);
            PG8_WAIT_V(8); PG8_WAIT_L(0); PG8_BAR; PG8_MMA(0, 0, At, B0); PG8_MMA(0, 1, At, B1); PG8_BAR; PG8_SCHED;
            PG8_LDA(At, 1, 1); PG8_STAGE(PG8_SB(1, 0), b3, voffB); PG8_STAGE(PG8_SB(1, 1), b3 + hstep, voffB); PG8_STAGE(PG8_SA(1, 0), a3, voffA);
            PG8_WAIT_V(8); PG8_WAIT_L(0); PG8_BAR; PG8_MMA(1, 0, At, B0); PG8_MMA(1, 1, At, B1); PG8_BAR; PG8_SCHED;
            } else {
            PG8_LDB(B0, 0, 0); PG8_SCHED; PG8_LDA(At, 0, 0); PG8_STAGE(PG8_SA(1, 1), a1 + hstep, voffA);
            PG8_WAIT_L(8); PG8_BAR; PG8_WAIT_L(0); PG8_MMA(0, 0, At, B0); PG8_BAR; PG8_SCHED;
            PG8_LDB(B1, 0, 1); PG8_STAGE(PG8_SB(0, 0), b2, voffB);
            PG8_BAR; PG8_WAIT_L(0); PG8_MMA(0, 1, At, B1); PG8_BAR;
            PG8_LDA(At, 0, 1); PG8_STAGE(PG8_SA(0, 0), a2, voffA);
            PG8_BAR; PG8_WAIT_L(0); PG8_MMA(1, 0, At, B0); PG8_BAR; PG8_SCHED;
            PG8_STAGE(PG8_SB(0, 1), b2 + hstep, voffB);
            PG8_WAIT_V(6); PG8_BAR; PG8_MMA(1, 1, At, B1); PG8_BAR;
            PG8_LDB(B0, 1, 0); PG8_SCHED; PG8_LDA(At, 1, 0); PG8_STAGE(PG8_SA(0, 1), a2 + hstep, voffA);
            PG8_WAIT_L(8); PG8_BAR; PG8_WAIT_L(0); PG8_MMA(0, 0, At, B0); PG8_BAR; PG8_SCHED;
            PG8_LDB(B1, 1, 1); PG8_STAGE(PG8_SB(1, 0), b3, voffB);
            PG8_BAR; PG8_WAIT_L(0); PG8_MMA(0, 1, At, B1); PG8_BAR;
            PG8_LDA(At, 1, 1); PG8_STAGE(PG8_SA(1, 0), a3, voffA);
            PG8_BAR; PG8_WAIT_L(0); PG8_MMA(1, 0, At, B0); PG8_BAR; PG8_SCHED;
            PG8_STAGE(PG8_SB(1, 1), b3 + hstep, voffB);
            PG8_WAIT_V(6); PG8_BAR; PG8_MMA(1, 1, At, B1); PG8_BAR;
            }
        }
        if constexpr (ALIGN_EPI) { if (wr == 0) PG8_BAR; }
        if constexpr (!Epi::AFTER_DRAIN) { E(acc, cur, wr, wc, fr, fq); S.done(cur); }
        if (!has_next) break;
#pragma unroll
        for (int a = 0; a < 2; ++a)
#pragma unroll
            for (int b = 0; b < 2; ++b)
#pragma unroll
                for (int m = 0; m < 4; ++m)
#pragma unroll
                    for (int n = 0; n < 2; ++n) acc[a][b][m][n] = AccT{};
        cur = nxt; cA = nA; cB = nB; ++ui;
        if constexpr (ALIGN_EPI) { if (wr == 1) PG8_BAR; }
    }
    PG8_WAIT_V(0);
    if constexpr (!ALIGN_EPI) { if (wr == 0) PG8_BAR; }
    PG8_BAR;
    if constexpr (Epi::AFTER_DRAIN) { E.fused(acc, cur, wr, wc, fr, fq, lds, wid, lane); S.done(cur); }
#undef PG8_SA
#undef PG8_SB
#undef PG8_STAGE
#undef PG8_LDA
#undef PG8_LDB
#undef PG8_MMA
#undef PG8_WAIT_V
#undef PG8_WAIT_L
#undef PG8_BAR
#undef PG8_SCHED
}
}

#define PG8_SP2 true
#define PG8_ALIGN true

#define XB_TMO      128
#define XB_XCNT(j)  (256  + 64 * (j))
#define XB_XSUB(j)  (1280 + 64 * (j))
#define XB_XGEN(j)  (2304 + 64 * (j))
#define XB_TOP      3328
#define XB_TOPGEN   3392
#define XCD_BAR_WORDS 3456
#define XB_SPIN_CAP (1u << 18)
#define LAS __attribute__((address_space(3)))

__device__ __forceinline__ unsigned xb_ld(unsigned* p)              { return __hip_atomic_load(p, __ATOMIC_RELAXED, __HIP_MEMORY_SCOPE_AGENT); }
__device__ __forceinline__ unsigned xb_add(unsigned* p, unsigned v) { return __hip_atomic_fetch_add(p, v, __ATOMIC_RELAXED, __HIP_MEMORY_SCOPE_AGENT); }
__device__ __forceinline__ unsigned xb_xcc_id() { return (unsigned)__builtin_amdgcn_s_getreg((3 << 11) | 20) & 0xFu; }
#define XB_SPIN(cond, bar) do { unsigned _sp = 0; while (cond) { __builtin_amdgcn_s_sleep(1); \
    if ((++_sp & 255u) == 0u) { if (xb_ld(&(bar)[XB_TMO])) break; if (_sp > XB_SPIN_CAP) { atomicAdd(&(bar)[XB_TMO], 1u); break; } } } } while (0)

struct XcdBarrier {
    unsigned* bar; unsigned x;
    volatile LAS unsigned* st;
};

__device__ __forceinline__ XcdBarrier xcd_barrier_post(unsigned* bar, volatile LAS unsigned* st) {
    XcdBarrier b; b.bar = bar; b.x = xb_xcc_id(); b.st = st;
    if (threadIdx.x == 0) (void)xb_add(&bar[XB_XCNT(b.x)], 1u);
    return b;
}
__device__ __forceinline__ void xcd_barrier_complete(unsigned* bar, unsigned x, unsigned& nloc, unsigned& nx) {
    const unsigned G = gridDim.x * gridDim.y * gridDim.z;
    unsigned sum, cnt, mine, sp = 0u;
    for (;;) {
        sum = 0u; cnt = 0u; mine = 0u;
#pragma unroll
        for (unsigned j = 0; j < 16; ++j) { const unsigned c = xb_ld(&bar[XB_XCNT(j)]); sum += c; cnt += (c > 0u) ? 1u : 0u; mine = (j == x) ? c : mine; }
        if (sum == G) break;
        __builtin_amdgcn_s_sleep(1);
        if ((++sp & 255u) == 0u) { if (xb_ld(&bar[XB_TMO])) break; if (sp > XB_SPIN_CAP) { atomicAdd(&bar[XB_TMO], 1u); break; } }
    }
    nloc = mine > 0u ? mine : 1u; nx = cnt > 0u ? cnt : 1u;
}

__device__ __forceinline__ void xcd_barrier(const XcdBarrier& b) {
    asm volatile("s_waitcnt vmcnt(0)" ::: "memory");
    __syncthreads();
    if (threadIdx.x == 0) {
        unsigned* bar = b.bar;
        __builtin_amdgcn_s_waitcnt(0);
        unsigned nloc = b.st[0], nx = b.st[1];
        if (nloc == 0u) { xcd_barrier_complete(bar, b.x, nloc, nx); b.st[0] = nloc; b.st[1] = nx; }
        const unsigned old = xb_add(&bar[XB_XSUB(b.x)], 1u);
        const unsigned gen = old / nloc;
        if (old + 1u == (gen + 1u) * nloc) {
            __builtin_amdgcn_fence(__ATOMIC_RELEASE, "agent");
            asm volatile("s_waitcnt vmcnt(0)" ::: "memory");
            const unsigned og = xb_add(&bar[XB_TOP], 1u);
            const unsigned tg = og / nx;
            if (og + 1u == (tg + 1u) * nx) xb_add(&bar[XB_TOPGEN], 1u);
            else XB_SPIN(xb_ld(&bar[XB_TOPGEN]) == tg, bar);
            __builtin_amdgcn_fence(__ATOMIC_ACQUIRE, "agent");
            xb_add(&bar[XB_XGEN(b.x)], 1u);
            asm volatile("s_waitcnt vmcnt(0)" ::: "memory");
        } else {
            XB_SPIN(xb_ld(&bar[XB_XGEN(b.x)]) == gen, bar);
            __builtin_amdgcn_fence(__ATOMIC_ACQUIRE, "agent");
            asm volatile("s_waitcnt vmcnt(0)" ::: "memory");
        }
    }
    __syncthreads();
}


constexpr int RING_OFF = 0, RING_BYTES = 131072, LDSCTL_OFF = 146432, MISC_OFF = LDSCTL_OFF + 320, LDS_BYTES = 147456;
constexpr int CW_BAR = 4096;
constexpr size_t CTL_CMAX = 65536;
constexpr size_t CTL_ZERO_BYTES = 1u << 20;
#define LDS_WAIT() asm volatile("s_waitcnt lgkmcnt(0)" ::: "memory")
typedef short bf16x8_t __attribute__((ext_vector_type(8)));
using pg8::cvt_pk_bf16;

__device__ __forceinline__ void tr_item(const float* colp, int ld, bf16_t* WT, int K, int k0, int n0, LAS float* scr, int lane, unsigned* cmaxp = nullptr) {
    float tv[32];
#pragma unroll
    for (int i = 0; i < 32; ++i) { const int kk = 2 * i + (lane >> 5); tv[i] = colp ? colp[(size_t)(k0 + kk) * ld] : 0.f; }
    if (cmaxp) { float mx = 0.f;
#pragma unroll
        for (int i = 0; i < 32; ++i) mx = fmaxf(mx, fabsf(tv[i]));
        mx = fmaxf(mx, __shfl_xor(mx, 32));
        if (lane < 32) atomicMax(cmaxp + n0 + lane, __float_as_uint(mx)); }
#pragma unroll
    for (int i = 0; i < 32; ++i) { const int kk = 2 * i + (lane >> 5); scr[kk * 33 + (lane & 31)] = tv[i]; }
    LDS_WAIT(); asm volatile("" ::: "memory");
    const int c = lane & 7;
#pragma unroll
    for (int j = 0; j < 4; ++j) { const int n = (lane >> 3) + 8 * j; const LAS float* s = scr + (8 * c) * 33 + n;
        u32x4 o; o.x = pk2(s[0 * 33], s[1 * 33]); o.y = pk2(s[2 * 33], s[3 * 33]); o.z = pk2(s[4 * 33], s[5 * 33]); o.w = pk2(s[6 * 33], s[7 * 33]);
        *(u32x4*)(WT + (size_t)(n0 + n) * K + k0 + 8 * c) = o; }
    LDS_WAIT(); asm volatile("" ::: "memory");
}
constexpr int IT_GU = 32 * 352, IT_D = 88 * 64, IT_IN = 32 * 200, IT_OUT = 32 * 64, IT_ALL = 2 * IT_GU + 2 * IT_D + IT_IN + IT_OUT;
__device__ __forceinline__ void convert_item(const Ptrs& p, int it, LAS float* scr, int lane) {
    int r = it; const int ln = lane & 31;
#pragma unroll
    for (int which = 0; which < 2; ++which) {
        if (r < IT_GU) { const int kb = r / 352, q32 = r % 352, n = 32 * q32 + ln, pn = n >> 8, rr = n & 255;
            const float* src = rr < 128 ? (which ? p.f2_wg : p.f1_wg) : (which ? p.f2_wu : p.f1_wu);
            tr_item(src + 128 * pn + (rr & 127), FF, (bf16_t*)(p.WS() + (which ? WS_W2GU : WS_W1GU)), D, 64 * kb, 32 * q32, scr, lane, (unsigned*)(p.WS() + WS_CTL + CTL_CMAX) + which * 2 * FF); return; }
        r -= IT_GU;
        if (r < IT_D) { const int kb = r / 64, q32 = r % 64;
            tr_item((which ? p.f2_wd : p.f1_wd) + 32 * q32 + ln, D, (bf16_t*)(p.WS() + (which ? WS_W2D : WS_W1D)), FF, 64 * kb, 32 * q32, scr, lane, (unsigned*)(p.WS() + WS_CTL + CTL_CMAX) + 4 * FF + which * D); return; }
        r -= IT_D;
    }
    if (r < IT_IN) { const int kb = r / 200, q32 = r % 200, n = 32 * q32 + ln; int col;
        if (n < 4096) col = n; else if (n < 6144) col = n + 8; else { const int j = n - 6144; col = j < 64 ? 6152 + j : j < 72 ? 4096 + (j - 64) : j < 80 ? 6216 + (j - 72) : -1; }
        tr_item(col >= 0 ? p.w_in + col : nullptr, PW, (bf16_t*)(p.WS() + WS_WIN), D, 64 * kb, 32 * q32, scr, lane); return; }
    r -= IT_IN;
    { const int kb = r / 64, q32 = r % 64; tr_item(p.w_out + 32 * q32 + ln, D, (bf16_t*)(p.WS() + WS_WOUT), D, 64 * kb, 32 * q32, scr, lane); }
}
constexpr int MW_PITCH = 528;
template <int MT0, int NMT> __device__ __forceinline__ void mods_wg_body(const Ptrs& p, LAS unsigned char* lds, const int slab, const int tid) {
    const int lane = tid & 63, r = lane & 15, q = lane >> 4, n0 = 32 * slab;
    f32x4 acc[NMT][2];
#pragma unroll
    for (int mt = 0; mt < NMT; ++mt) { acc[mt][0] = (f32x4){0.f, 0.f, 0.f, 0.f}; acc[mt][1] = (f32x4){0.f, 0.f, 0.f, 0.f}; }
    const float* wp = p.w_ada + n0 + r + (size_t)(8 * q) * NMOD;
    float ring[4][2][8];
#define MW_LOADW(slot_, g_) do { _Pragma("unroll") for (int nt = 0; nt < 2; ++nt) _Pragma("unroll") for (int j = 0; j < 8; ++j) ring[slot_][nt][j] = wp[(size_t)(32 * (g_) + j) * NMOD + 16 * nt]; } while (0)
    MW_LOADW(0, 0); MW_LOADW(1, 1); MW_LOADW(2, 2); MW_LOADW(3, 3);
    for (int c = 0; c < 8; ++c) {
        f32x4 cv[17];
#pragma unroll
        for (int i = 0; i < 17; ++i) { const int e = tid + 512 * i, row = e >> 6, c4 = e & 63;
            cv[i] = *(const f32x4*)((row < BP ? p.c_p + (size_t)row * D : p.c_s + (size_t)(row - BP) * D) + 256 * c + 4 * c4); }
        __syncthreads();
#pragma unroll
        for (int i = 0; i < 17; ++i) { const int e = tid + 512 * i, row = e >> 6, c4 = e & 63; u32x2 w; w.x = cvt_pk_bf16(cv[i][0], cv[i][1]); w.y = cvt_pk_bf16(cv[i][2], cv[i][3]);
            *(LAS u32x2*)(lds + row * MW_PITCH + c4 * 8) = w; }
        if (tid < 8 * 64) { const int row = 136 + (tid >> 6), c4 = tid & 63; u32x2 z; z.x = 0u; z.y = 0u; *(LAS u32x2*)(lds + row * MW_PITCH + c4 * 8) = z; }
        __syncthreads();
#pragma unroll
        for (int s = 0; s < 8; ++s) {
            bf16x8_t bfr[2];
#pragma unroll
            for (int nt = 0; nt < 2; ++nt) { const float* v = ring[s & 3][nt]; u32x4 w; w.x = cvt_pk_bf16(v[0], v[1]); w.y = cvt_pk_bf16(v[2], v[3]); w.z = cvt_pk_bf16(v[4], v[5]); w.w = cvt_pk_bf16(v[6], v[7]); bfr[nt] = __builtin_bit_cast(bf16x8_t, w); }
            if (8 * c + s + 4 < 64) MW_LOADW(s & 3, 8 * c + s + 4);
            bf16x8_t afr[NMT];
#pragma unroll
            for (int mt = 0; mt < NMT; ++mt) afr[mt] = *(LAS const bf16x8_t*)(lds + (16 * (MT0 + mt) + r) * MW_PITCH + (32 * s + 8 * q) * 2);
            LDS_WAIT();
#pragma unroll
            for (int mt = 0; mt < NMT; ++mt) { acc[mt][0] = __builtin_amdgcn_mfma_f32_16x16x32_bf16(afr[mt], bfr[0], acc[mt][0], 0, 0, 0); acc[mt][1] = __builtin_amdgcn_mfma_f32_16x16x32_bf16(afr[mt], bfr[1], acc[mt][1], 0, 0, 0); }
        }
    }
#undef MW_LOADW
    float* MODS = (float*)(p.WS() + WS_MODS);
#pragma unroll
    for (int nt = 0; nt < 2; ++nt) { const int n = n0 + 16 * nt + r; const float bb = p.b_ada[n];
#pragma unroll
        for (int mt = 0; mt < NMT; ++mt)
#pragma unroll
            for (int i = 0; i < 4; ++i) { const int row = 16 * (MT0 + mt) + 4 * q + i; if (row < NB) MODS[(size_t)row * NMOD + n] = acc[mt][nt][i] + bb; } }
    __syncthreads();
}
template <int MT0, int NMT> __device__ __forceinline__ void mods_item_t(const Ptrs& p, const int slab, const int lane) {
    const int r = lane & 15, q = lane >> 4, n0 = 32 * slab;
    f32x4 acc[NMT][2];
#pragma unroll
    for (int mt = 0; mt < NMT; ++mt) { acc[mt][0] = (f32x4){0.f, 0.f, 0.f, 0.f}; acc[mt][1] = (f32x4){0.f, 0.f, 0.f, 0.f}; }
    const float* wp = p.w_ada + n0 + r + (size_t)(8 * q) * NMOD;
    const float* cp[NMT];
#pragma unroll
    for (int mt = 0; mt < NMT; ++mt) { int row = 16 * (MT0 + mt) + r; if (row > NB - 1) row = NB - 1; cp[mt] = (row < BP ? p.c_p + (size_t)row * D : p.c_s + (size_t)(row - BP) * D) + 8 * q; }
    const bool vlast = (16 * (MT0 + NMT - 1) + r) < NB;
    float bv[2][8]; f32x4 av[NMT][2];
#define MODS_LOAD(k0_) do { _Pragma("unroll") for (int nt = 0; nt < 2; ++nt) _Pragma("unroll") for (int j = 0; j < 8; ++j) bv[nt][j] = wp[(size_t)((k0_) + j) * NMOD + 16 * nt]; \
        _Pragma("unroll") for (int mt = 0; mt < NMT; ++mt) { av[mt][0] = *(const f32x4*)(cp[mt] + (k0_)); av[mt][1] = *(const f32x4*)(cp[mt] + (k0_) + 4); } } while (0)
    MODS_LOAD(0);
    for (int k0 = 0; k0 < D; k0 += 32) {
        bf16x8_t bfr[2], afr[NMT];
#pragma unroll
        for (int nt = 0; nt < 2; ++nt) { u32x4 w; w.x = cvt_pk_bf16(bv[nt][0], bv[nt][1]); w.y = cvt_pk_bf16(bv[nt][2], bv[nt][3]); w.z = cvt_pk_bf16(bv[nt][4], bv[nt][5]); w.w = cvt_pk_bf16(bv[nt][6], bv[nt][7]); bfr[nt] = __builtin_bit_cast(bf16x8_t, w); }
#pragma unroll
        for (int mt = 0; mt < NMT; ++mt) { f32x4 a0 = av[mt][0], a1 = av[mt][1]; if (mt == NMT - 1 && !vlast) { a0 = (f32x4){0.f, 0.f, 0.f, 0.f}; a1 = a0; }
            u32x4 w; w.x = cvt_pk_bf16(a0[0], a0[1]); w.y = cvt_pk_bf16(a0[2], a0[3]); w.z = cvt_pk_bf16(a1[0], a1[1]); w.w = cvt_pk_bf16(a1[2], a1[3]); afr[mt] = __builtin_bit_cast(bf16x8_t, w); }
        if (k0 + 32 < D) MODS_LOAD(k0 + 32);
#pragma unroll
        for (int mt = 0; mt < NMT; ++mt) { acc[mt][0] = __builtin_amdgcn_mfma_f32_16x16x32_bf16(afr[mt], bfr[0], acc[mt][0], 0, 0, 0); acc[mt][1] = __builtin_amdgcn_mfma_f32_16x16x32_bf16(afr[mt], bfr[1], acc[mt][1], 0, 0, 0); }
    }
#undef MODS_LOAD
    float* MODS = (float*)(p.WS() + WS_MODS);
#pragma unroll
    for (int nt = 0; nt < 2; ++nt) { const int n = n0 + 16 * nt + r; const float bb = p.b_ada[n];
#pragma unroll
        for (int mt = 0; mt < NMT; ++mt)
#pragma unroll
            for (int i = 0; i < 4; ++i) { const int row = 16 * (MT0 + mt) + 4 * q + i; if (row < NB) MODS[(size_t)row * NMOD + n] = acc[mt][nt][i] + bb; } }
}

template <int O0, int O1, int O2, int O3, int O4, int O5, int O6, int O7> __device__ __forceinline__ void tr_read8(u32x2 (&o)[8], const unsigned addr) {
    asm volatile("ds_read_b64_tr_b16 %0, %8 offset:%9\n\tds_read_b64_tr_b16 %1, %8 offset:%10\n\tds_read_b64_tr_b16 %2, %8 offset:%11\n\tds_read_b64_tr_b16 %3, %8 offset:%12\n\t"
                 "ds_read_b64_tr_b16 %4, %8 offset:%13\n\tds_read_b64_tr_b16 %5, %8 offset:%14\n\tds_read_b64_tr_b16 %6, %8 offset:%15\n\tds_read_b64_tr_b16 %7, %8 offset:%16\n\ts_waitcnt lgkmcnt(0)"
                 : "=&v"(o[0]), "=&v"(o[1]), "=&v"(o[2]), "=&v"(o[3]), "=&v"(o[4]), "=&v"(o[5]), "=&v"(o[6]), "=&v"(o[7])
                 : "v"(addr), "n"(O0), "n"(O1), "n"(O2), "n"(O3), "n"(O4), "n"(O5), "n"(O6), "n"(O7) : "memory");
}
__device__ __forceinline__ bf16x8_t frag2(const u32x2 a, const u32x2 b) { u32x4 v; v.x = a.x; v.y = a.y; v.z = b.x; v.w = b.y; return __builtin_bit_cast(bf16x8_t, v); }
constexpr int ML_QC = 0, ML_KC = 33792, ML_KW = 67584, ML_VR = 101376, ML_CB = 109056, ML_N = 142848, ML_SC = 144896, ML_END = 145920; __device__ __forceinline__ void mlstm_mfma_unit(const Ptrs& p, LAS unsigned char* lds, const int unit, const int tid) {
    const int lane = tid & 63, wv = __builtin_amdgcn_readfirstlane(tid >> 6), r = lane & 15, q = lane >> 4;
    const int bh = unit >> 3, sl = unit & 7, b = bh >> 2, h = bh & 3, e0 = 32 * sl;
    const bf16_t* QM = (const bf16_t*)(p.WS() + WS_QM); const bf16_t* KM = (const bf16_t*)(p.WS() + WS_KM); const bf16_t* PROJ = (const bf16_t*)(p.WS() + WS_PROJ);
    const float* BC = (const float*)(p.WS() + WS_BC) + (size_t)bh * 2048; const float* IG = (const float*)(p.WS() + WS_IG) + (size_t)bh * 2048; const float* MMa = (const float*)(p.WS() + WS_MM) + (size_t)bh * 2048;
    float* HM = (float*)(p.WS() + WS_HM);
    const int srow = tid >> 3, sd = (tid & 7) * 32, se = (tid & 7) * 4;
    LAS float* su = (LAS float*)(lds + ML_SC); LAS float* sv = su + 64; LAS float* ssw = su + 128; LAS float* smm = su + 192;
    for (int i = tid; i < 16896 / 4; i += 512) ((LAS unsigned*)(lds + ML_CB))[i] = 0u;
    if (tid < 256) ((LAS float*)(lds + ML_N))[tid] = 0.f;
    f32x4 accC[4][2];
#pragma unroll
    for (int k = 0; k < 4; ++k) { accC[k][0] = (f32x4){0.f, 0.f, 0.f, 0.f}; accC[k][1] = (f32x4){0.f, 0.f, 0.f, 0.f}; }
    u32x4 pq[4], pk[4]; u32x2 pv; float pbc, pig, pmm, pbL, pmL, pm0;
#define ML_PREFETCH(cc) do { const size_t rr_ = (size_t)b * 2048 + 64 * (cc) + srow; const bf16_t* qp_ = QM + rr_ * 1024 + h * 256 + sd; const bf16_t* kp_ = KM + rr_ * 1024 + h * 256 + sd; \
        _Pragma("unroll") for (int j_ = 0; j_ < 4; ++j_) { pq[j_] = *(const u32x4*)(qp_ + 8 * j_); pk[j_] = *(const u32x4*)(kp_ + 8 * j_); } \
        pv = *(const u32x2*)(PROJ + rr_ * PROJ_LD + PC_VM + h * 256 + e0 + se); pbc = BC[64 * (cc) + srow]; pig = IG[64 * (cc) + srow]; pmm = MMa[64 * (cc) + srow]; \
        pbL = BC[64 * (cc) + 63]; pmL = MMa[64 * (cc) + 63]; pm0 = (cc) ? MMa[64 * (cc) - 1] : 0.f; } while (0)
    ML_PREFETCH(0);
    for (int c = 0; c < 32; ++c) {
        const int cur = c & 1, nxt = cur ^ 1;
        const float bL = pbL, mL = pmL, m0 = pm0;
        {
            const float wl = __expf(bL - pbc + pig - mL);
#pragma unroll
            for (int j = 0; j < 4; ++j) { *(LAS u32x4*)(lds + ML_QC + srow * 528 + (sd + 8 * j) * 2) = pq[j]; *(LAS u32x4*)(lds + ML_KC + srow * 528 + (sd + 8 * j) * 2) = pk[j]; }
#pragma unroll
            for (int j = 0; j < 4; ++j) { u32x4 ws_;
#pragma unroll
                for (int e2 = 0; e2 < 4; ++e2) { const unsigned w = pk[j][e2]; ws_[e2] = cvt_pk_bf16(bflo(w) * wl, bfhi(w) * wl); }
                *(LAS u32x4*)(lds + ML_KW + srow * 528 + (sd + 8 * j) * 2) = ws_; }
            *(LAS u32x2*)(lds + ML_VR + srow * 96 + se * 2) = pv;
            if ((tid & 7) == 0) { su[srow] = pbc - pmm; sv[srow] = pig - pbc; ssw[srow] = __expf(pbc + m0 - pmm); smm[srow] = pmm; }
        }
        __syncthreads();
        if (c < 31) ML_PREFETCH(c + 1);
        if (wv < 4) {
            const int tt = wv; const size_t r0 = (size_t)b * 2048 + 64 * c;
            bf16x8_t qf[8];
            { LAS const unsigned char* qrow = lds + ML_QC + (16 * tt + r) * 528 + q * 16;
#pragma unroll
              for (int kk = 0; kk < 8; ++kk) qf[kk] = *(LAS const bf16x8_t*)(qrow + kk * 64); }
            const float ut = su[16 * tt + r]; float rs = 0.f; unsigned pw[4][2];
#pragma unroll
            for (int a = 0; a < 4; ++a) {
                if (a <= tt) {
                    LAS const unsigned char* krow = lds + ML_KC + (16 * a + r) * 528 + q * 16;
                    const f32x4 vs4 = *(LAS const f32x4*)(sv + 16 * a + 4 * q);
                    f32x4 S0 = (f32x4){0.f, 0.f, 0.f, 0.f}, S1 = S0;
#pragma unroll
                    for (int hf = 0; hf < 2; ++hf) { bf16x8_t kf[4];
#pragma unroll
                        for (int k4 = 0; k4 < 4; ++k4) kf[k4] = *(LAS const bf16x8_t*)(krow + (4 * hf + k4) * 64);
                        LDS_WAIT();
#pragma unroll
                        for (int k4 = 0; k4 < 4; k4 += 2) { S0 = __builtin_amdgcn_mfma_f32_16x16x32_bf16(kf[k4], qf[4 * hf + k4], S0, 0, 0, 0); S1 = __builtin_amdgcn_mfma_f32_16x16x32_bf16(kf[k4 + 1], qf[4 * hf + k4 + 1], S1, 0, 0, 0); } }
                    const f32x4 S = S0 + S1; float pe[4];
#pragma unroll
                    for (int i = 0; i < 4; ++i) { float x = S[i] * __expf(ut + vs4[i]); if (a == tt && (4 * q + i) > r) x = 0.f; pe[i] = x; rs += x; }
                    pw[a][0] = cvt_pk_bf16(pe[0], pe[1]); pw[a][1] = cvt_pk_bf16(pe[2], pe[3]);
                } else { pw[a][0] = 0u; pw[a][1] = 0u; }
            }
            rs = x32_sum(x16_sum(rs));
            u32x4 pf0, pf1; pf0.x = pw[0][0]; pf0.y = pw[0][1]; pf0.z = pw[1][0]; pf0.w = pw[1][1]; pf1.x = pw[2][0]; pf1.y = pw[2][1]; pf1.z = pw[3][0]; pf1.w = pw[3][1];
            f32x4 accn[2], accq[2];
            u32x2 vtr[8];
            tr_read8<0, 16 * 96, 32 * 96, 48 * 96, 32, 32 + 16 * 96, 32 + 32 * 96, 32 + 48 * 96>(vtr, (unsigned)(size_t)(lds + ML_VR) + (unsigned)((4 * q + (r >> 2)) * 96 + 8 * (r & 3)));
#pragma unroll
            for (int et = 0; et < 2; ++et) {
                LAS const unsigned char* crow = lds + ML_CB + cur * 16896 + (16 * et + r) * 528 + q * 16;
                bf16x8_t cf[4];
#pragma unroll
                for (int kk = 0; kk < 4; ++kk) cf[kk] = *(LAS const bf16x8_t*)(crow + kk * 64);
                LDS_WAIT();
                accn[et] = __builtin_amdgcn_mfma_f32_16x16x32_bf16(__builtin_bit_cast(bf16x8_t, pf0), frag2(vtr[4 * et + 0], vtr[4 * et + 1]), (f32x4){0.f, 0.f, 0.f, 0.f}, 0, 0, 0);
                if (tt >= 2) accn[et] = __builtin_amdgcn_mfma_f32_16x16x32_bf16(__builtin_bit_cast(bf16x8_t, pf1), frag2(vtr[4 * et + 2], vtr[4 * et + 3]), accn[et], 0, 0, 0);
                f32x4 q0 = (f32x4){0.f, 0.f, 0.f, 0.f}, q1 = q0;
#pragma unroll
                for (int kk = 0; kk < 4; kk += 2) { q0 = __builtin_amdgcn_mfma_f32_16x16x32_bf16(qf[kk], cf[kk], q0, 0, 0, 0); q1 = __builtin_amdgcn_mfma_f32_16x16x32_bf16(qf[kk + 1], cf[kk + 1], q1, 0, 0, 0); }
#pragma unroll
                for (int kk = 0; kk < 4; ++kk) cf[kk] = *(LAS const bf16x8_t*)(crow + (4 + kk) * 64);
                LDS_WAIT();
#pragma unroll
                for (int kk = 0; kk < 4; kk += 2) { q0 = __builtin_amdgcn_mfma_f32_16x16x32_bf16(qf[4 + kk], cf[kk], q0, 0, 0, 0); q1 = __builtin_amdgcn_mfma_f32_16x16x32_bf16(qf[4 + kk + 1], cf[kk + 1], q1, 0, 0, 0); }
                accq[et] = q0 + q1;
            }
            float qn = 0.f;
            { LAS const float* nrow = (LAS const float*)(lds + ML_N + cur * 1024) + 64 * q; LAS const unsigned char* qrow2 = lds + ML_QC + (16 * tt + r) * 528 + 128 * q;
#pragma unroll
              for (int hf = 0; hf < 2; ++hf) { u32x4 wq[4]; f32x4 n0[4], n1[4];
#pragma unroll
                  for (int c4 = 0; c4 < 4; ++c4) { const int c8 = 4 * hf + c4; wq[c4] = *(LAS const u32x4*)(qrow2 + c8 * 16); n0[c4] = *(LAS const f32x4*)(nrow + 8 * c8); n1[c4] = *(LAS const f32x4*)(nrow + 8 * c8 + 4); }
                  LDS_WAIT();
#pragma unroll
                  for (int c4 = 0; c4 < 4; ++c4) { const u32x4 w = wq[c4];
                      qn += (bflo(w.x) * n0[c4][0] + bfhi(w.x) * n0[c4][1]) + (bflo(w.y) * n0[c4][2] + bfhi(w.y) * n0[c4][3]) + (bflo(w.z) * n1[c4][0] + bfhi(w.z) * n1[c4][1]) + (bflo(w.w) * n1[c4][2] + bfhi(w.w) * n1[c4][3]); } } }
            qn = x32_sum(x16_sum(qn));
            const float swt = ssw[16 * tt + r], mmt = smm[16 * tt + r];
            const float inv = 1.0f / fmaxf(fabsf(rs + swt * qn), __expf(-mmt));
#pragma unroll
            for (int i = 0; i < 4; ++i) { const float invv = __shfl(inv, 4 * q + i), swv = __shfl(swt, 4 * q + i);
                float* hp = HM + (r0 + 16 * tt + 4 * q + i) * 1024 + h * 256 + e0 + r;
                hp[0] = (accn[0][i] + swv * accq[0][i]) * invv; hp[16] = (accn[1][i] + swv * accq[1][i]) * invv; }
        } else {
            const int sw4 = wv - 4; const float decay = __expf(bL + m0 - mL);
#pragma unroll
            for (int k = 0; k < 4; ++k) { accC[k][0] = accC[k][0] * decay; accC[k][1] = accC[k][1] * decay; }
            u32x2 vt2[8], ka[8], kb[8];
            tr_read8<0, 4 * 96, 32 * 96, 36 * 96, 32, 32 + 4 * 96, 32 + 32 * 96, 32 + 36 * 96>(vt2, (unsigned)(size_t)(lds + ML_VR) + (unsigned)((8 * q + (r >> 2)) * 96 + 8 * (r & 3)));
            const unsigned kaddr = (unsigned)(size_t)(lds + ML_KW) + (unsigned)((8 * q + (r >> 2)) * 528 + 8 * (r & 3) + sw4 * 128);
            tr_read8<0, 4 * 528, 32 * 528, 36 * 528, 32, 32 + 4 * 528, 32 + 32 * 528, 32 + 36 * 528>(ka, kaddr);
            tr_read8<64, 64 + 4 * 528, 64 + 32 * 528, 64 + 36 * 528, 96, 96 + 4 * 528, 96 + 32 * 528, 96 + 36 * 528>(kb, kaddr);
            float nsum[4];
#pragma unroll
            for (int k = 0; k < 4; ++k) { const int dt = 4 * sw4 + k; float ns_ = 0.f;
#pragma unroll
                for (int kk2 = 0; kk2 < 2; ++kk2) { const u32x2 a0 = (k < 2 ? ka : kb)[4 * (k & 1) + 2 * kk2], a1 = (k < 2 ? ka : kb)[4 * (k & 1) + 2 * kk2 + 1]; const bf16x8_t af = frag2(a0, a1);
                    ns_ += (bflo(a0.x) + bfhi(a0.x)) + (bflo(a0.y) + bfhi(a0.y)) + (bflo(a1.x) + bfhi(a1.x)) + (bflo(a1.y) + bfhi(a1.y));
#pragma unroll
                    for (int et = 0; et < 2; ++et) accC[k][et] = __builtin_amdgcn_mfma_f32_16x16x32_bf16(af, frag2(vt2[4 * et + 2 * kk2], vt2[4 * et + 2 * kk2 + 1]), accC[k][et], 0, 0, 0); }
                nsum[k] = x32_sum(x16_sum(ns_));
#pragma unroll
                for (int et = 0; et < 2; ++et) { u32x2 o; o.x = cvt_pk_bf16(accC[k][et][0], accC[k][et][1]); o.y = cvt_pk_bf16(accC[k][et][2], accC[k][et][3]);
                    *(LAS u32x2*)(lds + ML_CB + nxt * 16896 + (16 * et + r) * 528 + (16 * dt + 4 * q) * 2) = o; } }
            if (q == 0) { LAS float* nb = (LAS float*)(lds + ML_N);
#pragma unroll
                for (int k = 0; k < 4; ++k) { const int d = 16 * (4 * sw4 + k) + r; nb[nxt * 256 + d] = decay * nb[cur * 256 + d] + nsum[k]; } }
        }
        __syncthreads();
    }
#undef ML_PREFETCH
    if (wv >= 4) { const int sw4 = wv - 4;
#pragma unroll
        for (int k = 0; k < 4; ++k)
#pragma unroll
            for (int et = 0; et < 2; ++et)
#pragma unroll
                for (int i = 0; i < 4; ++i) p.out[O_CP + ((size_t)bh * 256 + 16 * (4 * sw4 + k) + 4 * q + i) * 256 + e0 + 16 * et + r] = accC[k][et][i]; }
    if (sl == 0 && tid < 256) { p.out[O_NP + (size_t)bh * 256 + tid] = ((LAS const float*)(lds + ML_N))[tid]; if (tid == 0) p.out[O_MP + bh] = MMa[2047]; }
    __syncthreads();
}

__device__ __forceinline__ void scores_seg(const Ptrs& p, const int b, const int qt, const int klo, const int khi, const int lane) {
    const int r = lane & 15, q = lane >> 4;
    const bf16_t* PROJ = (const bf16_t*)(p.WS() + WS_PROJ); const float* SMALL = (const float*)(p.WS() + WS_SMALL); const bf16_t* KI = (const bf16_t*)(p.WS() + WS_KI) + (size_t)b * 2048 * 64; float* SC = (float*)(p.WS() + WS_SC);
    const size_t row = (size_t)b * 2048 + 16 * qt + r;
    bf16x8_t qa[8][2]; float w8[8];
#pragma unroll
    for (int j = 0; j < 8; ++j) { qa[j][0] = *(const bf16x8_t*)(PROJ + row * PROJ_LD + PC_QI + 64 * j + 8 * q); qa[j][1] = *(const bf16x8_t*)(PROJ + row * PROJ_LD + PC_QI + 64 * j + 32 + 8 * q); w8[j] = SMALL[row * SMALL_LD + 72 + j] * (0.35355339059327373f * 0.125f); }
    float* scrow = SC + row * 2048 + 4 * q;
#pragma unroll 2
    for (int kt = klo; kt < khi; ++kt) {
        const bf16_t* kp = KI + (size_t)(16 * kt + r) * 64 + 8 * q;
        const bf16x8_t k0 = *(const bf16x8_t*)kp, k1 = *(const bf16x8_t*)(kp + 32);
        f32x4 sc = (f32x4){0.f, 0.f, 0.f, 0.f};
#pragma unroll
        for (int j = 0; j < 8; ++j) { f32x4 S = __builtin_amdgcn_mfma_f32_16x16x32_bf16(k0, qa[j][0], (f32x4){0.f, 0.f, 0.f, 0.f}, 0, 0, 0); S = __builtin_amdgcn_mfma_f32_16x16x32_bf16(k1, qa[j][1], S, 0, 0, 0);
#pragma unroll
            for (int i = 0; i < 4; ++i) sc[i] += w8[j] * fmaxf(S[i], 0.f); }
        *(f32x4*)(scrow + 16 * kt) = sc;
    }
}
__device__ __forceinline__ void scores_mfma_prompt(const Ptrs& p, const int u, const int lane) {
    const int b = u >> 8, rem = u & 255, pair = rem >> 2, part = rem & 3;
    const int qtA = pair, qtB = 127 - pair, nA = qtA + 1, ntot = 129;
    const int j0 = part * 33, j1 = (j0 + 33 < ntot) ? j0 + 33 : ntot;
    if (j0 < nA) scores_seg(p, b, qtA, j0, j1 < nA ? j1 : nA, lane);
    if (j1 > nA) scores_seg(p, b, qtB, (j0 > nA ? j0 : nA) - nA, j1 - nA, lane);
}

constexpr int SS_PITCH = 8208;
__device__ __forceinline__ void scores_select_unit(const Ptrs& p, LAS unsigned char* lds, const int b, const int qt, const int tid) {
    const int lane = tid & 63, wv = __builtin_amdgcn_readfirstlane(tid >> 6), r = lane & 15, q = lane >> 4;
    const bf16_t* PROJ = (const bf16_t*)(p.WS() + WS_PROJ); const float* SMALL = (const float*)(p.WS() + WS_SMALL); const bf16_t* KI = (const bf16_t*)(p.WS() + WS_KI) + (size_t)b * 2048 * 64;
    const size_t row = (size_t)b * 2048 + 16 * qt + r;
    bf16x8_t qa[8][2]; float w8[8];
#pragma unroll
    for (int j = 0; j < 8; ++j) { qa[j][0] = *(const bf16x8_t*)(PROJ + row * PROJ_LD + PC_QI + 64 * j + 8 * q); qa[j][1] = *(const bf16x8_t*)(PROJ + row * PROJ_LD + PC_QI + 64 * j + 32 + 8 * q); w8[j] = SMALL[row * SMALL_LD + 72 + j] * (0.35355339059327373f * 0.125f); }
    __syncthreads();
#pragma unroll 2
    for (int kt = wv; kt <= qt; kt += 8) {
        const bf16_t* kp = KI + (size_t)(16 * kt + r) * 64 + 8 * q;
        const bf16x8_t k0 = *(const bf16x8_t*)kp, k1 = *(const bf16x8_t*)(kp + 32);
        f32x4 sc = (f32x4){0.f, 0.f, 0.f, 0.f};
#pragma unroll
        for (int j = 0; j < 8; ++j) { f32x4 S = __builtin_amdgcn_mfma_f32_16x16x32_bf16(k0, qa[j][0], (f32x4){0.f, 0.f, 0.f, 0.f}, 0, 0, 0); S = __builtin_amdgcn_mfma_f32_16x16x32_bf16(k1, qa[j][1], S, 0, 0, 0);
#pragma unroll
            for (int i = 0; i < 4; ++i) sc[i] += w8[j] * fmaxf(S[i], 0.f); }
        *(LAS f32x4*)(lds + r * SS_PITCH + (16 * kt + 4 * q) * 4) = sc;
    }
    __syncthreads();
#pragma unroll
    for (int rr = 0; rr < 2; ++rr) { const int tl = 2 * wv + rr, nvalid = 16 * qt + tl + 1; float raw[32];
#pragma unroll
        for (int i = 0; i < 32; ++i) raw[i] = *(LAS const float*)(lds + tl * SS_PITCH + (64 * i + lane) * 4);
        select_compute<32>(raw, nvalid, (u64*)(p.WS() + WS_MASK) + ((size_t)b * 2048 + 16 * qt + tl) * 32, lane); }
}

template <int DT0> __device__ __forceinline__ void v_tr_read8(u32x2 (&o)[2][2][2]  , const unsigned addr) {
    asm volatile("ds_read_b64_tr_b16 %0, %8 offset:%9\n\tds_read_b64_tr_b16 %1, %8 offset:%10\n\tds_read_b64_tr_b16 %2, %8 offset:%11\n\tds_read_b64_tr_b16 %3, %8 offset:%12\n\t"
                 "ds_read_b64_tr_b16 %4, %8 offset:%13\n\tds_read_b64_tr_b16 %5, %8 offset:%14\n\tds_read_b64_tr_b16 %6, %8 offset:%15\n\tds_read_b64_tr_b16 %7, %8 offset:%16\n\ts_waitcnt lgkmcnt(0)"
                 : "=&v"(o[0][0][0]), "=&v"(o[0][0][1]), "=&v"(o[0][1][0]), "=&v"(o[0][1][1]), "=&v"(o[1][0][0]), "=&v"(o[1][0][1]), "=&v"(o[1][1][0]), "=&v"(o[1][1][1])
                 : "v"(addr), "n"(DT0 * 32), "n"(DT0 * 32 + 16 * 288), "n"(DT0 * 32 + 32 * 288), "n"(DT0 * 32 + 48 * 288),
                   "n"(DT0 * 32 + 32), "n"(DT0 * 32 + 32 + 16 * 288), "n"(DT0 * 32 + 32 + 32 * 288), "n"(DT0 * 32 + 32 + 48 * 288) : "memory");
}
constexpr int AT_BUF = 35840, AT_KC = 0, AT_VT = 17408, AT_MASK = 71680, AT_BIAS = 88064, AT_END = 96256;
__device__ __forceinline__ void attn_mfma_block(const Ptrs& p, LAS unsigned char* lds, const int b, const int qb, const int g, const int tid) {
    const int lane = tid & 63, wv = __builtin_amdgcn_readfirstlane(tid >> 6), r = lane & 15, q = lane >> 4, hh = 4 * g + (wv & 3), mh = wv >> 2;
    const int t0 = 64 * qb, ntile = qb + 1; const size_t row0 = (size_t)b * 2048 + t0;
    const bf16_t* QA = (const bf16_t*)(p.WS() + WS_QA); const bf16_t* KA = (const bf16_t*)(p.WS() + WS_KA); const bf16_t* PROJ = (const bf16_t*)(p.WS() + WS_PROJ); const u64* MASK = (const u64*)(p.WS() + WS_MASK);
    LAS u64* maskL = (LAS u64*)(lds + AT_MASK); LAS const float* biasn = (LAS const float*)(lds + AT_BIAS);
    __syncthreads();
    for (int i = tid; i < 2048; i += 512) maskL[i] = MASK[(row0 + (i >> 5)) * 32 + (i & 31)];
    bf16x8_t qf[2][4];
#pragma unroll
    for (int m2 = 0; m2 < 2; ++m2)
#pragma unroll
        for (int kk = 0; kk < 4; ++kk) qf[m2][kk] = *(const bf16x8_t*)(QA + (row0 + 16 * (2 * mh + m2) + r) * 1024 + hh * 128 + 32 * kk + 8 * q);
    f32x4 O[2][8]; float mrun[2], lrun[2];
#pragma unroll
    for (int m2 = 0; m2 < 2; ++m2) { mrun[m2] = -INFINITY; lrun[m2] = 0.f;
#pragma unroll
        for (int dt = 0; dt < 8; ++dt) O[m2][dt] = (f32x4){0.f, 0.f, 0.f, 0.f}; }
    const float bfar = p.t5[31 * 8 + hh];
    const int srow = tid >> 3, sp = tid & 7;
    u32x4 pk[2], pv[2];
#define AT_PREFETCH(kt_) do { const size_t kr_ = (size_t)b * 2048 + 64 * (kt_) + srow; const bf16_t* kp_ = KA + kr_ * 256 + g * 128 + sp * 16; const bf16_t* vp_ = PROJ + kr_ * PROJ_LD + PC_VA + g * 128 + sp * 16; \
        pk[0] = *(const u32x4*)kp_; pk[1] = *(const u32x4*)(kp_ + 8); pv[0] = *(const u32x4*)vp_; pv[1] = *(const u32x4*)(vp_ + 8); } while (0)
#define AT_STAGE(buf_) do { LAS unsigned char* bb_ = lds + (buf_) * AT_BUF; \
        *(LAS u32x4*)(bb_ + AT_KC + srow * 272 + sp * 32) = pk[0]; *(LAS u32x4*)(bb_ + AT_KC + srow * 272 + sp * 32 + 16) = pk[1]; \
        *(LAS u32x4*)(bb_ + AT_VT + srow * 288 + sp * 32) = pv[0]; *(LAS u32x4*)(bb_ + AT_VT + srow * 288 + sp * 32 + 16) = pv[1]; } while (0)
    AT_PREFETCH(0); AT_STAGE(0); if (ntile > 1) AT_PREFETCH(1);
    __syncthreads();
    for (int kt = 0; kt < ntile; ++kt) {
        const int buf = kt & 1; LAS const unsigned char* bb = lds + buf * AT_BUF;
        f32x4 S[2][4];
#pragma unroll
        for (int a = 0; a < 4; ++a) { bf16x8_t kf[4];
#pragma unroll
            for (int kk = 0; kk < 4; ++kk) kf[kk] = *(LAS const bf16x8_t*)(bb + AT_KC + (16 * a + r) * 272 + kk * 64 + q * 16);
            LDS_WAIT();
            S[0][a] = (f32x4){0.f, 0.f, 0.f, 0.f}; S[1][a] = (f32x4){0.f, 0.f, 0.f, 0.f};
#pragma unroll
            for (int kk = 0; kk < 4; ++kk) { S[0][a] = __builtin_amdgcn_mfma_f32_16x16x32_bf16(kf[kk], qf[0][kk], S[0][a], 0, 0, 0); S[1][a] = __builtin_amdgcn_mfma_f32_16x16x32_bf16(kf[kk], qf[1][kk], S[1][a], 0, 0, 0); } }
        u32x4 pf[2][2];
#pragma unroll
        for (int m2 = 0; m2 < 2; ++m2) {
            const int mt = 2 * mh + m2, t = t0 + 16 * mt + r; const u64 mwq = maskL[(16 * mt + r) * 32 + kt] >> (4 * q);
            const unsigned mlo = (unsigned)mwq, mhi = (unsigned)(mwq >> 32);
            const bool far = (t0 + 16 * mt - 64 * kt - 63) >= 128;
            float bia[4][4];
            if (far) {
#pragma unroll
                for (int a = 0; a < 4; ++a)
#pragma unroll
                    for (int i = 0; i < 4; ++i) bia[a][i] = bfar;
            } else {
                const int dbase = t - 64 * kt - 4 * q;
#pragma unroll
                for (int a = 0; a < 4; ++a)
#pragma unroll
                    for (int i = 0; i < 4; ++i) { int dist = dbase - (16 * a + i); dist = dist < 0 ? 0 : (dist > 255 ? 255 : dist); bia[a][i] = biasn[dist * 8 + hh]; }
                LDS_WAIT();
            }
            float mx = -INFINITY;
#pragma unroll
            for (int a = 0; a < 4; ++a)
#pragma unroll
                for (int i = 0; i < 4; ++i) { const bool on = (((a < 2) ? mlo : mhi) >> (16 * (a & 1) + i)) & 1u; const float lg = on ? S[m2][a][i] + bia[a][i] : -INFINITY; S[m2][a][i] = lg; mx = fmaxf(mx, lg); }
            mx = x32_max(x16_max(mx));
            const float mnew = fmaxf(mrun[m2], mx), muse = (mnew == -INFINITY) ? 0.f : mnew; const float alpha = __expf(mrun[m2] - muse); mrun[m2] = mnew;
            float psum = 0.f; unsigned pw[4][2];
#pragma unroll
            for (int a = 0; a < 4; ++a) { float pe[4];
#pragma unroll
                for (int i = 0; i < 4; ++i) { pe[i] = __expf(S[m2][a][i] - muse); psum += pe[i]; }
                pw[a][0] = cvt_pk_bf16(pe[0], pe[1]); pw[a][1] = cvt_pk_bf16(pe[2], pe[3]); }
            psum = x32_sum(x16_sum(psum));
            lrun[m2] = lrun[m2] * alpha + psum;
            pf[m2][0].x = pw[0][0]; pf[m2][0].y = pw[0][1]; pf[m2][0].z = pw[1][0]; pf[m2][0].w = pw[1][1]; pf[m2][1].x = pw[2][0]; pf[m2][1].y = pw[2][1]; pf[m2][1].z = pw[3][0]; pf[m2][1].w = pw[3][1];
#pragma unroll
            for (int i = 0; i < 4; ++i) { const float al = __shfl(alpha, 4 * q + i);
#pragma unroll
                for (int dt = 0; dt < 8; ++dt) O[m2][dt][i] *= al; }
        }
        {
            const unsigned vaddr = (unsigned)(size_t)(bb + AT_VT) + (unsigned)((4 * q + (r >> 2)) * 288 + 8 * (r & 3));
#define AT_PV2(DT0_) do { u32x2 vt_[2][2][2]; v_tr_read8<DT0_>(vt_, vaddr); \
            _Pragma("unroll") for (int a2 = 0; a2 < 2; ++a2) _Pragma("unroll") for (int d2 = 0; d2 < 2; ++d2) { u32x4 vf; vf.x = vt_[d2][a2][0].x; vf.y = vt_[d2][a2][0].y; vf.z = vt_[d2][a2][1].x; vf.w = vt_[d2][a2][1].y; \
                O[0][(DT0_) + d2] = __builtin_amdgcn_mfma_f32_16x16x32_bf16(__builtin_bit_cast(bf16x8_t, pf[0][a2]), __builtin_bit_cast(bf16x8_t, vf), O[0][(DT0_) + d2], 0, 0, 0); \
                O[1][(DT0_) + d2] = __builtin_amdgcn_mfma_f32_16x16x32_bf16(__builtin_bit_cast(bf16x8_t, pf[1][a2]), __builtin_bit_cast(bf16x8_t, vf), O[1][(DT0_) + d2], 0, 0, 0); } } while (0)
            AT_PV2(0); AT_PV2(2); AT_PV2(4); AT_PV2(6);
#undef AT_PV2
        }
        if (kt + 1 < ntile) { AT_STAGE(buf ^ 1); if (kt + 2 < ntile) AT_PREFETCH(kt + 2); }
        __syncthreads();
    }
#undef AT_PREFETCH
#undef AT_STAGE
    bf16_t* CAT = (bf16_t*)(p.WS() + WS_CAT);
#pragma unroll
    for (int m2 = 0; m2 < 2; ++m2) { const float invl = 1.0f / lrun[m2];
#pragma unroll
        for (int i = 0; i < 4; ++i) { const float iv = __shfl(invl, 4 * q + i); bf16_t* cp = CAT + (row0 + 16 * (2 * mh + m2) + 4 * q + i) * D + 1024 + hh * 128 + r;
#pragma unroll
            for (int dt = 0; dt < 8; ++dt) cp[16 * dt] = f2bf(O[m2][dt][i] * iv); } }
}

__device__ __forceinline__ void scores_mfma_sample(const Ptrs& p, const int u, const int lane) {
    const int r = lane & 15, q = lane >> 4, b = u >> 4, part = u & 15;
    const bf16_t* PROJ = (const bf16_t*)(p.WS() + WS_PROJ); const float* SMALL = (const float*)(p.WS() + WS_SMALL); float* SCS = (float*)(p.WS() + WS_SCS);
    bf16x8_t qa[2][2]; float w4[2][4];
#pragma unroll
    for (int mtl = 0; mtl < 2; ++mtl) { const size_t row = (size_t)MP + 4 * b + 2 * mtl + (r >> 3);
        qa[mtl][0] = *(const bf16x8_t*)(PROJ + row * PROJ_LD + PC_QI + 64 * (r & 7) + 8 * q); qa[mtl][1] = *(const bf16x8_t*)(PROJ + row * PROJ_LD + PC_QI + 64 * (r & 7) + 32 + 8 * q);
        const size_t wrow = (size_t)MP + 4 * b + 2 * mtl + (q >> 1);
#pragma unroll
        for (int i = 0; i < 4; ++i) w4[mtl][i] = SMALL[wrow * SMALL_LD + 72 + 4 * (q & 1) + i] * (0.35355339059327373f * 0.125f); }
    const int tlo = 8 * part, thi = (part == 15) ? 129 : 8 * part + 8;
    for (int kt = tlo; kt < thi; ++kt) {
        const int s = 16 * kt + r; f32x4 k0a, k0b, k1a, k1b;
        if (s < 2052) { const float* kr = s < 2048 ? p.cache_ik + ((size_t)p.page_table[b * 16 + (s >> 7)] * 128 + (s & 127)) * 64 : SMALL + (size_t)(MP + 4 * b + (s - 2048)) * SMALL_LD;
            k0a = *(const f32x4*)(kr + 8 * q); k0b = *(const f32x4*)(kr + 8 * q + 4); k1a = *(const f32x4*)(kr + 32 + 8 * q); k1b = *(const f32x4*)(kr + 32 + 8 * q + 4); }
        else { k0a = (f32x4){0.f, 0.f, 0.f, 0.f}; k0b = k0a; k1a = k0a; k1b = k0a; }
        u32x4 w0, w1; w0.x = cvt_pk_bf16(k0a[0], k0a[1]); w0.y = cvt_pk_bf16(k0a[2], k0a[3]); w0.z = cvt_pk_bf16(k0b[0], k0b[1]); w0.w = cvt_pk_bf16(k0b[2], k0b[3]);
        w1.x = cvt_pk_bf16(k1a[0], k1a[1]); w1.y = cvt_pk_bf16(k1a[2], k1a[3]); w1.z = cvt_pk_bf16(k1b[0], k1b[1]); w1.w = cvt_pk_bf16(k1b[2], k1b[3]);
        const bf16x8_t kb0 = __builtin_bit_cast(bf16x8_t, w0), kb1 = __builtin_bit_cast(bf16x8_t, w1);
#pragma unroll
        for (int mtl = 0; mtl < 2; ++mtl) {
            f32x4 S = __builtin_amdgcn_mfma_f32_16x16x32_bf16(qa[mtl][0], kb0, (f32x4){0.f, 0.f, 0.f, 0.f}, 0, 0, 0); S = __builtin_amdgcn_mfma_f32_16x16x32_bf16(qa[mtl][1], kb1, S, 0, 0, 0);
            float sc = (w4[mtl][0] * fmaxf(S[0], 0.f) + w4[mtl][1] * fmaxf(S[1], 0.f)) + (w4[mtl][2] * fmaxf(S[2], 0.f) + w4[mtl][3] * fmaxf(S[3], 0.f));
            sc = x16_sum(sc);
            if ((q & 1) == 0) SCS[(size_t)(4 * b + 2 * mtl + (q >> 1)) * SCS_LD + s] = sc;
        }
    }
}

constexpr int SA_LS = 96256, SA_LP = 104960, SA_SEL = 113664, SA_N = 115840;
__device__ __forceinline__ void attn_mfma_sample(const Ptrs& p, LAS unsigned char* lds, const int b, const int g, const int tid) {
    const int lane = tid & 63, wv = __builtin_amdgcn_readfirstlane(tid >> 6), r = lane & 15, q = lane >> 4;
    const bf16_t* QA = (const bf16_t*)(p.WS() + WS_QA); const bf16_t* KA = (const bf16_t*)(p.WS() + WS_KA); const bf16_t* PROJ = (const bf16_t*)(p.WS() + WS_PROJ); const u64* MASKS = (const u64*)(p.WS() + WS_MASKS);
    LAS int* listS = (LAS int*)(lds + SA_LS); LAS int* listP = (LAS int*)(lds + SA_LP); LAS unsigned char* sel = lds + SA_SEL; LAS int* nk = (LAS int*)(lds + SA_N); LAS const float* biasn = (LAS const float*)(lds + AT_BIAS);
    __syncthreads();
    LAS u64* mk4 = (LAS u64*)(lds + SA_N + 64);
    if (wv < 4) {
        float raw[33]; select_load<33>(raw, (const float*)(p.WS() + WS_SCS) + (size_t)(4 * b + wv) * SCS_LD, lane);
        select_compute<33>(raw, 2049 + wv, (u64*)(mk4 + wv * 33), lane);
    }
    __syncthreads();
    if (wv == 0) {
        int base = 0;
        for (int w = 0; w < 33; ++w) {
            const u64 m0 = mk4[w], m1 = mk4[33 + w], m2 = mk4[66 + w], m3 = mk4[99 + w];
            const unsigned s4 = (unsigned)((m0 >> lane) & 1ull) | ((unsigned)((m1 >> lane) & 1ull) << 1) | ((unsigned)((m2 >> lane) & 1ull) << 2) | ((unsigned)((m3 >> lane) & 1ull) << 3);
            const bool on = s4 != 0u; const u64 bal = __ballot(on);
            if (on) { const int pos = base + __popcll(bal & ((1ull << lane) - 1ull)); listS[pos] = 64 * w + lane; sel[pos] = (unsigned char)s4; }
            base += __popcll(bal);
        }
        const int npad = (base + 63) & ~63;
        for (int i = base + lane; i < npad; i += 64) { listS[i] = 0; sel[i] = 0; }
        if (lane == 0) { nk[0] = base; nk[1] = npad; }
    }
    __syncthreads();
    const int npad = nk[1], ntile = npad >> 6;
    for (int i = tid; i < npad; i += 512) { const int s = listS[i]; listP[i] = s < 2048 ? p.page_table[b * 16 + (s >> 7)] * 128 + (s & 127) : -(1 + (s - 2048)); }
    bf16x8_t qf[4];
    { const size_t qrow = (size_t)MP + 4 * b + (r >> 2); const int hh = 4 * g + (r & 3);
#pragma unroll
      for (int kk = 0; kk < 4; ++kk) qf[kk] = *(const bf16x8_t*)(QA + qrow * 1024 + hh * 128 + 32 * kk + 8 * q); }
    const int trow = r >> 2, hrow = 4 * g + (r & 3), qpos = 2048 + trow;
    f32x4 O = (f32x4){0.f, 0.f, 0.f, 0.f}; float mrun = -INFINITY, lrun = 0.f;
    const int srow = tid >> 3, sp = tid & 7;
    f32x4 pkf[4], pvf[4];
    __syncthreads();
#define SA_PREFETCH(kt_) do { const int e_ = listP[64 * (kt_) + srow]; \
        if (e_ >= 0) { const float* kp_ = p.cache_k + ((size_t)e_ * 2 + g) * 128 + sp * 16; const float* vp_ = p.cache_v + ((size_t)e_ * 2 + g) * 128 + sp * 16; \
            _Pragma("unroll") for (int j_ = 0; j_ < 4; ++j_) { pkf[j_] = *(const f32x4*)(kp_ + 4 * j_); pvf[j_] = *(const f32x4*)(vp_ + 4 * j_); } } \
        else { const size_t nr_ = (size_t)MP + 4 * b + (-e_ - 1); const bf16_t* kp_ = KA + nr_ * 256 + g * 128 + sp * 16; const bf16_t* vp_ = PROJ + nr_ * PROJ_LD + PC_VA + g * 128 + sp * 16; \
            const u32x4 a0_ = *(const u32x4*)kp_, a1_ = *(const u32x4*)(kp_ + 8), c0_ = *(const u32x4*)vp_, c1_ = *(const u32x4*)(vp_ + 8); \
            pkf[0] = (f32x4){bflo(a0_.x), bfhi(a0_.x), bflo(a0_.y), bfhi(a0_.y)}; pkf[1] = (f32x4){bflo(a0_.z), bfhi(a0_.z), bflo(a0_.w), bfhi(a0_.w)}; pkf[2] = (f32x4){bflo(a1_.x), bfhi(a1_.x), bflo(a1_.y), bfhi(a1_.y)}; pkf[3] = (f32x4){bflo(a1_.z), bfhi(a1_.z), bflo(a1_.w), bfhi(a1_.w)}; \
            pvf[0] = (f32x4){bflo(c0_.x), bfhi(c0_.x), bflo(c0_.y), bfhi(c0_.y)}; pvf[1] = (f32x4){bflo(c0_.z), bfhi(c0_.z), bflo(c0_.w), bfhi(c0_.w)}; pvf[2] = (f32x4){bflo(c1_.x), bfhi(c1_.x), bflo(c1_.y), bfhi(c1_.y)}; pvf[3] = (f32x4){bflo(c1_.z), bfhi(c1_.z), bflo(c1_.w), bfhi(c1_.w)}; } } while (0)
#define SA_STAGE(buf_) do { LAS unsigned char* bb_ = lds + (buf_) * AT_BUF; u32x4 w0_, w1_; \
        w0_.x = cvt_pk_bf16(pkf[0][0], pkf[0][1]); w0_.y = cvt_pk_bf16(pkf[0][2], pkf[0][3]); w0_.z = cvt_pk_bf16(pkf[1][0], pkf[1][1]); w0_.w = cvt_pk_bf16(pkf[1][2], pkf[1][3]); \
        w1_.x = cvt_pk_bf16(pkf[2][0], pkf[2][1]); w1_.y = cvt_pk_bf16(pkf[2][2], pkf[2][3]); w1_.z = cvt_pk_bf16(pkf[3][0], pkf[3][1]); w1_.w = cvt_pk_bf16(pkf[3][2], pkf[3][3]); \
        *(LAS u32x4*)(bb_ + AT_KC + srow * 272 + sp * 32) = w0_; *(LAS u32x4*)(bb_ + AT_KC + srow * 272 + sp * 32 + 16) = w1_; \
        _Pragma("unroll") for (int j_ = 0; j_ < 4; ++j_) _Pragma("unroll") for (int e_ = 0; e_ < 4; e_ += 2) { const unsigned w_ = cvt_pk_bf16(pvf[j_][e_], pvf[j_][e_ + 1]); const int d_ = sp * 16 + 4 * j_ + e_; \
            *(LAS bf16_t*)(bb_ + AT_VT + d_ * 144 + srow * 2) = (bf16_t)(w_ & 0xffffu); *(LAS bf16_t*)(bb_ + AT_VT + (d_ + 1) * 144 + srow * 2) = (bf16_t)(w_ >> 16); } } while (0)
    SA_PREFETCH(0); SA_STAGE(0); if (ntile > 1) SA_PREFETCH(1);
    __syncthreads();
    for (int kt = 0; kt < ntile; ++kt) {
        const int buf = kt & 1; LAS const unsigned char* bb = lds + buf * AT_BUF;
        if (kt + 1 < ntile) { SA_STAGE(buf ^ 1); if (kt + 2 < ntile) SA_PREFETCH(kt + 2); }
        f32x4 S[4];
#pragma unroll
        for (int a = 0; a < 4; ++a) { S[a] = (f32x4){0.f, 0.f, 0.f, 0.f};
#pragma unroll
            for (int kk = 0; kk < 4; ++kk) S[a] = __builtin_amdgcn_mfma_f32_16x16x32_bf16(*(LAS const bf16x8_t*)(bb + AT_KC + (16 * a + r) * 272 + kk * 64 + q * 16), qf[kk], S[a], 0, 0, 0); }
        float mx = -INFINITY;
#pragma unroll
        for (int a = 0; a < 4; ++a) { const int i0 = 64 * kt + 16 * a + 4 * q; const unsigned s4w = *(LAS const unsigned*)(sel + i0);
            const int ks0 = listS[i0], ks1 = listS[i0 + 1], ks2 = listS[i0 + 2], ks3 = listS[i0 + 3]; const int ksv[4] = {ks0, ks1, ks2, ks3};
#pragma unroll
            for (int i = 0; i < 4; ++i) { const bool on = (s4w >> (8 * i + trow)) & 1u; int dist = qpos - ksv[i]; dist = dist < 0 ? 0 : (dist > 255 ? 255 : dist);
                const float lg = on ? S[a][i] + biasn[dist * 8 + hrow] : -INFINITY; S[a][i] = lg; mx = fmaxf(mx, lg); } }
        mx = x32_max(x16_max(mx));
        const float mnew = fmaxf(mrun, mx), muse = (mnew == -INFINITY) ? 0.f : mnew; const float alpha = __expf(mrun - muse); mrun = mnew;
        float psum = 0.f; unsigned pw[4][2];
#pragma unroll
        for (int a = 0; a < 4; ++a) { float pe[4];
#pragma unroll
            for (int i = 0; i < 4; ++i) { pe[i] = __expf(S[a][i] - muse); psum += pe[i]; }
            pw[a][0] = cvt_pk_bf16(pe[0], pe[1]); pw[a][1] = cvt_pk_bf16(pe[2], pe[3]); }
        psum = x32_sum(x16_sum(psum));
        lrun = lrun * alpha + psum;
        u32x4 pf[2]; pf[0].x = pw[0][0]; pf[0].y = pw[0][1]; pf[0].z = pw[1][0]; pf[0].w = pw[1][1]; pf[1].x = pw[2][0]; pf[1].y = pw[2][1]; pf[1].z = pw[3][0]; pf[1].w = pw[3][1];
#pragma unroll
        for (int i = 0; i < 4; ++i) O[i] *= __shfl(alpha, 4 * q + i);
        { LAS const unsigned char* vrow = bb + AT_VT + (16 * wv + r) * 144;
#pragma unroll
          for (int a2 = 0; a2 < 2; ++a2) { const u32x2 lo = *(LAS const u32x2*)(vrow + (32 * a2 + 4 * q) * 2), hi = *(LAS const u32x2*)(vrow + (32 * a2 + 16 + 4 * q) * 2); u32x4 vf; vf.x = lo.x; vf.y = lo.y; vf.z = hi.x; vf.w = hi.y;
              O = __builtin_amdgcn_mfma_f32_16x16x32_bf16(__builtin_bit_cast(bf16x8_t, pf[a2]), __builtin_bit_cast(bf16x8_t, vf), O, 0, 0, 0); } }
        __syncthreads();
    }
#undef SA_PREFETCH
#undef SA_STAGE
    bf16_t* CAT = (bf16_t*)(p.WS() + WS_CAT); const float invl = 1.0f / lrun;
#pragma unroll
    for (int i = 0; i < 4; ++i) { const float iv = __shfl(invl, 4 * q + i); CAT[((size_t)MP + 4 * b + q) * D + 1024 + (4 * g + i) * 128 + 16 * wv + r] = f2bf(O[i] * iv); }
}

struct MkArgs { Ptrs p; int ph_lo, ph_hi, sub, pad; };
__global__ void __launch_bounds__(512, 2) mk_fwd(MkArgs a) {
    extern __shared__ __attribute__((aligned(16))) unsigned char lds_raw[];
    LAS unsigned char* lds = (LAS unsigned char*)lds_raw;
    const int lo_ = a.ph_lo, hi_ = a.ph_hi;
    const Ptrs& p = a.p;
    { unsigned char* w = p.ws_; asm volatile("" :: "s"(w), "s"(lo_), "s"(hi_)); }
    const int tid0 = threadIdx.x;
#define PART_ENV int tid = tid0; asm volatile("" : "+v"(tid)); const int lane = tid & 63, wave = __builtin_amdgcn_readfirstlane(tid >> 6), gw = vcu * 8 + wave; (void)lane; (void)wave; (void)gw;
    const int tid = tid0, lane = tid & 63, wave = __builtin_amdgcn_readfirstlane(tid >> 6);
    const int G = gridDim.x; const int bx = blockIdx.x; const int vcu = (G % 8 == 0) ? (bx % 8) * (G / 8) + bx / 8 : bx;
    const int gw = vcu * 8 + wave, NGW = G * 8;
    for (int u = tid; u < (LDS_BYTES - LDSCTL_OFF) / 4; u += 512) ((LAS unsigned*)(lds + LDSCTL_OFF))[u] = 0u;
    __syncthreads();
    const bool one_launch = (hi_ - lo_) > 1;
    XcdBarrier bar; bar.bar = (unsigned*)(p.WS() + WS_CTL) + CW_BAR; bar.x = 0; bar.st = nullptr;
    if (one_launch) bar = xcd_barrier_post((unsigned*)(p.WS() + WS_CTL) + CW_BAR, (volatile LAS unsigned*)(lds + MISC_OFF) + 8);
    const int lo = lo_, hi = hi_;
#define IN(k) (lo <= (k) && (k) < hi)
#define SEAM(k) do { if (IN(k) && IN((k) + 1)) xcd_barrier(bar); } while (0)
    const float* mods = (const float*)(p.WS() + WS_MODS);
    bf16_t* Hb = (bf16_t*)(p.WS() + WS_H); bf16_t* ACT = (bf16_t*)(p.WS() + WS_ACT); bf16_t* CAT = (bf16_t*)(p.WS() + WS_CAT);
    float* X = p.out + O_Y;

    if (IN(0)) {
        if (G == 256) {
            if (vcu < 144) { PART_ENV const int wi = 8 * vcu + wave; if (wi & 1) mods_wg_body<5, 4>(p, lds, wi >> 1, tid); else mods_wg_body<0, 5>(p, lds, wi >> 1, tid); }
            { PART_ENV LAS float* scr = (LAS float*)(lds + RING_OFF + wave * 16384);
              constexpr int NM = 12, NMW = 1152, IT_M = NM * NMW;
              if (vcu < 144) { const int mw = vcu * 8 + wave; for (int k = 0; k < NM; ++k) convert_item(p, mw + k * NMW, scr, lane); }
              else { const int ow = (vcu - 144) * 8 + wave; for (int it = IT_M + ow; it < IT_ALL; it += 896) convert_item(p, it, scr, lane); } }
        } else {
            { PART_ENV if ((gw & 15) < 9) { const int it = (gw >> 4) * 9 + (gw & 15); if (it < 2 * (NMOD / 32)) { if (it & 1) mods_item_t<5, 4>(p, it >> 1, lane); else mods_item_t<0, 5>(p, it >> 1, lane); } } }
            { PART_ENV LAS float* scr = (LAS float*)(lds + RING_OFF + wave * 16384); for (int it = gw; it < IT_ALL; it += NGW) convert_item(p, it, scr, lane); }
        }
    }
    SEAM(0);
    if (IN(1)) { PART_ENV for (int row = gw; row < M; row += NGW) { const float* mr = mods + (size_t)row_bm(row) * NMOD;
        normmod_q8(row < MP ? p.x_p + (size_t)row * D : p.x_s + (size_t)(row - MP) * D, p.f1_g, mr + D, mr, p.WS() + WS_H8 + (size_t)row * D, (float*)(p.WS() + WS_SA) + row, lane); }
        for (int n = gw; n < 4 * FF; n += NGW) { const int which = n >= 2 * FF, nn = which ? n - 2 * FF : n;
            quant_wrow<D>((const bf16_t*)(p.WS() + (which ? WS_W2GU : WS_W1GU)) + (size_t)nn * D, p.WS() + (which ? WS_W2GU8 : WS_W1GU8) + (size_t)nn * D, (unsigned*)(p.WS() + WS_CTL + CTL_CMAX) + n, lane); }
        for (int n = gw; n < 2 * D; n += NGW) { const int which = n >= D, nn = which ? n - D : n;
            quant_wrow<FF>((const bf16_t*)(p.WS() + (which ? WS_W2D : WS_W1D)) + (size_t)nn * FF, p.WS() + (which ? WS_W2D8 : WS_W1D8) + (size_t)nn * FF, (unsigned*)(p.WS() + WS_CTL + CTL_CMAX) + 4 * FF + n, lane); } }
    SEAM(1);
    if (IN(2)) { PART_ENV pg8::Gemm g{(const bf16_t*)(p.WS() + WS_H8), (const bf16_t*)(p.WS() + WS_W1GU8), M, 2 * FF, D / 2, D / 2}; pg8::StaticOrder S; S.init(MP, 2 * FF, G, bx);
        pg8::EpiSwigluI8 E{ACT, (const float*)(p.WS() + WS_SA), (const float*)(p.WS() + WS_CTL + CTL_CMAX), (float*)(p.WS() + WS_RMAXP), p.WS() + WS_ACT8};
        pg8::gemm_phase<pg8::EpiSwigluI8, pg8::StaticOrder, PG8_ALIGN, PG8_SP2>(lds + RING_OFF, g, S, E); }
    if (IN(2) && IN(15)) xcd_barrier(bar);
    if (IN(15)) { PART_ENV
        const int ngemm = G > 88 ? 88 : G, nreq = G > 88 ? G - 88 : G, creq = G > 88 ? bx - 88 : bx;
        if (bx < ngemm) { pg8::Gemm g{(const bf16_t*)(p.WS() + WS_H8), (const bf16_t*)(p.WS() + WS_W1GU8), M, 2 * FF, D / 2, D / 2}; pg8::SampleOrder S; S.init(2 * FF, ngemm, bx);
            pg8::EpiSwigluI8 E{ACT, (const float*)(p.WS() + WS_SA), (const float*)(p.WS() + WS_CTL + CTL_CMAX), (float*)(p.WS() + WS_RMAXP), p.WS() + WS_ACT8};
            pg8::gemm_phase<pg8::EpiSwigluI8, pg8::SampleOrder, PG8_ALIGN, PG8_SP2>(lds + RING_OFF, g, S, E); }
        if (creq >= 0) for (int row = creq * 8 + wave; row < MP; row += nreq * 8) requant_act_row(p.WS() + WS_ACT8 + (size_t)row * FF, (const float*)(p.WS() + WS_RMAXP) + (size_t)row * 176, (float*)(p.WS() + WS_SA2) + row, lane); }
    if (IN(15) && IN(3)) xcd_barrier(bar);
    if (IN(3)) { PART_ENV
#pragma nounroll
      for (int s_ = 0; s_ < 2; ++s_) {
        if ((s_ == 0) != ((bx & 1) != 0)) { pg8::Gemm g{(const bf16_t*)(p.WS() + WS_ACT8), (const bf16_t*)(p.WS() + WS_W1D8), MP, D, FF / 2, FF / 2}; pg8::StaticOrder S; S.init(MP, D, G, bx, 4);
        pg8::EpiResidI8T<false, true> E{p.x_p, (bf16_t*)(p.WS() + WS_XB), mods + 2 * D, 0.5f, (const float*)(p.WS() + WS_SA2), (const float*)(p.WS() + WS_CTL + CTL_CMAX) + 4 * FF};
        pg8::gemm_phase<pg8::EpiResidI8T<false, true>, pg8::StaticOrder, PG8_ALIGN, PG8_SP2>(lds + RING_OFF, g, S, E); }
        else { pg8::Gemm g{ACT, (const bf16_t*)(p.WS() + WS_W1D), M, D, FF, 512}; pg8::SplitOrder S{11, G, (bx & 1) ? (bx >> 1) : (G >> 1) + (bx >> 1)}; pg8::EpiSlab E{(float*)(p.WS() + WS_SLAB)};
        pg8::gemm_phase<pg8::EpiSlab, pg8::SplitOrder, PG8_ALIGN, PG8_SP2>(lds + RING_OFF, g, S, E); }
        __syncthreads(); } }
    SEAM(3);
    if (IN(4)) { PART_ENV const int nit = fix_rows_n(gw, NGW); for (int it = 0; it < nit; ++it) { const int row = fix_row_at(gw, NGW, it); const float* mr = mods + (size_t)row_bm(row) * NMOD + 3 * D;
        bf16_t* xb = (bf16_t*)(p.WS() + WS_XB) + (size_t)row * D; f32x4 v[8];
        if (row < MP) row_load_b(v, xb, lane);
        else { row_load(v, p.x_s + (size_t)(row - MP) * D, lane); fix_add<11>(v, (const float*)(p.WS() + WS_SLAB) + (size_t)(row - MP) * D, mr - D, 0.5f, lane); row_store_b(v, xb, lane); }
        normmod_vals(v, p.mix_g, mr + D, mr, Hb + (size_t)row * D, lane); } }
    SEAM(4);
    if (IN(5)) { PART_ENV pg8::Gemm g{Hb, (const bf16_t*)(p.WS() + WS_WIN), M, 6400, D, D}; pg8::StaticOrder S; S.init(M, 6400, G, bx); pg8::EpiProj E{(bf16_t*)(p.WS() + WS_PROJ), (float*)(p.WS() + WS_SMALL)};
        pg8::gemm_phase<pg8::EpiProj, pg8::StaticOrder, PG8_ALIGN, PG8_SP2>(lds + RING_OFF, g, S, E); }
    SEAM(5);
    if (IN(6)) { const bool spread = G >= 64; const int NGI = spread ? NGW - 32 : NGW;
        { PART_ENV const bool scanw = spread ? (wave == 7 && vcu < 32) : (gw < 32); const int gi = !spread ? gw : (vcu < 32 ? vcu * 7 + wave : 224 + (vcu - 32) * 8 + wave);
          if (scanw) scan_bh(p, spread ? vcu : gw, lane);
          if (!(spread && scanw)) for (int row = gi; row < M; row += NGI) post_row(p, row, lane); }
        { PART_ENV constexpr int NU = (MP / 8) * 8; const bool scanw = spread && wave == 7 && vcu < 32; const int gi = !spread ? gw : (vcu < 32 ? vcu * 7 + wave : 224 + (vcu - 32) * 8 + wave);
          if (scanw) {}
          else if ((NGI & 7) == 0 && gi < NU) { f32x4 w[4];
#pragma unroll
              for (int k = 0; k < 4; ++k) w[k] = *(const f32x4*)(p.conv_w + (size_t)k * 2048 + 256 * (gi & 7) + 4 * lane);
              u32x2 cur[11], nxt[11]; conv_load(cur, p, gi, lane);
              for (int u = gi; u < NU; u += NGI) { const bool more = u + NGI < NU; if (more) conv_load(nxt, p, u + NGI, lane); conv_compute(cur, w, p, u, lane);
                  if (more) {
#pragma unroll
                      for (int i = 0; i < 11; ++i) cur[i] = nxt[i]; } } }
          else if ((NGI & 7) != 0) { for (int u = gi; u < NU; u += NGI) { f32x4 w[4];
#pragma unroll
              for (int k = 0; k < 4; ++k) w[k] = *(const f32x4*)(p.conv_w + (size_t)k * 2048 + 256 * (u & 7) + 4 * lane);
              u32x2 cur[11]; conv_load(cur, p, u, lane); conv_compute(cur, w, p, u, lane); } } } }
    SEAM(6);
    if (IN(7)) {
        if (a.sub & 1) { PART_ENV for (int u = vcu; u < 256; u += G) { const int b = u >> 5;
            for (int k = 0; k < 2; ++k) { const int pi = 2 * (u & 31) + k; scores_select_unit(p, lds, b, pi, tid); scores_select_unit(p, lds, b, 127 - pi, tid); } }
          __syncthreads(); }
        if (a.sub & 2) { PART_ENV for (int u = gw; u < 2048; u += NGW) scores_mfma_sample(p, u, lane); }
        if (a.sub & 4) { PART_ENV for (int unit = vcu; unit < 256; unit += G) mlstm_mfma_unit(p, lds, unit, tid); }
        if (a.sub & 8) { PART_ENV mlstm_sample_items(p, lds_raw, vcu, G, tid); }
    }
    SEAM(7);
    if (IN(9)) {
        { PART_ENV for (int i = tid; i < 2048; i += 512) ((LAS float*)(lds + AT_BIAS))[i] = p.t5[t5_bucket(i >> 3) * 8 + (i & 7)];
          if (a.sub & 16) for (int u = vcu; u < 256; u += G) { const int b = u >> 5, g = (u >> 4) & 1, qb = u & 15; attn_mfma_block(p, lds, b, qb, g, tid); attn_mfma_block(p, lds, b, 31 - qb, g, tid); }
          __syncthreads(); }
        if (a.sub & 32) { PART_ENV for (int u = vcu; u < 256; u += G) attn_mfma_sample(p, lds, u >> 1, u & 1, tid);
          __syncthreads(); }
        if (a.sub & 64) { PART_ENV for (int row = gw; row < M; row += 2 * NGW) { mlstm_out_row(p, row, lane); if (row + NGW < M) mlstm_out_row(p, row + NGW, lane); } }
    }
    SEAM(9);
    if (IN(10)) { PART_ENV { pg8::Gemm g{CAT, (const bf16_t*)(p.WS() + WS_WOUT), MP, D, D, D}; pg8::StaticOrder S; S.init(MP, D, G, bx, 4); pg8::EpiResidT<true, true> E{(bf16_t*)(p.WS() + WS_XB), (bf16_t*)(p.WS() + WS_XB), mods + 5 * D, 1.0f};
        pg8::gemm_phase<pg8::EpiResidT<true, true>, pg8::StaticOrder, PG8_ALIGN, PG8_SP2>(lds + RING_OFF, g, S, E); }
        __syncthreads();
        { pg8::Gemm g{CAT, (const bf16_t*)(p.WS() + WS_WOUT), M, D, D, 256}; pg8::SplitOrder S{8, G, bx}; pg8::EpiSlab E{(float*)(p.WS() + WS_SLAB)};
        pg8::gemm_phase<pg8::EpiSlab, pg8::SplitOrder, PG8_ALIGN, PG8_SP2>(lds + RING_OFF, g, S, E); } }
    SEAM(10);
    if (IN(11)) { PART_ENV const int nit = fix_rows_n(gw, NGW); for (int it = 0; it < nit; ++it) { const int row = fix_row_at(gw, NGW, it); const float* mr = mods + (size_t)row_bm(row) * NMOD + 6 * D;
        bf16_t* xb = (bf16_t*)(p.WS() + WS_XB) + (size_t)row * D; f32x4 v[8]; row_load_b(v, xb, lane);
        if (row >= MP) { fix_add<8>(v, (const float*)(p.WS() + WS_SLAB) + (size_t)(row - MP) * D, mr - D, 1.0f, lane); row_store_b(v, xb, lane); }
        normmod_q8_vals(v, p.f2_g, mr + D, mr, p.WS() + WS_H8 + (size_t)row * D, (float*)(p.WS() + WS_SA) + row, lane); } }
    SEAM(11);
    if (IN(12)) { PART_ENV pg8::Gemm g{(const bf16_t*)(p.WS() + WS_H8), (const bf16_t*)(p.WS() + WS_W2GU8), M, 2 * FF, D / 2, D / 2}; pg8::StaticOrder S; S.init(MP, 2 * FF, G, bx);
        pg8::EpiSwigluI8 E{ACT, (const float*)(p.WS() + WS_SA), (const float*)(p.WS() + WS_CTL + CTL_CMAX) + 2 * FF, (float*)(p.WS() + WS_RMAXP), p.WS() + WS_ACT8};
        pg8::gemm_phase<pg8::EpiSwigluI8, pg8::StaticOrder, PG8_ALIGN, PG8_SP2>(lds + RING_OFF, g, S, E); }
    if (IN(12) && IN(16)) xcd_barrier(bar);
    if (IN(16)) { PART_ENV
        const int ngemm = G > 88 ? 88 : G, nreq = G > 88 ? G - 88 : G, creq = G > 88 ? bx - 88 : bx;
        if (bx < ngemm) { pg8::Gemm g{(const bf16_t*)(p.WS() + WS_H8), (const bf16_t*)(p.WS() + WS_W2GU8), M, 2 * FF, D / 2, D / 2}; pg8::SampleOrder S; S.init(2 * FF, ngemm, bx);
            pg8::EpiSwigluI8 E{ACT, (const float*)(p.WS() + WS_SA), (const float*)(p.WS() + WS_CTL + CTL_CMAX) + 2 * FF, (float*)(p.WS() + WS_RMAXP), p.WS() + WS_ACT8};
            pg8::gemm_phase<pg8::EpiSwigluI8, pg8::SampleOrder, PG8_ALIGN, PG8_SP2>(lds + RING_OFF, g, S, E); }
        if (creq >= 0) for (int row = creq * 8 + wave; row < MP; row += nreq * 8) requant_act_row(p.WS() + WS_ACT8 + (size_t)row * FF, (const float*)(p.WS() + WS_RMAXP) + (size_t)row * 176, (float*)(p.WS() + WS_SA2) + row, lane); }
    if (IN(16) && IN(13)) xcd_barrier(bar);
    if (IN(13)) { PART_ENV
#pragma nounroll
      for (int s_ = 0; s_ < 2; ++s_) {
        if ((s_ == 0) != ((bx & 1) != 0)) { pg8::Gemm g{(const bf16_t*)(p.WS() + WS_ACT8), (const bf16_t*)(p.WS() + WS_W2D8), MP, D, FF / 2, FF / 2}; pg8::StaticOrder S; S.init(MP, D, G, bx, 4);
        pg8::EpiResidI8T<true, false> E{(bf16_t*)(p.WS() + WS_XB), X, mods + 8 * D, 0.5f, (const float*)(p.WS() + WS_SA2), (const float*)(p.WS() + WS_CTL + CTL_CMAX) + 4 * FF + D};
        pg8::gemm_phase<pg8::EpiResidI8T<true, false>, pg8::StaticOrder, PG8_ALIGN, PG8_SP2>(lds + RING_OFF, g, S, E); }
        else { pg8::Gemm g{ACT, (const bf16_t*)(p.WS() + WS_W2D), M, D, FF, 512}; pg8::SplitOrder S{11, G, (bx & 1) ? (bx >> 1) : (G >> 1) + (bx >> 1)}; pg8::EpiSlab E{(float*)(p.WS() + WS_SLAB)};
        pg8::gemm_phase<pg8::EpiSlab, pg8::SplitOrder, PG8_ALIGN, PG8_SP2>(lds + RING_OFF, g, S, E); }
        __syncthreads(); } }
    SEAM(13);
    if (IN(14)) { PART_ENV for (int t = gw; t < 4 * MS; t += NGW) { int ln = lane; asm volatile("" : "+v"(ln)); const int row = MP + (t >> 2), j0 = 2 * (t & 3);
        const float* mr = mods + (size_t)row_bm(row) * NMOD + 8 * D; const bf16_t* xr = (const bf16_t*)(p.WS() + WS_XB) + (size_t)row * D; const float* slab = (const float*)(p.WS() + WS_SLAB) + (size_t)(row - MP) * D;
        f32x4 v[2], a[2];
#pragma unroll
        for (int jj = 0; jj < 2; ++jj) { const u32x2 w = *(const u32x2*)(xr + 256 * (j0 + jj) + 4 * ln); v[jj][0] = bflo(w.x); v[jj][1] = bfhi(w.x); v[jj][2] = bflo(w.y); v[jj][3] = bfhi(w.y); a[jj] = (f32x4){0.f, 0.f, 0.f, 0.f};
#pragma unroll
            for (int k = 0; k < 11; ++k) a[jj] += ((const f32x4*)(slab + (size_t)k * MS * D))[64 * (j0 + jj) + ln]; }
#pragma unroll
        for (int jj = 0; jj < 2; ++jj) ((f32x4*)(X + (size_t)row * D))[64 * (j0 + jj) + ln] = v[jj] + (((const f32x4*)mr)[64 * (j0 + jj) + ln] * 0.5f) * a[jj]; } }
#undef IN
#undef SEAM
}

extern "C" void kernel_launch(void* const* d_in, const int* in_sizes, int n_in, void* d_out, int out_size, void* d_ws, size_t ws_size, hipStream_t stream) {
    static int ok = 0, grid = 0;
    if (ok == 0) {
        if (n_in != 31 || out_size != (int)O_END || ws_size < WS_END) { fprintf(stderr, "kernel_launch: unexpected shapes: n_in %d out %d ws %zu (need %zu)\n", n_in, out_size, ws_size, (size_t)WS_END); ok = -1; return; }
        if (hipFuncSetAttribute((const void*)mk_fwd, hipFuncAttributeMaxDynamicSharedMemorySize, LDS_BYTES) != hipSuccess) { fprintf(stderr, "kernel_launch: hipFuncSetAttribute(mk_fwd) failed\n"); ok = -1; return; }
        int dev = 0, cus = 0; if (hipGetDevice(&dev) != hipSuccess || hipDeviceGetAttribute(&cus, hipDeviceAttributeMultiprocessorCount, dev) != hipSuccess || cus < 8) { fprintf(stderr, "kernel_launch: device query failed\n"); ok = -1; return; }
        grid = cus;
        ok = 1;
    }
    if (ok < 0) return;
    Ptrs p{};
    const float* const* f = (const float* const*)d_in;
    p.x_p = f[0]; p.x_s = f[1]; p.c_p = f[2]; p.c_s = f[3]; p.cache_k = f[4]; p.cache_v = f[5]; p.cache_ik = f[6]; p.page_table = (const int*)d_in[7];
    p.state_C = f[8]; p.state_n = f[9]; p.state_m = f[10]; p.state_conv = f[11];
    p.f1_g = f[12]; p.f1_wg = f[13]; p.f1_wu = f[14]; p.f1_wd = f[15]; p.mix_g = f[16]; p.w_in = f[17]; p.conv_w = f[18]; p.gate_b = f[19]; p.out_g = f[20]; p.qn_g = f[21]; p.kn_g = f[22]; p.t5 = f[23];
    p.w_out = f[24]; p.f2_g = f[25]; p.f2_wg = f[26]; p.f2_wu = f[27]; p.f2_wd = f[28]; p.w_ada = f[29]; p.b_ada = f[30];
    p.out = (float*)d_out; p.ws_ = (unsigned char*)d_ws;
    if (hipMemsetAsync((char*)d_ws + WS_CTL, 0, CTL_ZERO_BYTES, stream) != hipSuccess) { fprintf(stderr, "kernel_launch: memset failed\n"); return; }
    MkArgs a{}; a.p = p;
    a.sub = 127; a.pad = 0;
#ifdef MK_SEQ
    { static const int seq[] = {MK_SEQ}; for (unsigned i = 0; i < sizeof(seq) / sizeof(seq[0]); ++i) { a.ph_lo = seq[i] & 255; a.ph_hi = a.ph_lo + 1; a.sub = (seq[i] >> 8) ? (seq[i] >> 8) : 127; hipLaunchKernelGGL(mk_fwd, dim3(grid), dim3(512), LDS_BYTES, stream, a); } }
#else
    a.ph_lo = 0; a.ph_hi = 17; hipLaunchKernelGGL(mk_fwd, dim3(grid), dim3(512), LDS_BYTES, stream, a);
#endif
}
```

```cpp
#include <hip/hip_runtime.h>
#include <stdint.h>
#include <stdio.h>

typedef unsigned short bf16_t;
typedef float f32x4 __attribute__((ext_vector_type(4)));
typedef unsigned u32x2 __attribute__((ext_vector_type(2)));
typedef unsigned u32x4 __attribute__((ext_vector_type(4)));
typedef unsigned long long u64;

constexpr int D = 2048, BP = 8, TP = 2048, BS = 128, TS = 4;
constexpr int MP = BP * TP, MS = BS * TS, M = MP + MS;
constexpr int FF = 5632, NMOD = 9 * D, NB = BP + BS;
constexpr int PW = 6224;
constexpr int PROJ_LD = 6144, SMALL_LD = 128;
constexpr int SCS_LD = 2112;
constexpr float EPS = 1e-6f;
constexpr int PC_QM = 0, PC_KM = 1024, PC_VM = 2048, PC_OM = 3072, PC_QA = 4096, PC_KA = 5120, PC_VA = 5376, PC_QI = 5632;

constexpr size_t O_Y = 0;
constexpr size_t O_KP = O_Y + (size_t)M * D;
constexpr size_t O_VP = O_KP + (size_t)MP * 256;
constexpr size_t O_IKP = O_VP + (size_t)MP * 256;
constexpr size_t O_CP = O_IKP + (size_t)MP * 64;
constexpr size_t O_NP = O_CP + (size_t)BP * 4 * 65536;
constexpr size_t O_MP = O_NP + (size_t)BP * 4 * 256;
constexpr size_t O_CVP = O_MP + (size_t)BP * 4;
constexpr size_t O_KS = O_CVP + (size_t)BP * 3 * 2048;
constexpr size_t O_VS = O_KS + (size_t)MS * 256;
constexpr size_t O_IKS = O_VS + (size_t)MS * 256;
constexpr size_t O_CS = O_IKS + (size_t)MS * 64;
constexpr size_t O_NS = O_CS + (size_t)BS * 4 * 65536;
constexpr size_t O_MS = O_NS + (size_t)BS * 4 * 256;
constexpr size_t O_CVS = O_MS + (size_t)BS * 4;
constexpr size_t O_END = O_CVS + (size_t)BS * 3 * 2048;
static_assert(O_END == 80962080, "output size");

constexpr size_t al256(size_t x) { return (x + 255) & ~(size_t)255; }
constexpr size_t WS_CTL = 0;
constexpr size_t WS_MODS = 1u << 20;
constexpr size_t WS_H = al256(WS_MODS + (size_t)NB * NMOD * 4);
constexpr size_t WS_ACT = al256(WS_H + (size_t)M * D * 2);
constexpr size_t WS_PROJ = al256(WS_ACT + (size_t)M * FF * 2);
constexpr size_t WS_SMALL = al256(WS_PROJ + (size_t)M * PROJ_LD * 2);
constexpr size_t WS_QA = al256(WS_SMALL + (size_t)M * SMALL_LD * 4);
constexpr size_t WS_KA = al256(WS_QA + (size_t)M * 1024 * 2);
constexpr size_t WS_QM = al256(WS_KA + (size_t)M * 256 * 2);
constexpr size_t WS_KM = al256(WS_QM + (size_t)M * 1024 * 2);
constexpr size_t WS_HM = al256(WS_KM + (size_t)M * 1024 * 2);
constexpr size_t WS_CAT = al256(WS_HM + (size_t)M * 1024 * 4);
constexpr size_t WS_BC = al256(WS_CAT + (size_t)M * D * 2);
constexpr size_t WS_IG = al256(WS_BC + (size_t)32 * 2048 * 4);
constexpr size_t WS_MM = al256(WS_IG + (size_t)32 * 2048 * 4);
constexpr size_t WS_SC = al256(WS_MM + (size_t)32 * 2048 * 4);
constexpr size_t WS_SCS = al256(WS_SC + (size_t)MP * 2048 * 4);
constexpr size_t WS_MASK = al256(WS_SCS + (size_t)MS * SCS_LD * 4);
constexpr size_t WS_MASKS = al256(WS_MASK + (size_t)MP * 32 * 8);
constexpr size_t WS_KI = al256(WS_MASKS + (size_t)MS * 33 * 8);
constexpr size_t WS_SLAB = al256(WS_KI + (size_t)M * 64 * 2);
constexpr size_t WS_XB = al256(WS_SLAB + (size_t)11 * MS * D * 4);
constexpr size_t WS_H8 = al256(WS_XB + (size_t)M * D * 2);
constexpr size_t WS_SA = al256(WS_H8 + (size_t)M * D);
constexpr size_t WS_W1GU8 = al256(WS_SA + (size_t)M * 4);
constexpr size_t WS_W2GU8 = al256(WS_W1GU8 + (size_t)2 * FF * D);
constexpr size_t WS_ACT8 = al256(WS_W2GU8 + (size_t)2 * FF * D);
constexpr size_t WS_SA2 = al256(WS_ACT8 + (size_t)M * FF);
constexpr size_t WS_RMAXP = al256(WS_SA2 + (size_t)M * 4);
constexpr size_t WS_W1D8 = al256(WS_RMAXP + (size_t)M * 176 * 4);
constexpr size_t WS_W2D8 = al256(WS_W1D8 + (size_t)D * FF);
constexpr size_t WS_W1GU = al256(WS_W2D8 + (size_t)D * FF);
constexpr size_t WS_W1D = al256(WS_W1GU + (size_t)2 * FF * D * 2);
constexpr size_t WS_WIN = al256(WS_W1D + (size_t)D * FF * 2);
constexpr size_t WS_WOUT = al256(WS_WIN + (size_t)6400 * D * 2);
constexpr size_t WS_W2GU = al256(WS_WOUT + (size_t)D * D * 2);
constexpr size_t WS_W2D = al256(WS_W2GU + (size_t)2 * FF * D * 2);
constexpr size_t WS_END = al256(WS_W2D + (size_t)D * FF * 2);

struct Ptrs {
    const float *x_p, *x_s, *c_p, *c_s, *cache_k, *cache_v, *cache_ik; const int* page_table;
    const float *state_C, *state_n, *state_m, *state_conv;
    const float *f1_g, *f1_wg, *f1_wu, *f1_wd, *mix_g, *w_in, *conv_w, *gate_b, *out_g, *qn_g, *kn_g, *t5, *w_out, *f2_g, *f2_wg, *f2_wu, *f2_wd, *w_ada, *b_ada;
    float* out; unsigned char* ws_;
    __device__ __forceinline__ unsigned char* WS() const { const unsigned long long w = (unsigned long long)ws_; unsigned w0 = (unsigned)w, w1 = (unsigned)(w >> 32); asm volatile("" : "+v"(w0), "+v"(w1));
        return (unsigned char*)(__attribute__((address_space(1))) unsigned char*)(((unsigned long long)(unsigned)__builtin_amdgcn_readfirstlane(w1) << 32) | (unsigned)__builtin_amdgcn_readfirstlane(w0)); }
};

__device__ __forceinline__ float bf2f(bf16_t v) { return __uint_as_float(((unsigned)v) << 16); }
__device__ __forceinline__ bf16_t f2bf(float f) { unsigned u = __float_as_uint(f); u += 0x7fffu + ((u >> 16) & 1u); return (bf16_t)(u >> 16); }
__device__ __forceinline__ unsigned pk2(float lo, float hi) { return (unsigned)f2bf(lo) | ((unsigned)f2bf(hi) << 16); }
__device__ __forceinline__ float bflo(unsigned w) { return __uint_as_float(w << 16); }
__device__ __forceinline__ float bfhi(unsigned w) { return __uint_as_float(w & 0xffff0000u); }
__device__ __forceinline__ float wave_sum(float v) {
#pragma unroll
    for (int o = 1; o < 64; o <<= 1) v += __shfl_xor(v, o);
    return v;
}
__device__ __forceinline__ float wave_max(float v) {
#pragma unroll
    for (int o = 1; o < 64; o <<= 1) v = fmaxf(v, __shfl_xor(v, o));
    return v;
}
__device__ __forceinline__ float x16_max(float x) { const auto r = __builtin_amdgcn_permlane16_swap(__float_as_uint(x), __float_as_uint(x), false, false); return fmaxf(__uint_as_float(r[0]), __uint_as_float(r[1])); }
__device__ __forceinline__ float x32_max(float x) { const auto r = __builtin_amdgcn_permlane32_swap(__float_as_uint(x), __float_as_uint(x), false, false); return fmaxf(__uint_as_float(r[0]), __uint_as_float(r[1])); }
__device__ __forceinline__ float x16_sum(float x) { const auto r = __builtin_amdgcn_permlane16_swap(__float_as_uint(x), __float_as_uint(x), false, false); return __uint_as_float(r[0]) + __uint_as_float(r[1]); }
__device__ __forceinline__ float x32_sum(float x) { const auto r = __builtin_amdgcn_permlane32_swap(__float_as_uint(x), __float_as_uint(x), false, false); return __uint_as_float(r[0]) + __uint_as_float(r[1]); }
__device__ __forceinline__ float silu_f(float x) { return x / (1.0f + __expf(-x)); }
__device__ __forceinline__ int row_bm(int row) { return row < MP ? (row >> 11) : BP + ((row - MP) >> 2); }
__device__ __forceinline__ int t5_bucket(int dist) {
    if (dist < 16) return dist;
    const float ratio = logf((float)dist / 16.0f) / 2.0794415416798357f;
    int large = 16 + (int)(ratio * 16.0f);
    return large < 31 ? large : 31;
}

__device__ __forceinline__ void normmod_vals(const f32x4 (&v)[8], const float* g, const float* sc, const float* sh, bf16_t* hr, int lane);
__device__ __forceinline__ void normmod_row(const float* xr, const float* g, const float* sc, const float* sh, bf16_t* hr, int lane) {
    f32x4 v[8];
#pragma unroll
    for (int j = 0; j < 8; ++j) v[j] = ((const f32x4*)xr)[64 * j + lane];
    normmod_vals(v, g, sc, sh, hr, lane);
}
template <int NS> __device__ __forceinline__ void normmod_fix_row(const float* base, const float* slab, const float* gate, const float scale, float* xo, const float* g, const float* sc, const float* sh, bf16_t* hr, int lane) {
    f32x4 v[8];
#pragma unroll
    for (int j = 0; j < 8; ++j) { f32x4 a = (f32x4){0.f, 0.f, 0.f, 0.f};
#pragma unroll
        for (int k = 0; k < NS; ++k) a += ((const f32x4*)(slab + (size_t)k * MS * D))[64 * j + lane];
        v[j] = ((const f32x4*)base)[64 * j + lane] + (((const f32x4*)gate)[64 * j + lane] * scale) * a; ((f32x4*)xo)[64 * j + lane] = v[j]; }
    if (hr) normmod_vals(v, g, sc, sh, hr, lane);
}
__device__ __forceinline__ void normmod_vals(const f32x4 (&v)[8], const float* g, const float* sc, const float* sh, bf16_t* hr, int lane) {
    float ss = 0.f;
#pragma unroll
    for (int j = 0; j < 8; ++j) ss += (v[j][0] * v[j][0] + v[j][1] * v[j][1]) + (v[j][2] * v[j][2] + v[j][3] * v[j][3]);
    ss = wave_sum(ss);
    const float r = 1.0f / sqrtf(ss * (1.0f / D) + EPS);
#pragma unroll
    for (int j = 0; j < 8; ++j) {
        const int col = 256 * j + 4 * lane;
        const f32x4 gg = *(const f32x4*)(g + col), s = *(const f32x4*)(sc + col), h = *(const f32x4*)(sh + col);
        const f32x4 o = v[j] * r * gg * (1.0f + s) + h;
        u32x2 w; w[0] = pk2(o[0], o[1]); w[1] = pk2(o[2], o[3]);
        *(u32x2*)(hr + col) = w;
    }
}

__device__ __forceinline__ void row_load(f32x4 (&v)[8], const float* xr, int lane) {
#pragma unroll
    for (int j = 0; j < 8; ++j) v[j] = ((const f32x4*)xr)[64 * j + lane];
}
__device__ __forceinline__ void row_load_b(f32x4 (&v)[8], const bf16_t* xr, int lane) {
#pragma unroll
    for (int j = 0; j < 8; ++j) { const u32x2 w = *(const u32x2*)(xr + 256 * j + 4 * lane); v[j][0] = bflo(w.x); v[j][1] = bfhi(w.x); v[j][2] = bflo(w.y); v[j][3] = bfhi(w.y); }
}
__device__ __forceinline__ void row_store_b(const f32x4 (&v)[8], bf16_t* xr, int lane) {
#pragma unroll
    for (int j = 0; j < 8; ++j) { u32x2 w; w.x = pk2(v[j][0], v[j][1]); w.y = pk2(v[j][2], v[j][3]); *(u32x2*)(xr + 256 * j + 4 * lane) = w; }
}
template <int NS> __device__ __forceinline__ void fix_add(f32x4 (&v)[8], const float* slab, const float* gate, const float scale, int lane) {
#pragma unroll
    for (int j = 0; j < 8; j += 2) { f32x4 a = (f32x4){0.f, 0.f, 0.f, 0.f}, b = a;
#pragma unroll
        for (int k = 0; k < NS; ++k) { a += ((const f32x4*)(slab + (size_t)k * MS * D))[64 * j + lane]; b += ((const f32x4*)(slab + (size_t)k * MS * D))[64 * (j + 1) + lane]; }
        v[j] += (((const f32x4*)gate)[64 * j + lane] * scale) * a; v[j + 1] += (((const f32x4*)gate)[64 * (j + 1) + lane] * scale) * b;
        asm volatile("" : "+v"(v[j]), "+v"(v[j + 1]) :: "memory"); }
}
__device__ __forceinline__ int fix_rows_n(int gw, int NGW) { return NGW == 2048 ? (gw < 512 ? 6 : 9) : (M - gw + NGW - 1) / NGW; }
__device__ __forceinline__ int fix_row_at(int gw, int NGW, int it) {
    if (NGW != 2048) return gw + it * NGW;
    if (gw < 512) return it == 0 ? MP + gw : gw + (it - 1) * 2048;
    return it < 8 ? gw + it * 2048 : ((gw - 512) & 511) + (5 + ((gw - 512) >> 9)) * 2048;
}
__device__ __forceinline__ unsigned q8x4(float a, float b, float c, float d, float inv) {
    const int qa = (int)rintf(fminf(fmaxf(a * inv, -127.f), 127.f)), qb = (int)rintf(fminf(fmaxf(b * inv, -127.f), 127.f)), qc = (int)rintf(fminf(fmaxf(c * inv, -127.f), 127.f)), qd = (int)rintf(fminf(fmaxf(d * inv, -127.f), 127.f));
    return (unsigned)(qa & 0xff) | ((unsigned)(qb & 0xff) << 8) | ((unsigned)(qc & 0xff) << 16) | ((unsigned)(qd & 0xff) << 24);
}
template <int KW> __device__ __forceinline__ void quant_wrow(const bf16_t* wrow, unsigned char* orow, unsigned* cm, int lane) {
    const float mx = fmaxf(__uint_as_float(*cm), 1e-30f), inv = 127.0f / mx;
#pragma unroll
    for (int j = 0; j < KW / 512; ++j) { const u32x4 w = *(const u32x4*)(wrow + 8 * lane + 512 * j); u32x2 o;
        o.x = q8x4(bflo(w.x), bfhi(w.x), bflo(w.y), bfhi(w.y), inv); o.y = q8x4(bflo(w.z), bfhi(w.z), bflo(w.w), bfhi(w.w), inv);
        *(u32x2*)(orow + 8 * lane + 512 * j) = o; }
    if (lane == 0) *(float*)cm = mx * (1.0f / 127.0f);
}
__device__ __forceinline__ void requant_act_row(unsigned char* arow, const float* rmp, float* sa2, int lane) {
    float mx = fmaxf(rmp[lane], rmp[64 + lane]); if (lane < 48) mx = fmaxf(mx, rmp[128 + lane]);
    mx = fmaxf(wave_max(mx), 1e-30f); const float rinv = 1.0f / mx;
    u32x2 w[11]; float f[11];
#pragma unroll
    for (int j = 0; j < 11; ++j) { w[j] = *(const u32x2*)(arow + 8 * lane + 512 * j); f[j] = rmp[16 * j + (lane >> 2)] * rinv; }
#pragma unroll
    for (int j = 0; j < 11; ++j) { unsigned b[8];
#pragma unroll
        for (int e = 0; e < 4; ++e) { b[e] = __float_as_uint(__builtin_fmaf((float)((w[j].x >> (8 * e)) & 255u) - 128.0f, f[j], 12582912.0f)); b[4 + e] = __float_as_uint(__builtin_fmaf((float)((w[j].y >> (8 * e)) & 255u) - 128.0f, f[j], 12582912.0f)); }
        u32x2 o; o.x = __builtin_amdgcn_perm(b[1], b[0], 0x0c0c0400u) | __builtin_amdgcn_perm(b[3], b[2], 0x04000c0cu); o.y = __builtin_amdgcn_perm(b[5], b[4], 0x0c0c0400u) | __builtin_amdgcn_perm(b[7], b[6], 0x04000c0cu);
        *(u32x2*)(arow + 8 * lane + 512 * j) = o; }
    if (lane == 0) *sa2 = mx * (1.0f / 127.0f);
}
__device__ __forceinline__ void normmod_q8_vals(f32x4 (&v)[8], const float* g, const float* sc, const float* sh, unsigned char* hr, float* sa, int lane) {
    float ss = 0.f;
#pragma unroll
    for (int j = 0; j < 8; ++j) ss += (v[j][0] * v[j][0] + v[j][1] * v[j][1]) + (v[j][2] * v[j][2] + v[j][3] * v[j][3]);
    ss = wave_sum(ss);
    const float r = 1.0f / sqrtf(ss * (1.0f / D) + EPS); float amax = 0.f;
#pragma unroll
    for (int j = 0; j < 8; ++j) { const int col = 256 * j + 4 * lane; const f32x4 gg = *(const f32x4*)(g + col), s = *(const f32x4*)(sc + col), h = *(const f32x4*)(sh + col);
        v[j] = v[j] * r * gg * (1.0f + s) + h; amax = fmaxf(amax, fmaxf(fmaxf(fabsf(v[j][0]), fabsf(v[j][1])), fmaxf(fabsf(v[j][2]), fabsf(v[j][3])))); }
    amax = fmaxf(wave_max(amax), 1e-30f); const float inv = 127.0f / amax;
#pragma unroll
    for (int j = 0; j < 8; ++j) *(unsigned*)(hr + 256 * j + 4 * lane) = q8x4(v[j][0], v[j][1], v[j][2], v[j][3], inv);
    if (lane == 0) *sa = amax * (1.0f / 127.0f);
}
__device__ __forceinline__ void normmod_q8(const float* xr, const float* g, const float* sc, const float* sh, unsigned char* hr, float* sa, int lane) {
    f32x4 v[8];
#pragma unroll
    for (int j = 0; j < 8; ++j) v[j] = ((const f32x4*)xr)[64 * j + lane];
    normmod_q8_vals(v, g, sc, sh, hr, sa, lane);
}
template <int NS> __device__ __forceinline__ void fix_row_vals(f32x4 (&v)[8], const float* base, const float* slab, const float* gate, const float scale, float* xo, int lane) {
#pragma unroll
    for (int j = 0; j < 8; ++j) { f32x4 a = (f32x4){0.f, 0.f, 0.f, 0.f};
#pragma unroll
        for (int k = 0; k < NS; ++k) a += ((const f32x4*)(slab + (size_t)k * MS * D))[64 * j + lane];
        v[j] = ((const f32x4*)base)[64 * j + lane] + (((const f32x4*)gate)[64 * j + lane] * scale) * a; ((f32x4*)xo)[64 * j + lane] = v[j]; }
}

__device__ __forceinline__ void post_row(const Ptrs& p, int row, int lane) {
    const bf16_t* PROJ = (const bf16_t*)(p.WS() + WS_PROJ); const float* SMALL = (const float*)(p.WS() + WS_SMALL);
    const bf16_t* pr = PROJ + (size_t)row * PROJ_LD; const float* sm = SMALL + (size_t)row * SMALL_LD;
    const bool prompt = row < MP; const int b = prompt ? row >> 11 : (row - MP) >> 2, t = prompt ? row & 2047 : (row - MP) & 3;
    const int rrel = prompt ? row : row - MP;
    const u32x4 ld_q0 = *(const u32x4*)(pr + PC_QA + 16 * lane), ld_q1 = *(const u32x4*)(pr + PC_QA + 16 * lane + 8);
    const u32x2 ld_k = *(const u32x2*)(pr + PC_KA + 4 * lane), ld_v = *(const u32x2*)(pr + PC_VA + 4 * lane); const float ld_ki = sm[lane];
    {
        const u32x4 w0 = ld_q0, w1 = ld_q1;
        float q[16];
#pragma unroll
        for (int i = 0; i < 4; ++i) { q[2 * i] = bflo(w0[i]); q[2 * i + 1] = bfhi(w0[i]); q[8 + 2 * i] = bflo(w1[i]); q[8 + 2 * i + 1] = bfhi(w1[i]); }
        float ss = 0.f;
#pragma unroll
        for (int i = 0; i < 16; ++i) ss += q[i] * q[i];
        ss += __shfl_xor(ss, 1); ss += __shfl_xor(ss, 2); ss += __shfl_xor(ss, 4);
        const float r = (1.0f / sqrtf(ss * (1.0f / 128.0f) + EPS)) * 0.08838834764831845f;
        const float* gq = p.qn_g + ((16 * lane) & 127);
        u32x4 o0, o1;
#pragma unroll
        for (int i = 0; i < 4; ++i) { o0[i] = pk2(q[2 * i] * r * gq[2 * i], q[2 * i + 1] * r * gq[2 * i + 1]); o1[i] = pk2(q[8 + 2 * i] * r * gq[8 + 2 * i], q[8 + 2 * i + 1] * r * gq[8 + 2 * i + 1]); }
        bf16_t* qa = (bf16_t*)(p.WS() + WS_QA) + (size_t)row * 1024 + 16 * lane;
        *(u32x4*)qa = o0; *(u32x4*)(qa + 8) = o1;
    }
    {
        const u32x2 w = ld_k;
        float k[4] = {bflo(w[0]), bfhi(w[0]), bflo(w[1]), bfhi(w[1])};
        float ss = (k[0] * k[0] + k[1] * k[1]) + (k[2] * k[2] + k[3] * k[3]);
        ss += __shfl_xor(ss, 1); ss += __shfl_xor(ss, 2); ss += __shfl_xor(ss, 4); ss += __shfl_xor(ss, 8); ss += __shfl_xor(ss, 16);
        const float r = 1.0f / sqrtf(ss * (1.0f / 128.0f) + EPS);
        const f32x4 gk = *(const f32x4*)(p.kn_g + ((4 * lane) & 127));
        f32x4 o; o[0] = k[0] * r * gk[0]; o[1] = k[1] * r * gk[1]; o[2] = k[2] * r * gk[2]; o[3] = k[3] * r * gk[3];
        *(f32x4*)(p.out + (prompt ? O_KP : O_KS) + (size_t)rrel * 256 + 4 * lane) = o;
        u32x2 ob; ob[0] = pk2(o[0], o[1]); ob[1] = pk2(o[2], o[3]);
        *(u32x2*)((bf16_t*)(p.WS() + WS_KA) + (size_t)row * 256 + 4 * lane) = ob;
        const u32x2 wv = ld_v;
        f32x4 ov; ov[0] = bflo(wv[0]); ov[1] = bfhi(wv[0]); ov[2] = bflo(wv[1]); ov[3] = bfhi(wv[1]);
        *(f32x4*)(p.out + (prompt ? O_VP : O_VS) + (size_t)rrel * 256 + 4 * lane) = ov;
    }
    { const float kv = ld_ki; p.out[(prompt ? O_IKP : O_IKS) + (size_t)rrel * 64 + lane] = kv; ((bf16_t*)(p.WS() + WS_KI))[(size_t)row * 64 + lane] = f2bf(kv); }
    if (!prompt) {
        bf16_t* QM = (bf16_t*)(p.WS() + WS_QM); bf16_t* KM = (bf16_t*)(p.WS() + WS_KM);
#pragma unroll
        for (int j = 0; j < 4; ++j) {
            const int c = 8 * lane + 512 * j;
            float xs[4][8];
#pragma unroll
            for (int k = 0; k < 4; ++k) {
                if (t - k >= 0) { const u32x4 w = *(const u32x4*)(pr - (size_t)k * PROJ_LD + c);
#pragma unroll
                    for (int i = 0; i < 4; ++i) { xs[k][2 * i] = bflo(w[i]); xs[k][2 * i + 1] = bfhi(w[i]); } }
                else if (prompt) {
#pragma unroll
                    for (int i = 0; i < 8; ++i) xs[k][i] = 0.f; }
                else { const float* sb = p.state_conv + ((size_t)b * 3 + (3 + t - k)) * 2048 + c; const f32x4 a0 = *(const f32x4*)sb, a1 = *(const f32x4*)(sb + 4);
#pragma unroll
                    for (int i = 0; i < 4; ++i) { xs[k][i] = a0[i]; xs[k][4 + i] = a1[i]; } }
            }
            float y[8];
#pragma unroll
            for (int i = 0; i < 8; ++i) y[i] = 0.f;
#pragma unroll
            for (int k = 0; k < 4; ++k) { const float* wk = p.conv_w + (size_t)(3 - k) * 2048 + c; const f32x4 a0 = *(const f32x4*)wk, a1 = *(const f32x4*)(wk + 4);
#pragma unroll
                for (int i = 0; i < 4; ++i) { y[i] += a0[i] * xs[k][i]; y[4 + i] += a1[i] * xs[k][4 + i]; } }
            const float scl = c < 1024 ? 1.0f : 0.0625f;
            u32x4 o;
#pragma unroll
            for (int i = 0; i < 4; ++i) o[i] = pk2(silu_f(y[2 * i]) * scl, silu_f(y[2 * i + 1]) * scl);
            if (c < 1024) *(u32x4*)(QM + (size_t)row * 1024 + c) = o; else *(u32x4*)(KM + (size_t)row * 1024 + (c - 1024)) = o;
            const int slot = prompt ? t - (TP - 3) : t - 1;
            if (slot >= 0) { float* cv = p.out + (prompt ? O_CVP : O_CVS) + ((size_t)b * 3 + slot) * 2048 + c;
                f32x4 a0, a1;
#pragma unroll
                for (int i = 0; i < 4; ++i) { a0[i] = xs[0][i]; a1[i] = xs[0][4 + i]; }
                *(f32x4*)cv = a0; *(f32x4*)(cv + 4) = a1; }
        }
    }
}
__device__ __forceinline__ void conv_load(u32x2 (&xr)[11], const Ptrs& p, const int unit, const int lane) {
    const bf16_t* PROJ = (const bf16_t*)(p.WS() + WS_PROJ);
    const int rg = unit >> 3, slab = unit & 7, row0 = 8 * rg, t0 = row0 & 2047, c = 256 * slab + 4 * lane;
#pragma unroll
    for (int i = 0; i < 11; ++i) { if (t0 + i - 3 >= 0) xr[i] = *(const u32x2*)(PROJ + (size_t)(row0 + i - 3) * PROJ_LD + c); else { xr[i].x = 0u; xr[i].y = 0u; } }
}
__device__ __forceinline__ void conv_compute(const u32x2 (&xr)[11], const f32x4 (&w)[4], const Ptrs& p, const int unit, const int lane) {
    bf16_t* QM = (bf16_t*)(p.WS() + WS_QM); bf16_t* KM = (bf16_t*)(p.WS() + WS_KM);
    const int rg = unit >> 3, slab = unit & 7, row0 = 8 * rg, t0 = row0 & 2047, b = row0 >> 11, c = 256 * slab + 4 * lane;
    const float scl = c < 1024 ? 1.0f : 0.0625f; bf16_t* dst = c < 1024 ? QM + c : KM + (c - 1024);
#pragma unroll
    for (int i = 0; i < 8; ++i) {
        f32x4 y = (f32x4){0.f, 0.f, 0.f, 0.f};
#pragma unroll
        for (int k = 0; k < 4; ++k) { const u32x2 x = xr[i + k]; f32x4 xv; xv[0] = bflo(x.x); xv[1] = bfhi(x.x); xv[2] = bflo(x.y); xv[3] = bfhi(x.y); y += w[k] * xv; }
        u32x2 o; o.x = pk2(silu_f(y[0]) * scl, silu_f(y[1]) * scl); o.y = pk2(silu_f(y[2]) * scl, silu_f(y[3]) * scl);
        *(u32x2*)(dst + (size_t)(row0 + i) * 1024) = o;
        const int slot = t0 + i - (TP - 3);
        if (slot >= 0) { const u32x2 x = xr[i + 3]; f32x4 xv; xv[0] = bflo(x.x); xv[1] = bfhi(x.x); xv[2] = bflo(x.y); xv[3] = bfhi(x.y); *(f32x4*)(p.out + O_CVP + ((size_t)b * 3 + slot) * 2048 + c) = xv; }
    }
}
__device__ __forceinline__ float logsigmoid_f(float x) { return fminf(x, 0.f) - log1pf(expf(-fabsf(x))); }
__device__ __forceinline__ void scan_bh(const Ptrs& p, int bh, int lane) {
    const float* SMALL = (const float*)(p.WS() + WS_SMALL);
    float* BC = (float*)(p.WS() + WS_BC) + (size_t)bh * 2048; float* IG = (float*)(p.WS() + WS_IG) + (size_t)bh * 2048; float* MMa = (float*)(p.WS() + WS_MM) + (size_t)bh * 2048;
    const int b = bh >> 2, h = bh & 3; const float bi = p.gate_b[h], bfv = p.gate_b[4 + h];
    float lf[32], ig[32];
    float A = 0.f, Bv = -INFINITY;
#pragma unroll
    for (int i = 0; i < 32; ++i) { const float* sm = SMALL + ((size_t)b * 2048 + 32 * lane + i) * SMALL_LD; ig[i] = sm[64 + h] + bi; lf[i] = logsigmoid_f(sm[68 + h] + bfv); A += lf[i]; Bv = fmaxf(Bv + lf[i], ig[i]); }
    const float Aown = A;
#pragma unroll
    for (int off = 1; off < 64; off <<= 1) { const float Ap = __shfl_up(A, off), Bp = __shfl_up(Bv, off); if (lane >= off) { Bv = fmaxf(Bp + A, Bv); A = Ap + A; } }
    float Aex = __shfl_up(A, 1), Bex = __shfl_up(Bv, 1); if (lane == 0) { Aex = 0.f; Bex = -INFINITY; }
    float m = fmaxf(0.0f + Aex, Bex);
    float c = __shfl_up(Aown, 1); if ((lane & 1) == 0) c = 0.f;
#pragma unroll
    for (int i = 0; i < 32; ++i) { m = fmaxf(m + lf[i], ig[i]); c += lf[i]; const int t = 32 * lane + i; MMa[t] = m; BC[t] = c; IG[t] = ig[i]; }
}

__device__ __forceinline__ void mlstm_sample_items(const Ptrs& p, unsigned char* lds, const int first, const int stride, const int tid) {
    float (*qf)[256] = (float (*)[256])(lds); float (*kf)[256] = (float (*)[256])(lds + 4096); float (*vf)[256] = (float (*)[256])(lds + 8192);
    float (*red)[4][256] = (float (*)[4][256])(lds + 12288);
    float* bc = (float*)(lds + 12288 + 32768); float* ig = bc + 4; float* mm = bc + 8; float* sw = bc + 12; float* wl = bc + 16; float (*Pm)[4] = (float (*)[4])(bc + 20); float* qn = bc + 36; float* sc2 = bc + 40;
    const int lane = tid & 63, wv = tid >> 6;
    const bf16_t* QM = (const bf16_t*)(p.WS() + WS_QM); const bf16_t* KM = (const bf16_t*)(p.WS() + WS_KM); const bf16_t* PROJ = (const bf16_t*)(p.WS() + WS_PROJ); const float* SMALL = (const float*)(p.WS() + WS_SMALL);
    float* HM = (float*)(p.WS() + WS_HM);
    for (int item = first; item < BS * 4; item += stride) {
        const int b = item >> 2, h = item & 3; const size_t r0 = (size_t)MP + 4 * b;
        for (int i = tid; i < 1024; i += 512) { const int t = i >> 8, d = i & 255;
            qf[t][d] = bf2f(QM[(r0 + t) * 1024 + h * 256 + d]); kf[t][d] = bf2f(KM[(r0 + t) * 1024 + h * 256 + d]); vf[t][d] = bf2f(PROJ[(r0 + t) * PROJ_LD + PC_VM + h * 256 + d]); }
        if (tid == 0) {
            const float m0 = p.state_m[item]; float m = m0, c = 0.f;
            for (int t = 0; t < 4; ++t) { const float* sm = SMALL + (r0 + t) * SMALL_LD; const float igt = sm[64 + h] + p.gate_b[h], lft = logsigmoid_f(sm[68 + h] + p.gate_b[4 + h]);
                m = fmaxf(m + lft, igt); c += lft; bc[t] = c; ig[t] = igt; mm[t] = m; sw[t] = expf(c + m0 - m); }
            for (int t = 0; t < 4; ++t) wl[t] = expf(bc[3] - bc[t] + ig[t] - mm[3]);
            sc2[0] = expf(bc[3] + m0 - mm[3]);
        }
        __syncthreads();
        if (wv < 4) {
            const int t = wv; float a = 0.f, d0 = 0.f, d1 = 0.f, d2 = 0.f, d3 = 0.f;
            for (int i = 0; i < 4; ++i) { const int d = lane + 64 * i; const float qv = qf[t][d]; a += qv * p.state_n[(size_t)item * 256 + d]; d0 += qv * kf[0][d]; d1 += qv * kf[1][d]; d2 += qv * kf[2][d]; d3 += qv * kf[3][d]; }
            a = wave_sum(a); d0 = wave_sum(d0); d1 = wave_sum(d1); d2 = wave_sum(d2); d3 = wave_sum(d3);
            if (lane == 0) { qn[t] = a; const float dd[4] = {d0, d1, d2, d3};
                for (int s = 0; s < 4; ++s) Pm[t][s] = s <= t ? dd[s] * expf(bc[t] - bc[s] + ig[s] - mm[t]) : 0.f; }
        }
        __syncthreads();
        {
            const int e = 4 * lane; const float decay = sc2[0];
            f32x4 qc[4]; for (int t = 0; t < 4; ++t) qc[t] = (f32x4){0.f, 0.f, 0.f, 0.f};
            f32x4 vv[4]; for (int s = 0; s < 4; ++s) vv[s] = *(const f32x4*)&vf[s][e];
            const float* Cin = p.state_C + (size_t)item * 65536; float* Cout = p.out + O_CS + (size_t)item * 65536;
            for (int i0 = 0; i0 < 32; i0 += 8) { f32x4 c8[8];
#pragma unroll
                for (int ii = 0; ii < 8; ++ii) c8[ii] = *(const f32x4*)(Cin + (size_t)(wv + 8 * (i0 + ii)) * 256 + e);
#pragma unroll
                for (int ii = 0; ii < 8; ++ii) { const int d = wv + 8 * (i0 + ii); const f32x4 c0 = c8[ii];
                    f32x4 cn = c0 * decay;
#pragma unroll
                    for (int s = 0; s < 4; ++s) cn += (wl[s] * kf[s][d]) * vv[s];
                    *(f32x4*)(Cout + (size_t)d * 256 + e) = cn;
#pragma unroll
                    for (int t = 0; t < 4; ++t) qc[t] += qf[t][d] * c0; } }
#pragma unroll
            for (int t = 0; t < 4; ++t) *(f32x4*)&red[wv][t][e] = qc[t];
        }
        __syncthreads();
        for (int i = tid; i < 1024; i += 512) { const int t = i >> 8, e = i & 255; float QC = 0.f;
#pragma unroll
            for (int w = 0; w < 8; ++w) QC += red[w][t][e];
            float num = sw[t] * QC, rs = 0.f;
            for (int s = 0; s <= t; ++s) { num += Pm[t][s] * vf[s][e]; rs += Pm[t][s]; }
            const float den = rs + sw[t] * qn[t];
            HM[(r0 + t) * 1024 + h * 256 + e] = num / fmaxf(fabsf(den), expf(-mm[t])); }
        if (tid < 256) { const int d = tid; float a = sc2[0] * p.state_n[(size_t)item * 256 + d]; for (int s = 0; s < 4; ++s) a += wl[s] * kf[s][d]; p.out[O_NS + (size_t)item * 256 + d] = a; }
        if (tid == 0) p.out[O_MS + item] = mm[3];
        __syncthreads();
    }
}

__device__ __forceinline__ void mlstm_out_row(const Ptrs& p, const int row, const int lane) {
    const float* HM = (const float*)(p.WS() + WS_HM); const bf16_t* PROJ = (const bf16_t*)(p.WS() + WS_PROJ); bf16_t* CAT = (bf16_t*)(p.WS() + WS_CAT);
    {
        const float* hr = HM + (size_t)row * 1024 + 16 * lane; float hv[16];
#pragma unroll
        for (int i = 0; i < 4; ++i) { const f32x4 a = *(const f32x4*)(hr + 4 * i); hv[4 * i] = a[0]; hv[4 * i + 1] = a[1]; hv[4 * i + 2] = a[2]; hv[4 * i + 3] = a[3]; }
        float ss = 0.f;
#pragma unroll
        for (int i = 0; i < 16; ++i) ss += hv[i] * hv[i];
        ss += __shfl_xor(ss, 1); ss += __shfl_xor(ss, 2); ss += __shfl_xor(ss, 4); ss += __shfl_xor(ss, 8);
        const float r = 1.0f / sqrtf(ss * (1.0f / 256.0f) + EPS);
        const bf16_t* orow = PROJ + (size_t)row * PROJ_LD + PC_OM + 16 * lane; const u32x4 w0 = *(const u32x4*)orow, w1 = *(const u32x4*)(orow + 8);
        float ov[16];
#pragma unroll
        for (int i = 0; i < 4; ++i) { ov[2 * i] = bflo(w0[i]); ov[2 * i + 1] = bfhi(w0[i]); ov[8 + 2 * i] = bflo(w1[i]); ov[8 + 2 * i + 1] = bfhi(w1[i]); }
        const float* g = p.out_g + 16 * lane; u32x4 o0, o1;
#pragma unroll
        for (int i = 0; i < 4; ++i) {
            const float a0 = hv[2 * i] * r * g[2 * i] / (1.0f + __expf(-ov[2 * i])), a1 = hv[2 * i + 1] * r * g[2 * i + 1] / (1.0f + __expf(-ov[2 * i + 1]));
            const float b0 = hv[8 + 2 * i] * r * g[8 + 2 * i] / (1.0f + __expf(-ov[8 + 2 * i])), b1 = hv[8 + 2 * i + 1] * r * g[8 + 2 * i + 1] / (1.0f + __expf(-ov[8 + 2 * i + 1]));
            o0[i] = pk2(a0, a1); o1[i] = pk2(b0, b1); }
        bf16_t* cr = CAT + (size_t)row * D + 16 * lane; *(u32x4*)cr = o0; *(u32x4*)(cr + 8) = o1;
    }
}

__device__ __forceinline__ unsigned order_key(float x) { const unsigned bts = __float_as_uint(x); return (bts & 0x80000000u) ? ~bts : (bts | 0x80000000u); }
template <int NREG> __device__ __forceinline__ void select_load(float (&raw)[NREG], const float* sc, int lane) {
#pragma unroll
    for (int i = 0; i < NREG; ++i) raw[i] = sc[64 * i + lane];
}
template <int NREG> __device__ __forceinline__ void select_compute(const float (&raw)[NREG], int nvalid, u64* mask, int lane) {
    unsigned u[NREG];
#pragma unroll
    for (int i = 0; i < NREG; ++i) { const int s = 64 * i + lane; u[i] = s < nvalid ? order_key(raw[i]) : 0u; }
    if (nvalid <= 256) {
#pragma unroll
        for (int i = 0; i < NREG; ++i) { const u64 mk = __ballot(64 * i + lane < nvalid); if (lane == 0) mask[i] = mk; }
        return;
    }
    unsigned T = 0u; bool exact = false;
    for (int bit = 31; bit >= 0; --bit) {
        const unsigned cand = T | (1u << bit);
        int cnt = 0;
#pragma unroll
        for (int i = 0; i + 3 < NREG; i += 4) if (64 * i < nvalid) { u64 m0, m1, m2, m3;
            asm volatile("v_cmp_ge_u32_e64 %0, %4, %8\n\tv_cmp_ge_u32_e64 %1, %5, %8\n\tv_cmp_ge_u32_e64 %2, %6, %8\n\tv_cmp_ge_u32_e64 %3, %7, %8\n\ts_nop 4"
                         : "=&s"(m0), "=&s"(m1), "=&s"(m2), "=&s"(m3) : "v"(u[i]), "v"(u[i + 1]), "v"(u[i + 2]), "v"(u[i + 3]), "s"(cand));
            cnt += (__popcll(m0) + __popcll(m1)) + (__popcll(m2) + __popcll(m3)); }
#pragma unroll
        for (int i = NREG & ~3; i < NREG; ++i) cnt += __popcll(__ballot(u[i] >= cand));
        if (cnt >= 256) T = cand;
        if (cnt == 256) { exact = true; break; }
    }
    if (exact) {
#pragma unroll
        for (int i = 0; i < NREG; ++i) { const u64 mk = __ballot(u[i] >= T); if (lane == 0) mask[i] = mk; }
        return;
    }
    int G = 0;
#pragma unroll
    for (int i = 0; i < NREG; ++i) G += __popcll(__ballot(u[i] > T));
    int need = 256 - G;
#pragma unroll
    for (int i = 0; i < NREG; ++i) {
        const u64 gt = __ballot(u[i] > T), eq = __ballot(u[i] == T); const int c = __popcll(eq); u64 take;
        if (c <= need) { take = eq; need -= c; }
        else { u64 mrem = eq; take = 0ull; for (int k = 0; k < need; ++k) { const u64 low = mrem & (~mrem + 1ull); take |= low; mrem ^= low; } need = 0; }
        if (lane == 0) mask[i] = gt | take;
    }
}

namespace pg8 {
#define PG8_LAS __attribute__((address_space(3)))
typedef unsigned short bf16_t;
typedef short bf16x8 __attribute__((ext_vector_type(8)));
typedef float f32x4 __attribute__((ext_vector_type(4)));
typedef unsigned u32x4 __attribute__((ext_vector_type(4)));
typedef int i32x4 __attribute__((ext_vector_type(4)));
constexpr int BM = 256, BK = 64, HALF = 128, HTB = HALF * BK * 2  , STAGE_BYTES = 8 * HTB, NXCD = 8, WGM = 8;

__host__ __device__ __forceinline__ int lds_byte(int r, int c) { const int st = (r >> 4) * 2 + (c >> 5), rr = r & 15, cc = c & 31, ob = rr * 64 + cc * 2; return st * 1024 + (ob ^ (((ob >> 9) & 1) << 5)); }
__host__ __device__ __forceinline__ void stage_rc(int b, int& R, int& C) { const int st = b / 1024, sb = b % 1024, swz = sb ^ (((sb >> 9) & 1) << 5); R = (st >> 1) * 16 + swz / 64; C = (st & 1) * 32 + (swz % 64) / 2; }
__host__ __device__ __forceinline__ int perm32(int rho) { const int n = rho >> 4, i = rho & 15; return 8 * (i >> 2) + 4 * n + (i & 3); }

struct Unit { int pm, pn, pk; };
struct Gemm { const bf16_t* A; const bf16_t* Bt; int M, N, K, KL; };

struct StaticOrder {
    int nM, nN, nwg, G, c, wgm;
    __host__ __device__ void init(int M, int N, int G_, int c_, int wgm_ = WGM) { nM = M / BM; nN = N / BM; nwg = nM * nN; G = G_; c = c_; wgm = wgm_; }
    __host__ __device__ bool next(int i, Unit& u) const {
        const long L = (long)i * G + c; if (L >= nwg) return false;
        int wgid = (int)L; { const int q = nwg / NXCD, r = nwg % NXCD, xcd = wgid % NXCD, off = wgid / NXCD; wgid = (xcd < r ? xcd * (q + 1) : r * (q + 1) + (xcd - r) * q) + off; }
        const int nig = wgm * nN, gid = wgid / nig, fm = gid * wgm, gsz = (nM - fm) < wgm ? (nM - fm) : wgm;
        u.pm = fm + ((wgid % nig) % gsz); u.pn = (wgid % nig) / gsz; u.pk = 0; return true;
    }
    __device__ __forceinline__ void a_ready(const Unit&) const {}
    __device__ __forceinline__ void done(const Unit&) const {}
};
struct SampleOrder {
    StaticOrder S;
    __host__ __device__ void init(int N, int G_, int c_) { S.init(MS, N, G_, c_); }
    __host__ __device__ bool next(int i, Unit& u) const { if (!S.next(i, u)) return false; u.pm += MP / BM; return true; }
    __device__ __forceinline__ void a_ready(const Unit&) const {}
    __device__ __forceinline__ void done(const Unit&) const {}
};


typedef float f32x2_t __attribute__((ext_vector_type(2)));
typedef __bf16 bf16x2_t __attribute__((ext_vector_type(2)));
__device__ __forceinline__ unsigned cvt_pk_bf16(float lo, float hi) { const f32x2_t v = {lo, hi}; const bf16x2_t b = __builtin_convertvector(v, bf16x2_t); return __builtin_bit_cast(unsigned, b); }
__device__ __forceinline__ float silu_fast(float x) { return x * __builtin_amdgcn_rcpf(1.0f + __expf(-x)); }

struct EpiSwiglu {
    typedef f32x4 AccT; static constexpr bool PERM = true, AFTER_DRAIN = false;
    bf16_t* O;
    __device__ __forceinline__ void operator()(const f32x4 (&acc)[2][2][4][2], const Unit& u, int wr, int wc, int fr, int fq) const {
        const int row0 = u.pm * BM + wr * 64 + fr, col0 = u.pn * HALF + wc * 32 + 8 * fq;
#pragma unroll
        for (int ai = 0; ai < 2; ++ai)
#pragma unroll
            for (int m = 0; m < 4; ++m) { bf16_t* rowp = O + (size_t)(row0 + ai * HALF + m * 16) * FF + col0;
                const f32x4 g0 = acc[ai][0][m][0], g1 = acc[ai][0][m][1], u0 = acc[ai][1][m][0], u1 = acc[ai][1][m][1];
                u32x4 w; w.x = cvt_pk_bf16(silu_fast(g0[0]) * u0[0], silu_fast(g0[1]) * u0[1]); w.y = cvt_pk_bf16(silu_fast(g0[2]) * u0[2], silu_fast(g0[3]) * u0[3]);
                w.z = cvt_pk_bf16(silu_fast(g1[0]) * u1[0], silu_fast(g1[1]) * u1[1]); w.w = cvt_pk_bf16(silu_fast(g1[2]) * u1[2], silu_fast(g1[3]) * u1[3]);
                *(u32x4*)rowp = w; }
    }
};
struct EpiSwigluI8 {
    typedef i32x4 AccT; static constexpr bool PERM = true, AFTER_DRAIN = false;
    bf16_t* O; const float* sa; const float* sb; float* rmaxp; unsigned char* O8;
    __device__ __forceinline__ void operator()(const i32x4 (&acc)[2][2][4][2], const Unit& u, int wr, int wc, int fr, int fq) const {
        const int row0 = u.pm * BM + wr * 64 + fr, col0 = u.pn * HALF + wc * 32 + 8 * fq, brow = u.pn * BM + wc * 32 + 8 * fq;
        const f32x4 sg0 = *(const f32x4*)(sb + brow), sg1 = *(const f32x4*)(sb + brow + 4), su0 = *(const f32x4*)(sb + brow + HALF), su1 = *(const f32x4*)(sb + brow + HALF + 4);
        float srv[2][4];
#pragma unroll
        for (int ai = 0; ai < 2; ++ai)
#pragma unroll
            for (int m = 0; m < 4; ++m) srv[ai][m] = sa[row0 + ai * HALF + m * 16];
#pragma unroll
        for (int ai = 0; ai < 2; ++ai)
#pragma unroll
            for (int m = 0; m < 4; ++m) { const int row = row0 + ai * HALF + m * 16; const float sr = srv[ai][m]; bf16_t* rowp = O + (size_t)row * FF + col0;
                const i32x4 g0 = acc[ai][0][m][0], g1 = acc[ai][0][m][1], u0 = acc[ai][1][m][0], u1 = acc[ai][1][m][1];
                float o[8];
#pragma unroll
                for (int e = 0; e < 4; ++e) { o[e] = silu_fast((float)g0[e] * (sr * sg0[e])) * ((float)u0[e] * (sr * su0[e])); o[4 + e] = silu_fast((float)g1[e] * (sr * sg1[e])) * ((float)u1[e] * (sr * su1[e])); }
                float mx = fmaxf(fmaxf(fmaxf(fabsf(o[0]), fabsf(o[1])), fmaxf(fabsf(o[2]), fabsf(o[3]))), fmaxf(fmaxf(fabsf(o[4]), fabsf(o[5])), fmaxf(fabsf(o[6]), fabsf(o[7]))));
                mx = x32_max(x16_max(mx));
                if (u.pm < MP / BM) {
                    const float inv = 127.0f / fmaxf(mx, 1e-30f); unsigned b[8];
#pragma unroll
                    for (int e = 0; e < 8; ++e) b[e] = __float_as_uint(__builtin_fmaf(o[e], inv, 12583040.0f));
                    u32x2 w8; w8.x = __builtin_amdgcn_perm(b[1], b[0], 0x0c0c0400u) | __builtin_amdgcn_perm(b[3], b[2], 0x04000c0cu); w8.y = __builtin_amdgcn_perm(b[5], b[4], 0x0c0c0400u) | __builtin_amdgcn_perm(b[7], b[6], 0x04000c0cu);
                    *(u32x2*)(O8 + (size_t)row * FF + col0) = w8;
                    if (fq == 0) rmaxp[(size_t)row * 176 + u.pn * 4 + wc] = mx;
                } else { u32x4 w; w.x = cvt_pk_bf16(o[0], o[1]); w.y = cvt_pk_bf16(o[2], o[3]); w.z = cvt_pk_bf16(o[4], o[5]); w.w = cvt_pk_bf16(o[6], o[7]); *(u32x4*)rowp = w; } }
    }
};
struct EpiResid {
    typedef f32x4 AccT; static constexpr bool PERM = false, AFTER_DRAIN = false;
    const float* base_p; const float* base_s; float* out; const float* gate; float scale;
    __device__ __forceinline__ void operator()(const f32x4 (&acc)[2][2][4][2], const Unit& u, int wr, int wc, int fr, int fq) const {
        const int col0 = u.pn * BM + wc * 32 + 4 * fq;
#pragma unroll
        for (int ai = 0; ai < 2; ++ai)
#pragma unroll
            for (int m = 0; m < 4; ++m) { const int row = u.pm * BM + ai * HALF + wr * 64 + m * 16 + fr;
                const float* bp = (row < MP ? base_p + (size_t)row * D : base_s + (size_t)(row - MP) * D) + col0;
                const float* gp = gate + (size_t)row_bm(row) * NMOD + col0; float* op = out + (size_t)row * D + col0;
#pragma unroll
                for (int bj = 0; bj < 2; ++bj)
#pragma unroll
                    for (int n = 0; n < 2; ++n) { const int o = bj * HALF + n * 16; const f32x4 bs = *(const f32x4*)(bp + o), g = *(const f32x4*)(gp + o);
                        *(f32x4*)(op + o) = bs + (g * scale) * acc[ai][bj][m][n]; } }
    }
};
template <bool BB, bool OB> struct EpiResidT {
    typedef f32x4 AccT; static constexpr bool PERM = false, AFTER_DRAIN = false;
    const void* base; void* out; const float* gate; float scale;
    __device__ __forceinline__ void operator()(const f32x4 (&acc)[2][2][4][2], const Unit& u, int wr, int wc, int fr, int fq) const {
        const int col0 = u.pn * BM + wc * 32 + 4 * fq, row0 = u.pm * BM + wr * 64 + fr;
        const float* gp = gate + (size_t)(u.pm >> 3) * NMOD + col0;
#pragma unroll
        for (int bj = 0; bj < 2; ++bj)
#pragma unroll
            for (int n = 0; n < 2; ++n) { const int o = bj * HALF + n * 16; const f32x4 gs = *(const f32x4*)(gp + o) * scale;
#pragma unroll
                for (int ai = 0; ai < 2; ++ai) { f32x4 bs[4];
#pragma unroll
                    for (int m = 0; m < 4; ++m) { const size_t off = (size_t)(row0 + ai * HALF + m * 16) * D + col0 + o;
                        if (BB) { const u32x2 w = *(const u32x2*)((const bf16_t*)base + off); bs[m][0] = bflo(w.x); bs[m][1] = bfhi(w.x); bs[m][2] = bflo(w.y); bs[m][3] = bfhi(w.y); }
                        else bs[m] = *(const f32x4*)((const float*)base + off); }
#pragma unroll
                    for (int m = 0; m < 4; ++m) { const size_t off = (size_t)(row0 + ai * HALF + m * 16) * D + col0 + o; const f32x4 v = bs[m] + gs * acc[ai][bj][m][n];
                        if (OB) { u32x2 w; w.x = cvt_pk_bf16(v[0], v[1]); w.y = cvt_pk_bf16(v[2], v[3]); *(u32x2*)((bf16_t*)out + off) = w; }
                        else *(f32x4*)((float*)out + off) = v; }
                    asm volatile("" ::: "memory"); } }
    }
};
template <bool BB, bool OB> struct EpiResidI8T {
    typedef i32x4 AccT; static constexpr bool PERM = false, AFTER_DRAIN = false;
    const void* base; void* out; const float* gate; float scale; const float* sa; const float* sb;
    __device__ __forceinline__ void operator()(const i32x4 (&acc)[2][2][4][2], const Unit& u, int wr, int wc, int fr, int fq) const {
        const int col0 = u.pn * BM + wc * 32 + 4 * fq, row0 = u.pm * BM + wr * 64 + fr;
        const float* gp = gate + (size_t)(u.pm >> 3) * NMOD + col0;
        float sr[2][4];
#pragma unroll
        for (int ai = 0; ai < 2; ++ai)
#pragma unroll
            for (int m = 0; m < 4; ++m) sr[ai][m] = sa[row0 + ai * HALF + m * 16] * scale;
#pragma unroll
        for (int bj = 0; bj < 2; ++bj)
#pragma unroll
            for (int n = 0; n < 2; ++n) { const int o = bj * HALF + n * 16; const f32x4 gs = *(const f32x4*)(sb + col0 + o) * *(const f32x4*)(gp + o);
#pragma unroll
                for (int ai = 0; ai < 2; ++ai) { f32x4 bs[4];
#pragma unroll
                    for (int m = 0; m < 4; ++m) { const size_t off = (size_t)(row0 + ai * HALF + m * 16) * D + col0 + o;
                        if (BB) { const u32x2 w = *(const u32x2*)((const bf16_t*)base + off); bs[m][0] = bflo(w.x); bs[m][1] = bfhi(w.x); bs[m][2] = bflo(w.y); bs[m][3] = bfhi(w.y); }
                        else bs[m] = *(const f32x4*)((const float*)base + off); }
#pragma unroll
                    for (int m = 0; m < 4; ++m) { const size_t off = (size_t)(row0 + ai * HALF + m * 16) * D + col0 + o; const i32x4 a = acc[ai][bj][m][n];
                        f32x4 v; v[0] = (float)a[0]; v[1] = (float)a[1]; v[2] = (float)a[2]; v[3] = (float)a[3];
                        v = bs[m] + (gs * sr[ai][m]) * v;
                        if (OB) { u32x2 w; w.x = cvt_pk_bf16(v[0], v[1]); w.y = cvt_pk_bf16(v[2], v[3]); *(u32x2*)((bf16_t*)out + off) = w; }
                        else *(f32x4*)((float*)out + off) = v; }
                    asm volatile("" ::: "memory"); } }
    }
};
struct SplitOrder {
    int NS, G, c;
    __device__ __forceinline__ bool next(int i, Unit& u) const { const int L = i * G + c; if (L >= 16 * NS) return false; const int tile = L / NS; u.pk = L - tile * NS; u.pm = 64 + (tile >> 3); u.pn = tile & 7; return true; }
    __device__ __forceinline__ void a_ready(const Unit&) const {}
    __device__ __forceinline__ void done(const Unit&) const {}
};
struct EpiSlab {
    typedef f32x4 AccT; static constexpr bool PERM = false, AFTER_DRAIN = false;
    float* slab;
    __device__ __forceinline__ void operator()(const f32x4 (&acc)[2][2][4][2], const Unit& u, int wr, int wc, int fr, int fq) const {
        const int col0 = u.pn * BM + wc * 32 + 4 * fq;
#pragma unroll
        for (int ai = 0; ai < 2; ++ai)
#pragma unroll
            for (int m = 0; m < 4; ++m) { const int row = (u.pm - 64) * BM + ai * HALF + wr * 64 + m * 16 + fr; float* op = slab + ((size_t)u.pk * MS + row) * D + col0;
#pragma unroll
                for (int bj = 0; bj < 2; ++bj)
#pragma unroll
                    for (int n = 0; n < 2; ++n) *(f32x4*)(op + bj * HALF + n * 16) = acc[ai][bj][m][n]; }
    }
};
struct EpiProj {
    typedef f32x4 AccT; static constexpr bool PERM = true, AFTER_DRAIN = false;
    bf16_t* PROJ; float* SMALL;
    __device__ __forceinline__ void operator()(const f32x4 (&acc)[2][2][4][2], const Unit& u, int wr, int wc, int fr, int fq) const {
        const int row0 = u.pm * BM + wr * 64 + fr;
        if (u.pn < 24) {
            const int col0 = u.pn * BM + wc * 32 + 8 * fq;
#pragma unroll
            for (int ai = 0; ai < 2; ++ai)
#pragma unroll
                for (int m = 0; m < 4; ++m) { bf16_t* rowp = PROJ + (size_t)(row0 + ai * HALF + m * 16) * PROJ_LD + col0;
#pragma unroll
                    for (int bj = 0; bj < 2; ++bj) { const f32x4 v0 = acc[ai][bj][m][0], v1 = acc[ai][bj][m][1];
                        u32x4 w; w.x = cvt_pk_bf16(v0[0], v0[1]); w.y = cvt_pk_bf16(v0[2], v0[3]); w.z = cvt_pk_bf16(v1[0], v1[1]); w.w = cvt_pk_bf16(v1[2], v1[3]);
                        *(u32x4*)(rowp + bj * HALF) = w; } }
        } else {
            const int col0 = wc * 32 + 8 * fq;
#pragma unroll
            for (int ai = 0; ai < 2; ++ai)
#pragma unroll
                for (int m = 0; m < 4; ++m) { float* rowp = SMALL + (size_t)(row0 + ai * HALF + m * 16) * SMALL_LD + col0;
                    *(f32x4*)rowp = acc[ai][0][m][0]; *(f32x4*)(rowp + 4) = acc[ai][0][m][1]; }
        }
    }
};

template <class T> struct Mma16;
template <> struct Mma16<f32x4> { static __device__ __forceinline__ f32x4 op(bf16x8 a, bf16x8 b, f32x4 c) { return __builtin_amdgcn_mfma_f32_16x16x32_bf16(a, b, c, 0, 0, 0); } };
template <> struct Mma16<i32x4> { static __device__ __forceinline__ i32x4 op(bf16x8 a, bf16x8 b, i32x4 c) { return __builtin_amdgcn_mfma_i32_16x16x64_i8(__builtin_bit_cast(i32x4, a), __builtin_bit_cast(i32x4, b), c, 0, 0, 0); } };
template <class Epi, class Sched, bool ALIGN_EPI = false, bool SP2 = false>
__device__ __forceinline__ void gemm_phase(PG8_LAS unsigned char* lds, const Gemm g, const Sched& S, const Epi& E) {
    int tid = threadIdx.x; asm volatile("" : "+v"(tid));
    const int wid = __builtin_amdgcn_readfirstlane(tid >> 6), lane = tid & 63, wr = wid >> 2, wc = wid & 3, fr = lane & 15, fq = lane >> 4;
    const int K = g.K, nt = g.KL / BK; const size_t kslice = (size_t)g.KL * 2;
    unsigned voffA[2], voffB[2];
#pragma unroll
    for (int i = 0; i < 2; ++i) { int R, C; stage_rc(tid * 16 + i * 8192, R, C); const int Rb = Epi::PERM ? ((R & ~31) + perm32(R & 31)) : R;
        voffA[i] = (unsigned)(R * K + C) * 2u; voffB[i] = (unsigned)(Rb * K + C) * 2u; }
    const size_t kstep = (size_t)(BK * 2);
    const size_t hstep = (size_t)HALF * K * 2;
    const size_t tstep = 2 * hstep;
    const unsigned ldsw = (unsigned)wid * 1024u;
    const int aoff = lds_byte(wr * 64 + fr, fq * 8), boff = lds_byte(wc * 32 + fr, fq * 8);
#define PG8_SA(b, h) (((b) * 2 + (h)) * HTB)
#define PG8_SB(b, h) ((4 + (b) * 2 + (h)) * HTB)
#define PG8_STAGE(bufoff, gbase, voff) do { _Pragma("unroll") for (int _i = 0; _i < 2; ++_i) \
        __builtin_amdgcn_global_load_lds((const unsigned*)((const char*)(gbase) + (voff)[_i]), (PG8_LAS unsigned*)(lds + (bufoff) + ldsw + _i * 8192), 16, 0, 0); } while (0)
#define PG8_LDA(dst, b, h) do { _Pragma("unroll") for (int m = 0; m < 4; ++m) _Pragma("unroll") for (int k = 0; k < 2; ++k) dst[m][k] = *(const PG8_LAS bf16x8*)(lds + PG8_SA(b, h) + aoff + m * 2048 + k * 1024); } while (0)
#define PG8_LDB(dst, b, h) do { _Pragma("unroll") for (int n = 0; n < 2; ++n) _Pragma("unroll") for (int k = 0; k < 2; ++k) dst[n][k] = *(const PG8_LAS bf16x8*)(lds + PG8_SB(b, h) + boff + n * 2048 + k * 1024); } while (0)
#define PG8_MMA(ai, bj, At, Bt) do { __builtin_amdgcn_s_setprio(1); _Pragma("unroll") for (int m = 0; m < 4; ++m) _Pragma("unroll") for (int n = 0; n < 2; ++n) _Pragma("unroll") for (int k = 0; k < 2; ++k) \
        acc[ai][bj][m][n] = Mma16<AccT>::op(Bt[n][k], At[m][k], acc[ai][bj][m][n]); __builtin_amdgcn_s_setprio(0); } while (0)
#define PG8_WAIT_V(n) asm volatile("s_waitcnt vmcnt(" #n ")" ::: "memory")
#define PG8_WAIT_L(n) asm volatile("s_waitcnt lgkmcnt(" #n ")" ::: "memory")
#define PG8_BAR __builtin_amdgcn_s_barrier()
#define PG8_SCHED __builtin_amdgcn_sched_barrier(0)
    Unit cur, nxt; int ui = 0;
    if (!S.next(0, cur)) return;
    typedef typename Epi::AccT AccT; AccT acc[2][2][4][2];
#pragma unroll
    for (int a = 0; a < 2; ++a)
#pragma unroll
        for (int b = 0; b < 2; ++b)
#pragma unroll
            for (int m = 0; m < 4; ++m)
#pragma unroll
                for (int n = 0; n < 2; ++n) acc[a][b][m][n] = AccT{};
    bf16x8 At[4][2], B0[2][2], B1[2][2];
    const char* cA = (const char*)g.A + (size_t)cur.pm * tstep + (size_t)cur.pk * kslice; const char* cB = (const char*)g.Bt + (size_t)cur.pn * tstep + (size_t)cur.pk * kslice;
    S.a_ready(cur);
    if constexpr (SP2) {
        PG8_STAGE(PG8_SB(0, 0), cB, voffB); PG8_STAGE(PG8_SB(0, 1), cB + hstep, voffB); PG8_STAGE(PG8_SA(0, 0), cA, voffA); PG8_STAGE(PG8_SA(0, 1), cA + hstep, voffA);
        if (wr == 1) PG8_BAR;
        PG8_WAIT_V(2); PG8_BAR;
        PG8_STAGE(PG8_SB(1, 0), cB + kstep, voffB); PG8_STAGE(PG8_SA(1, 0), cA + kstep, voffA); PG8_STAGE(PG8_SB(1, 1), cB + hstep + kstep, voffB);
        PG8_WAIT_V(6); PG8_BAR;
    } else {
        PG8_STAGE(PG8_SB(0, 0), cB, voffB); PG8_STAGE(PG8_SA(0, 0), cA, voffA); PG8_STAGE(PG8_SB(0, 1), cB + hstep, voffB); PG8_STAGE(PG8_SA(0, 1), cA + hstep, voffA);
        if (wr == 1) PG8_BAR;
        PG8_WAIT_V(4); PG8_BAR;
        PG8_STAGE(PG8_SB(1, 0), cB + kstep, voffB); PG8_STAGE(PG8_SA(1, 0), cA + kstep, voffA); PG8_STAGE(PG8_SB(1, 1), cB + hstep + kstep, voffB);
        PG8_WAIT_V(6); PG8_BAR;
    }
    for (;;) {
        const bool has_next = S.next(ui + 1, nxt);
        const char* nA = has_next ? (const char*)g.A + (size_t)nxt.pm * tstep + (size_t)nxt.pk * kslice : cA; const char* nB = has_next ? (const char*)g.Bt + (size_t)nxt.pn * tstep + (size_t)nxt.pk * kslice : cB;
        for (int t = 0; t < nt; t += 2) {
            const bool last = (t == nt - 2);
            const char* a1 = cA + (size_t)(t + 1) * kstep;
            const char* a2 = last ? nA : cA + (size_t)(t + 2) * kstep; const char* b2 = last ? nB : cB + (size_t)(t + 2) * kstep;
            const char* a3 = a2 + kstep; const char* b3 = b2 + kstep;
            if (last && has_next) S.a_ready(nxt);
            if constexpr (SP2) {
            PG8_LDB(B0, 0, 0); PG8_LDB(B1, 0, 1); PG8_SCHED; PG8_LDA(At, 0, 0); PG8_STAGE(PG8_SA(1, 1), a1 + hstep, voffA);
            PG8_WAIT_V(8); PG8_WAIT_L(0); PG8_BAR; PG8_MMA(0, 0, At, B0); PG8_MMA(0, 1, At, B1); PG8_BAR; PG8_SCHED;
            PG8_LDA(At, 0, 1); PG8_STAGE(PG8_SB(0, 0), b2, voffB); PG8_STAGE(PG8_SB(0, 1), b2 + hstep, voffB); PG8_STAGE(PG8_SA(0, 0), a2, voffA);
            PG8_WAIT_V(8); PG8_WAIT_L(0); PG8_BAR; PG8_MMA(1, 0, At, B0); PG8_MMA(1, 1, At, B1); PG8_BAR; PG8_SCHED;
            PG8_LDB(B0, 1, 0); PG8_LDB(B1, 1, 1); PG8_SCHED; PG8_LDA(At, 1, 0); PG8_STAGE(PG8_SA(0, 1), a2 + hstep, voffA);
            PG8_WAIT_V(8); PG8_WAIT_L(0); PG8_BAR; PG8_MMA(0, 0, At, B0); PG8_MMA(0, 1, At, B1); PG8_BAR; PG8_SCHED;
            PG8_LDA(At, 1, 1); PG8_STAGE(PG8_SB(1, 0), b3, voffB); PG8_STAGE(PG8_SB(1, 1), b3 + hstep, voffB); PG8_STAGE(PG8_SA(1, 0), a3, voffA);
            PG8_WAIT_V(8); PG8_WAIT_L(0); PG8_BAR; PG8_MMA(1, 0, At, B0); PG8_MMA(1, 1, At, B1); PG8_BAR; PG8_SCHED;
            } else {
            PG8_LDB(B0, 0, 0); PG8_SCHED; PG8_LDA(At, 0, 0); PG8_STAGE(PG8_SA(1, 1), a1 + hstep, voffA);
            PG8_WAIT_L(8); PG8_BAR; PG8_WAIT_L(0); PG8_MMA(0, 0, At, B0); PG8_BAR; PG8_SCHED;
            PG8_LDB(B1, 0, 1); PG8_STAGE(PG8_SB(0, 0), b2, voffB);
            PG8_BAR; PG8_WAIT_L(0); PG8_MMA(0, 1, At, B1); PG8_BAR;
            PG8_LDA(At, 0, 1); PG8_STAGE(PG8_SA(0, 0), a2, voffA);
            PG8_BAR; PG8_WAIT_L(0); PG8_MMA(1, 0, At, B0); PG8_BAR; PG8_SCHED;
            PG8_STAGE(PG8_SB(0, 1), b2 + hstep, voffB);
            PG8_WAIT_V(6); PG8_BAR; PG8_MMA(1, 1, At, B1); PG8_BAR;
            PG8_LDB(B0, 1, 0); PG8_SCHED; PG8_LDA(At, 1, 0); PG8_STAGE(PG8_SA(0, 1), a2 + hstep, voffA);
            PG8_WAIT_L(8); PG8_BAR; PG8_WAIT_L(0); PG8_MMA(0, 0, At, B0); PG8_BAR; PG8_SCHED;
            PG8_LDB(B1, 1, 1); PG8_STAGE(PG8_SB(1, 0), b3, voffB);
            PG8_BAR; PG8_WAIT_L(0); PG8_MMA(0, 1, At, B1); PG8_BAR;
            PG8_LDA(At, 1, 1); PG8_STAGE(PG8_SA(1, 0), a3, voffA);
            PG8_BAR; PG8_WAIT_L(0); PG8_MMA(1, 0, At, B0); PG8_BAR; PG8_SCHED;
            PG8_STAGE(PG8_SB(1, 1), b3 + hstep, voffB);
            PG8_WAIT_V(6); PG8_BAR; PG8_MMA(1, 1, At, B1); PG8_BAR;
            }
        }
        if constexpr (ALIGN_EPI) { if (wr == 0) PG8_BAR; }
        if constexpr (!Epi::AFTER_DRAIN) { E(acc, cur, wr, wc, fr, fq); S.done(cur); }
        if (!has_next) break;
#pragma unroll
        for (int a = 0; a < 2; ++a)
#pragma unroll
            for (int b = 0; b < 2; ++b)
#pragma unroll
                for (int m = 0; m < 4; ++m)
#pragma unroll
                    for (int n = 0; n < 2; ++n) acc[a][b][m][n] = AccT{};
        cur = nxt; cA = nA; cB = nB; ++ui;
        if constexpr (ALIGN_EPI) { if (wr == 1) PG8_BAR; }
    }
    PG8_WAIT_V(0);
    if constexpr (!ALIGN_EPI) { if (wr == 0) PG8_BAR; }
    PG8_BAR;
    if constexpr (Epi::AFTER_DRAIN) { E.fused(acc, cur, wr, wc, fr, fq, lds, wid, lane); S.done(cur); }
#undef PG8_SA
#undef PG8_SB
#undef PG8_STAGE
#undef PG8_LDA
#undef PG8_LDB
#undef PG8_MMA
#undef PG8_WAIT_V
#undef PG8_WAIT_L
#undef PG8_BAR
#undef PG8_SCHED
}
}

#define PG8_SP2 true
#define PG8_ALIGN true

#define XB_TMO      128
#define XB_XCNT(j)  (256  + 64 * (j))
#define XB_XSUB(j)  (1280 + 64 * (j))
#define XB_XGEN(j)  (2304 + 64 * (j))
#define XB_TOP      3328
#define XB_TOPGEN   3392
#define XCD_BAR_WORDS 3456
#define XB_SPIN_CAP (1u << 18)
#define LAS __attribute__((address_space(3)))

__device__ __forceinline__ unsigned xb_ld(unsigned* p)              { return __hip_atomic_load(p, __ATOMIC_RELAXED, __HIP_MEMORY_SCOPE_AGENT); }
__device__ __forceinline__ unsigned xb_add(unsigned* p, unsigned v) { return __hip_atomic_fetch_add(p, v, __ATOMIC_RELAXED, __HIP_MEMORY_SCOPE_AGENT); }
__device__ __forceinline__ unsigned xb_xcc_id() { return (unsigned)__builtin_amdgcn_s_getreg((3 << 11) | 20) & 0xFu; }
#define XB_SPIN(cond, bar) do { unsigned _sp = 0; while (cond) { __builtin_amdgcn_s_sleep(1); \
    if ((++_sp & 255u) == 0u) { if (xb_ld(&(bar)[XB_TMO])) break; if (_sp > XB_SPIN_CAP) { atomicAdd(&(bar)[XB_TMO], 1u); break; } } } } while (0)

struct XcdBarrier {
    unsigned* bar; unsigned x;
    volatile LAS unsigned* st;
};

__device__ __forceinline__ XcdBarrier xcd_barrier_post(unsigned* bar, volatile LAS unsigned* st) {
    XcdBarrier b; b.bar = bar; b.x = xb_xcc_id(); b.st = st;
    if (threadIdx.x == 0) (void)xb_add(&bar[XB_XCNT(b.x)], 1u);
    return b;
}
__device__ __forceinline__ void xcd_barrier_complete(unsigned* bar, unsigned x, unsigned& nloc, unsigned& nx) {
    const unsigned G = gridDim.x * gridDim.y * gridDim.z;
    unsigned sum, cnt, mine, sp = 0u;
    for (;;) {
        sum = 0u; cnt = 0u; mine = 0u;
#pragma unroll
        for (unsigned j = 0; j < 16; ++j) { const unsigned c = xb_ld(&bar[XB_XCNT(j)]); sum += c; cnt += (c > 0u) ? 1u : 0u; mine = (j == x) ? c : mine; }
        if (sum == G) break;
        __builtin_amdgcn_s_sleep(1);
        if ((++sp & 255u) == 0u) { if (xb_ld(&bar[XB_TMO])) break; if (sp > XB_SPIN_CAP) { atomicAdd(&bar[XB_TMO], 1u); break; } }
    }
    nloc = mine > 0u ? mine : 1u; nx = cnt > 0u ? cnt : 1u;
}

__device__ __forceinline__ void xcd_barrier(const XcdBarrier& b) {
    asm volatile("s_waitcnt vmcnt(0)" ::: "memory");
    __syncthreads();
    if (threadIdx.x == 0) {
        unsigned* bar = b.bar;
        __builtin_amdgcn_s_waitcnt(0);
        unsigned nloc = b.st[0], nx = b.st[1];
        if (nloc == 0u) { xcd_barrier_complete(bar, b.x, nloc, nx); b.st[0] = nloc; b.st[1] = nx; }
        const unsigned old = xb_add(&bar[XB_XSUB(b.x)], 1u);
        const unsigned gen = old / nloc;
        if (old + 1u == (gen + 1u) * nloc) {
            __builtin_amdgcn_fence(__ATOMIC_RELEASE, "agent");
            asm volatile("s_waitcnt vmcnt(0)" ::: "memory");
            const unsigned og = xb_add(&bar[XB_TOP], 1u);
            const unsigned tg = og / nx;
            if (og + 1u == (tg + 1u) * nx) xb_add(&bar[XB_TOPGEN], 1u);
            else XB_SPIN(xb_ld(&bar[XB_TOPGEN]) == tg, bar);
            __builtin_amdgcn_fence(__ATOMIC_ACQUIRE, "agent");
            xb_add(&bar[XB_XGEN(b.x)], 1u);
            asm volatile("s_waitcnt vmcnt(0)" ::: "memory");
        } else {
            XB_SPIN(xb_ld(&bar[XB_XGEN(b.x)]) == gen, bar);
            __builtin_amdgcn_fence(__ATOMIC_ACQUIRE, "agent");
            asm volatile("s_waitcnt vmcnt(0)" ::: "memory");
        }
    }
    __syncthreads();
}


constexpr int RING_OFF = 0, RING_BYTES = 131072, LDSCTL_OFF = 146432, MISC_OFF = LDSCTL_OFF + 320, LDS_BYTES = 147456;
constexpr int CW_BAR = 4096;
constexpr size_t CTL_CMAX = 65536;
constexpr size_t CTL_ZERO_BYTES = 1u << 20;
#define LDS_WAIT() asm volatile("s_waitcnt lgkmcnt(0)" ::: "memory")
typedef short bf16x8_t __attribute__((ext_vector_type(8)));
using pg8::cvt_pk_bf16;

__device__ __forceinline__ void tr_item(const float* colp, int ld, bf16_t* WT, int K, int k0, int n0, LAS float* scr, int lane, unsigned* cmaxp = nullptr) {
    float tv[32];
#pragma unroll
    for (int i = 0; i < 32; ++i) { const int kk = 2 * i + (lane >> 5); tv[i] = colp ? colp[(size_t)(k0 + kk) * ld] : 0.f; }
    if (cmaxp) { float mx = 0.f;
#pragma unroll
        for (int i = 0; i < 32; ++i) mx = fmaxf(mx, fabsf(tv[i]));
        mx = fmaxf(mx, __shfl_xor(mx, 32));
        if (lane < 32) atomicMax(cmaxp + n0 + lane, __float_as_uint(mx)); }
#pragma unroll
    for (int i = 0; i < 32; ++i) { const int kk = 2 * i + (lane >> 5); scr[kk * 33 + (lane & 31)] = tv[i]; }
    LDS_WAIT(); asm volatile("" ::: "memory");
    const int c = lane & 7;
#pragma unroll
    for (int j = 0; j < 4; ++j) { const int n = (lane >> 3) + 8 * j; const LAS float* s = scr + (8 * c) * 33 + n;
        u32x4 o; o.x = pk2(s[0 * 33], s[1 * 33]); o.y = pk2(s[2 * 33], s[3 * 33]); o.z = pk2(s[4 * 33], s[5 * 33]); o.w = pk2(s[6 * 33], s[7 * 33]);
        *(u32x4*)(WT + (size_t)(n0 + n) * K + k0 + 8 * c) = o; }
    LDS_WAIT(); asm volatile("" ::: "memory");
}
constexpr int IT_GU = 32 * 352, IT_D = 88 * 64, IT_IN = 32 * 200, IT_OUT = 32 * 64, IT_ALL = 2 * IT_GU + 2 * IT_D + IT_IN + IT_OUT;
__device__ __forceinline__ void convert_item(const Ptrs& p, int it, LAS float* scr, int lane) {
    int r = it; const int ln = lane & 31;
#pragma unroll
    for (int which = 0; which < 2; ++which) {
        if (r < IT_GU) { const int kb = r / 352, q32 = r % 352, n = 32 * q32 + ln, pn = n >> 8, rr = n & 255;
            const float* src = rr < 128 ? (which ? p.f2_wg : p.f1_wg) : (which ? p.f2_wu : p.f1_wu);
            tr_item(src + 128 * pn + (rr & 127), FF, (bf16_t*)(p.WS() + (which ? WS_W2GU : WS_W1GU)), D, 64 * kb, 32 * q32, scr, lane, (unsigned*)(p.WS() + WS_CTL + CTL_CMAX) + which * 2 * FF); return; }
        r -= IT_GU;
        if (r < IT_D) { const int kb = r / 64, q32 = r % 64;
            tr_item((which ? p.f2_wd : p.f1_wd) + 32 * q32 + ln, D, (bf16_t*)(p.WS() + (which ? WS_W2D : WS_W1D)), FF, 64 * kb, 32 * q32, scr, lane, (unsigned*)(p.WS() + WS_CTL + CTL_CMAX) + 4 * FF + which * D); return; }
        r -= IT_D;
    }
    if (r < IT_IN) { const int kb = r / 200, q32 = r % 200, n = 32 * q32 + ln; int col;
        if (n < 4096) col = n; else if (n < 6144) col = n + 8; else { const int j = n - 6144; col = j < 64 ? 6152 + j : j < 72 ? 4096 + (j - 64) : j < 80 ? 6216 + (j - 72) : -1; }
        tr_item(col >= 0 ? p.w_in + col : nullptr, PW, (bf16_t*)(p.WS() + WS_WIN), D, 64 * kb, 32 * q32, scr, lane); return; }
    r -= IT_IN;
    { const int kb = r / 64, q32 = r % 64; tr_item(p.w_out + 32 * q32 + ln, D, (bf16_t*)(p.WS() + WS_WOUT), D, 64 * kb, 32 * q32, scr, lane); }
}
constexpr int MW_PITCH = 528;
template <int MT0, int NMT> __device__ __forceinline__ void mods_wg_body(const Ptrs& p, LAS unsigned char* lds, const int slab, const int tid) {
    const int lane = tid & 63, r = lane & 15, q = lane >> 4, n0 = 32 * slab;
    f32x4 acc[NMT][2];
#pragma unroll
    for (int mt = 0; mt < NMT; ++mt) { acc[mt][0] = (f32x4){0.f, 0.f, 0.f, 0.f}; acc[mt][1] = (f32x4){0.f, 0.f, 0.f, 0.f}; }
    const float* wp = p.w_ada + n0 + r + (size_t)(8 * q) * NMOD;
    float ring[4][2][8];
#define MW_LOADW(slot_, g_) do { _Pragma("unroll") for (int nt = 0; nt < 2; ++nt) _Pragma("unroll") for (int j = 0; j < 8; ++j) ring[slot_][nt][j] = wp[(size_t)(32 * (g_) + j) * NMOD + 16 * nt]; } while (0)
    MW_LOADW(0, 0); MW_LOADW(1, 1); MW_LOADW(2, 2); MW_LOADW(3, 3);
    for (int c = 0; c < 8; ++c) {
        f32x4 cv[17];
#pragma unroll
        for (int i = 0; i < 17; ++i) { const int e = tid + 512 * i, row = e >> 6, c4 = e & 63;
            cv[i] = *(const f32x4*)((row < BP ? p.c_p + (size_t)row * D : p.c_s + (size_t)(row - BP) * D) + 256 * c + 4 * c4); }
        __syncthreads();
#pragma unroll
        for (int i = 0; i < 17; ++i) { const int e = tid + 512 * i, row = e >> 6, c4 = e & 63; u32x2 w; w.x = cvt_pk_bf16(cv[i][0], cv[i][1]); w.y = cvt_pk_bf16(cv[i][2], cv[i][3]);
            *(LAS u32x2*)(lds + row * MW_PITCH + c4 * 8) = w; }
        if (tid < 8 * 64) { const int row = 136 + (tid >> 6), c4 = tid & 63; u32x2 z; z.x = 0u; z.y = 0u; *(LAS u32x2*)(lds + row * MW_PITCH + c4 * 8) = z; }
        __syncthreads();
#pragma unroll
        for (int s = 0; s < 8; ++s) {
            bf16x8_t bfr[2];
#pragma unroll
            for (int nt = 0; nt < 2; ++nt) { const float* v = ring[s & 3][nt]; u32x4 w; w.x = cvt_pk_bf16(v[0], v[1]); w.y = cvt_pk_bf16(v[2], v[3]); w.z = cvt_pk_bf16(v[4], v[5]); w.w = cvt_pk_bf16(v[6], v[7]); bfr[nt] = __builtin_bit_cast(bf16x8_t, w); }
            if (8 * c + s + 4 < 64) MW_LOADW(s & 3, 8 * c + s + 4);
            bf16x8_t afr[NMT];
#pragma unroll
            for (int mt = 0; mt < NMT; ++mt) afr[mt] = *(LAS const bf16x8_t*)(lds + (16 * (MT0 + mt) + r) * MW_PITCH + (32 * s + 8 * q) * 2);
            LDS_WAIT();
#pragma unroll
            for (int mt = 0; mt < NMT; ++mt) { acc[mt][0] = __builtin_amdgcn_mfma_f32_16x16x32_bf16(afr[mt], bfr[0], acc[mt][0], 0, 0, 0); acc[mt][1] = __builtin_amdgcn_mfma_f32_16x16x32_bf16(afr[mt], bfr[1], acc[mt][1], 0, 0, 0); }
        }
    }
#undef MW_LOADW
    float* MODS = (float*)(p.WS() + WS_MODS);
#pragma unroll
    for (int nt = 0; nt < 2; ++nt) { const int n = n0 + 16 * nt + r; const float bb = p.b_ada[n];
#pragma unroll
        for (int mt = 0; mt < NMT; ++mt)
#pragma unroll
            for (int i = 0; i < 4; ++i) { const int row = 16 * (MT0 + mt) + 4 * q + i; if (row < NB) MODS[(size_t)row * NMOD + n] = acc[mt][nt][i] + bb; } }
    __syncthreads();
}
template <int MT0, int NMT> __device__ __forceinline__ void mods_item_t(const Ptrs& p, const int slab, const int lane) {
    const int r = lane & 15, q = lane >> 4, n0 = 32 * slab;
    f32x4 acc[NMT][2];
#pragma unroll
    for (int mt = 0; mt < NMT; ++mt) { acc[mt][0] = (f32x4){0.f, 0.f, 0.f, 0.f}; acc[mt][1] = (f32x4){0.f, 0.f, 0.f, 0.f}; }
    const float* wp = p.w_ada + n0 + r + (size_t)(8 * q) * NMOD;
    const float* cp[NMT];
#pragma unroll
    for (int mt = 0; mt < NMT; ++mt) { int row = 16 * (MT0 + mt) + r; if (row > NB - 1) row = NB - 1; cp[mt] = (row < BP ? p.c_p + (size_t)row * D : p.c_s + (size_t)(row - BP) * D) + 8 * q; }
    const bool vlast = (16 * (MT0 + NMT - 1) + r) < NB;
    float bv[2][8]; f32x4 av[NMT][2];
#define MODS_LOAD(k0_) do { _Pragma("unroll") for (int nt = 0; nt < 2; ++nt) _Pragma("unroll") for (int j = 0; j < 8; ++j) bv[nt][j] = wp[(size_t)((k0_) + j) * NMOD + 16 * nt]; \
        _Pragma("unroll") for (int mt = 0; mt < NMT; ++mt) { av[mt][0] = *(const f32x4*)(cp[mt] + (k0_)); av[mt][1] = *(const f32x4*)(cp[mt] + (k0_) + 4); } } while (0)
    MODS_LOAD(0);
    for (int k0 = 0; k0 < D; k0 += 32) {
        bf16x8_t bfr[2], afr[NMT];
#pragma unroll
        for (int nt = 0; nt < 2; ++nt) { u32x4 w; w.x = cvt_pk_bf16(bv[nt][0], bv[nt][1]); w.y = cvt_pk_bf16(bv[nt][2], bv[nt][3]); w.z = cvt_pk_bf16(bv[nt][4], bv[nt][5]); w.w = cvt_pk_bf16(bv[nt][6], bv[nt][7]); bfr[nt] = __builtin_bit_cast(bf16x8_t, w); }
#pragma unroll
        for (int mt = 0; mt < NMT; ++mt) { f32x4 a0 = av[mt][0], a1 = av[mt][1]; if (mt == NMT - 1 && !vlast) { a0 = (f32x4){0.f, 0.f, 0.f, 0.f}; a1 = a0; }
            u32x4 w; w.x = cvt_pk_bf16(a0[0], a0[1]); w.y = cvt_pk_bf16(a0[2], a0[3]); w.z = cvt_pk_bf16(a1[0], a1[1]); w.w = cvt_pk_bf16(a1[2], a1[3]); afr[mt] = __builtin_bit_cast(bf16x8_t, w); }
        if (k0 + 32 < D) MODS_LOAD(k0 + 32);
#pragma unroll
        for (int mt = 0; mt < NMT; ++mt) { acc[mt][0] = __builtin_amdgcn_mfma_f32_16x16x32_bf16(afr[mt], bfr[0], acc[mt][0], 0, 0, 0); acc[mt][1] = __builtin_amdgcn_mfma_f32_16x16x32_bf16(afr[mt], bfr[1], acc[mt][1], 0, 0, 0); }
    }
#undef MODS_LOAD
    float* MODS = (float*)(p.WS() + WS_MODS);
#pragma unroll
    for (int nt = 0; nt < 2; ++nt) { const int n = n0 + 16 * nt + r; const float bb = p.b_ada[n];
#pragma unroll
        for (int mt = 0; mt < NMT; ++mt)
#pragma unroll
            for (int i = 0; i < 4; ++i) { const int row = 16 * (MT0 + mt) + 4 * q + i; if (row < NB) MODS[(size_t)row * NMOD + n] = acc[mt][nt][i] + bb; } }
}

template <int O0, int O1, int O2, int O3, int O4, int O5, int O6, int O7> __device__ __forceinline__ void tr_read8(u32x2 (&o)[8], const unsigned addr) {
    asm volatile("ds_read_b64_tr_b16 %0, %8 offset:%9\n\tds_read_b64_tr_b16 %1, %8 offset:%10\n\tds_read_b64_tr_b16 %2, %8 offset:%11\n\tds_read_b64_tr_b16 %3, %8 offset:%12\n\t"
                 "ds_read_b64_tr_b16 %4, %8 offset:%13\n\tds_read_b64_tr_b16 %5, %8 offset:%14\n\tds_read_b64_tr_b16 %6, %8 offset:%15\n\tds_read_b64_tr_b16 %7, %8 offset:%16\n\ts_waitcnt lgkmcnt(0)"
                 : "=&v"(o[0]), "=&v"(o[1]), "=&v"(o[2]), "=&v"(o[3]), "=&v"(o[4]), "=&v"(o[5]), "=&v"(o[6]), "=&v"(o[7])
                 : "v"(addr), "n"(O0), "n"(O1), "n"(O2), "n"(O3), "n"(O4), "n"(O5), "n"(O6), "n"(O7) : "memory");
}
__device__ __forceinline__ bf16x8_t frag2(const u32x2 a, const u32x2 b) { u32x4 v; v.x = a.x; v.y = a.y; v.z = b.x; v.w = b.y; return __builtin_bit_cast(bf16x8_t, v); }
constexpr int ML_QC = 0, ML_KC = 33792, ML_KW = 67584, ML_VR = 101376, ML_CB = 109056, ML_N = 142848, ML_SC = 144896, ML_END = 145920; __device__ __forceinline__ void mlstm_mfma_unit(const Ptrs& p, LAS unsigned char* lds, const int unit, const int tid) {
    const int lane = tid & 63, wv = __builtin_amdgcn_readfirstlane(tid >> 6), r = lane & 15, q = lane >> 4;
    const int bh = unit >> 3, sl = unit & 7, b = bh >> 2, h = bh & 3, e0 = 32 * sl;
    const bf16_t* QM = (const bf16_t*)(p.WS() + WS_QM); const bf16_t* KM = (const bf16_t*)(p.WS() + WS_KM); const bf16_t* PROJ = (const bf16_t*)(p.WS() + WS_PROJ);
    const float* BC = (const float*)(p.WS() + WS_BC) + (size_t)bh * 2048; const float* IG = (const float*)(p.WS() + WS_IG) + (size_t)bh * 2048; const float* MMa = (const float*)(p.WS() + WS_MM) + (size_t)bh * 2048;
    float* HM = (float*)(p.WS() + WS_HM);
    const int srow = tid >> 3, sd = (tid & 7) * 32, se = (tid & 7) * 4;
    LAS float* su = (LAS float*)(lds + ML_SC); LAS float* sv = su + 64; LAS float* ssw = su + 128; LAS float* smm = su + 192;
    for (int i = tid; i < 16896 / 4; i += 512) ((LAS unsigned*)(lds + ML_CB))[i] = 0u;
    if (tid < 256) ((LAS float*)(lds + ML_N))[tid] = 0.f;
    f32x4 accC[4][2];
#pragma unroll
    for (int k = 0; k < 4; ++k) { accC[k][0] = (f32x4){0.f, 0.f, 0.f, 0.f}; accC[k][1] = (f32x4){0.f, 0.f, 0.f, 0.f}; }
    u32x4 pq[4], pk[4]; u32x2 pv; float pbc, pig, pmm, pbL, pmL, pm0;
#define ML_PREFETCH(cc) do { const size_t rr_ = (size_t)b * 2048 + 64 * (cc) + srow; const bf16_t* qp_ = QM + rr_ * 1024 + h * 256 + sd; const bf16_t* kp_ = KM + rr_ * 1024 + h * 256 + sd; \
        _Pragma("unroll") for (int j_ = 0; j_ < 4; ++j_) { pq[j_] = *(const u32x4*)(qp_ + 8 * j_); pk[j_] = *(const u32x4*)(kp_ + 8 * j_); } \
        pv = *(const u32x2*)(PROJ + rr_ * PROJ_LD + PC_VM + h * 256 + e0 + se); pbc = BC[64 * (cc) + srow]; pig = IG[64 * (cc) + srow]; pmm = MMa[64 * (cc) + srow]; \
        pbL = BC[64 * (cc) + 63]; pmL = MMa[64 * (cc) + 63]; pm0 = (cc) ? MMa[64 * (cc) - 1] : 0.f; } while (0)
    ML_PREFETCH(0);
    for (int c = 0; c < 32; ++c) {
        const int cur = c & 1, nxt = cur ^ 1;
        const float bL = pbL, mL = pmL, m0 = pm0;
        {
            const float wl = __expf(bL - pbc + pig - mL);
#pragma unroll
            for (int j = 0; j < 4; ++j) { *(LAS u32x4*)(lds + ML_QC + srow * 528 + (sd + 8 * j) * 2) = pq[j]; *(LAS u32x4*)(lds + ML_KC + srow * 528 + (sd + 8 * j) * 2) = pk[j]; }
#pragma unroll
            for (int j = 0; j < 4; ++j) { u32x4 ws_;
#pragma unroll
                for (int e2 = 0; e2 < 4; ++e2) { const unsigned w = pk[j][e2]; ws_[e2] = cvt_pk_bf16(bflo(w) * wl, bfhi(w) * wl); }
                *(LAS u32x4*)(lds + ML_KW + srow * 528 + (sd + 8 * j) * 2) = ws_; }
            *(LAS u32x2*)(lds + ML_VR + srow * 96 + se * 2) = pv;
            if ((tid & 7) == 0) { su[srow] = pbc - pmm; sv[srow] = pig - pbc; ssw[srow] = __expf(pbc + m0 - pmm); smm[srow] = pmm; }
        }
        __syncthreads();
        if (c < 31) ML_PREFETCH(c + 1);
        if (wv < 4) {
            const int tt = wv; const size_t r0 = (size_t)b * 2048 + 64 * c;
            bf16x8_t qf[8];
            { LAS const unsigned char* qrow = lds + ML_QC + (16 * tt + r) * 528 + q * 16;
#pragma unroll
              for (int kk = 0; kk < 8; ++kk) qf[kk] = *(LAS const bf16x8_t*)(qrow + kk * 64); }
            const float ut = su[16 * tt + r]; float rs = 0.f; unsigned pw[4][2];
#pragma unroll
            for (int a = 0; a < 4; ++a) {
                if (a <= tt) {
                    LAS const unsigned char* krow = lds + ML_KC + (16 * a + r) * 528 + q * 16;
                    const f32x4 vs4 = *(LAS const f32x4*)(sv + 16 * a + 4 * q);
                    f32x4 S0 = (f32x4){0.f, 0.f, 0.f, 0.f}, S1 = S0;
#pragma unroll
                    for (int hf = 0; hf < 2; ++hf) { bf16x8_t kf[4];
#pragma unroll
                        for (int k4 = 0; k4 < 4; ++k4) kf[k4] = *(LAS const bf16x8_t*)(krow + (4 * hf + k4) * 64);
                        LDS_WAIT();
#pragma unroll
                        for (int k4 = 0; k4 < 4; k4 += 2) { S0 = __builtin_amdgcn_mfma_f32_16x16x32_bf16(kf[k4], qf[4 * hf + k4], S0, 0, 0, 0); S1 = __builtin_amdgcn_mfma_f32_16x16x32_bf16(kf[k4 + 1], qf[4 * hf + k4 + 1], S1, 0, 0, 0); } }
                    const f32x4 S = S0 + S1; float pe[4];
#pragma unroll
                    for (int i = 0; i < 4; ++i) { float x = S[i] * __expf(ut + vs4[i]); if (a == tt && (4 * q + i) > r) x = 0.f; pe[i] = x; rs += x; }
                    pw[a][0] = cvt_pk_bf16(pe[0], pe[1]); pw[a][1] = cvt_pk_bf16(pe[2], pe[3]);
                } else { pw[a][0] = 0u; pw[a][1] = 0u; }
            }
            rs = x32_sum(x16_sum(rs));
            u32x4 pf0, pf1; pf0.x = pw[0][0]; pf0.y = pw[0][1]; pf0.z = pw[1][0]; pf0.w = pw[1][1]; pf1.x = pw[2][0]; pf1.y = pw[2][1]; pf1.z = pw[3][0]; pf1.w = pw[3][1];
            f32x4 accn[2], accq[2];
            u32x2 vtr[8];
            tr_read8<0, 16 * 96, 32 * 96, 48 * 96, 32, 32 + 16 * 96, 32 + 32 * 96, 32 + 48 * 96>(vtr, (unsigned)(size_t)(lds + ML_VR) + (unsigned)((4 * q + (r >> 2)) * 96 + 8 * (r & 3)));
#pragma unroll
            for (int et = 0; et < 2; ++et) {
                LAS const unsigned char* crow = lds + ML_CB + cur * 16896 + (16 * et + r) * 528 + q * 16;
                bf16x8_t cf[4];
#pragma unroll
                for (int kk = 0; kk < 4; ++kk) cf[kk] = *(LAS const bf16x8_t*)(crow + kk * 64);
                LDS_WAIT();
                accn[et] = __builtin_amdgcn_mfma_f32_16x16x32_bf16(__builtin_bit_cast(bf16x8_t, pf0), frag2(vtr[4 * et + 0], vtr[4 * et + 1]), (f32x4){0.f, 0.f, 0.f, 0.f}, 0, 0, 0);
                if (tt >= 2) accn[et] = __builtin_amdgcn_mfma_f32_16x16x32_bf16(__builtin_bit_cast(bf16x8_t, pf1), frag2(vtr[4 * et + 2], vtr[4 * et + 3]), accn[et], 0, 0, 0);
                f32x4 q0 = (f32x4){0.f, 0.f, 0.f, 0.f}, q1 = q0;
#pragma unroll
                for (int kk = 0; kk < 4; kk += 2) { q0 = __builtin_amdgcn_mfma_f32_16x16x32_bf16(qf[kk], cf[kk], q0, 0, 0, 0); q1 = __builtin_amdgcn_mfma_f32_16x16x32_bf16(qf[kk + 1], cf[kk + 1], q1, 0, 0, 0); }
#pragma unroll
                for (int kk = 0; kk < 4; ++kk) cf[kk] = *(LAS const bf16x8_t*)(crow + (4 + kk) * 64);
                LDS_WAIT();
#pragma unroll
                for (int kk = 0; kk < 4; kk += 2) { q0 = __builtin_amdgcn_mfma_f32_16x16x32_bf16(qf[4 + kk], cf[kk], q0, 0, 0, 0); q1 = __builtin_amdgcn_mfma_f32_16x16x32_bf16(qf[4 + kk + 1], cf[kk + 1], q1, 0, 0, 0); }
                accq[et] = q0 + q1;
            }
            float qn = 0.f;
            { LAS const float* nrow = (LAS const float*)(lds + ML_N + cur * 1024) + 64 * q; LAS const unsigned char* qrow2 = lds + ML_QC + (16 * tt + r) * 528 + 128 * q;
#pragma unroll
              for (int hf = 0; hf < 2; ++hf) { u32x4 wq[4]; f32x4 n0[4], n1[4];
#pragma unroll
                  for (int c4 = 0; c4 < 4; ++c4) { const int c8 = 4 * hf + c4; wq[c4] = *(LAS const u32x4*)(qrow2 + c8 * 16); n0[c4] = *(LAS const f32x4*)(nrow + 8 * c8); n1[c4] = *(LAS const f32x4*)(nrow + 8 * c8 + 4); }
                  LDS_WAIT();
#pragma unroll
                  for (int c4 = 0; c4 < 4; ++c4) { const u32x4 w = wq[c4];
                      qn += (bflo(w.x) * n0[c4][0] + bfhi(w.x) * n0[c4][1]) + (bflo(w.y) * n0[c4][2] + bfhi(w.y) * n0[c4][3]) + (bflo(w.z) * n1[c4][0] + bfhi(w.z) * n1[c4][1]) + (bflo(w.w) * n1[c4][2] + bfhi(w.w) * n1[c4][3]); } } }
            qn = x32_sum(x16_sum(qn));
            const float swt = ssw[16 * tt + r], mmt = smm[16 * tt + r];
            const float inv = 1.0f / fmaxf(fabsf(rs + swt * qn), __expf(-mmt));
#pragma unroll
            for (int i = 0; i < 4; ++i) { const float invv = __shfl(inv, 4 * q + i), swv = __shfl(swt, 4 * q + i);
                float* hp = HM + (r0 + 16 * tt + 4 * q + i) * 1024 + h * 256 + e0 + r;
                hp[0] = (accn[0][i] + swv * accq[0][i]) * invv; hp[16] = (accn[1][i] + swv * accq[1][i]) * invv; }
        } else {
            const int sw4 = wv - 4; const float decay = __expf(bL + m0 - mL);
#pragma unroll
            for (int k = 0; k < 4; ++k) { accC[k][0] = accC[k][0] * decay; accC[k][1] = accC[k][1] * decay; }
            u32x2 vt2[8], ka[8], kb[8];
            tr_read8<0, 4 * 96, 32 * 96, 36 * 96, 32, 32 + 4 * 96, 32 + 32 * 96, 32 + 36 * 96>(vt2, (unsigned)(size_t)(lds + ML_VR) + (unsigned)((8 * q + (r >> 2)) * 96 + 8 * (r & 3)));
            const unsigned kaddr = (unsigned)(size_t)(lds + ML_KW) + (unsigned)((8 * q + (r >> 2)) * 528 + 8 * (r & 3) + sw4 * 128);
            tr_read8<0, 4 * 528, 32 * 528, 36 * 528, 32, 32 + 4 * 528, 32 + 32 * 528, 32 + 36 * 528>(ka, kaddr);
            tr_read8<64, 64 + 4 * 528, 64 + 32 * 528, 64 + 36 * 528, 96, 96 + 4 * 528, 96 + 32 * 528, 96 + 36 * 528>(kb, kaddr);
            float nsum[4];
#pragma unroll
            for (int k = 0; k < 4; ++k) { const int dt = 4 * sw4 + k; float ns_ = 0.f;
#pragma unroll
                for (int kk2 = 0; kk2 < 2; ++kk2) { const u32x2 a0 = (k < 2 ? ka : kb)[4 * (k & 1) + 2 * kk2], a1 = (k < 2 ? ka : kb)[4 * (k & 1) + 2 * kk2 + 1]; const bf16x8_t af = frag2(a0, a1);
                    ns_ += (bflo(a0.x) + bfhi(a0.x)) + (bflo(a0.y) + bfhi(a0.y)) + (bflo(a1.x) + bfhi(a1.x)) + (bflo(a1.y) + bfhi(a1.y));
#pragma unroll
                    for (int et = 0; et < 2; ++et) accC[k][et] = __builtin_amdgcn_mfma_f32_16x16x32_bf16(af, frag2(vt2[4 * et + 2 * kk2], vt2[4 * et + 2 * kk2 + 1]), accC[k][et], 0, 0, 0); }
                nsum[k] = x32_sum(x16_sum(ns_));
#pragma unroll
                for (int et = 0; et < 2; ++et) { u32x2 o; o.x = cvt_pk_bf16(accC[k][et][0], accC[k][et][1]); o.y = cvt_pk_bf16(accC[k][et][2], accC[k][et][3]);
                    *(LAS u32x2*)(lds + ML_CB + nxt * 16896 + (16 * et + r) * 528 + (16 * dt + 4 * q) * 2) = o; } }
            if (q == 0) { LAS float* nb = (LAS float*)(lds + ML_N);
#pragma unroll
                for (int k = 0; k < 4; ++k) { const int d = 16 * (4 * sw4 + k) + r; nb[nxt * 256 + d] = decay * nb[cur * 256 + d] + nsum[k]; } }
        }
        __syncthreads();
    }
#undef ML_PREFETCH
    if (wv >= 4) { const int sw4 = wv - 4;
#pragma unroll
        for (int k = 0; k < 4; ++k)
#pragma unroll
            for (int et = 0; et < 2; ++et)
#pragma unroll
                for (int i = 0; i < 4; ++i) p.out[O_CP + ((size_t)bh * 256 + 16 * (4 * sw4 + k) + 4 * q + i) * 256 + e0 + 16 * et + r] = accC[k][et][i]; }
    if (sl == 0 && tid < 256) { p.out[O_NP + (size_t)bh * 256 + tid] = ((LAS const float*)(lds + ML_N))[tid]; if (tid == 0) p.out[O_MP + bh] = MMa[2047]; }
    __syncthreads();
}

__device__ __forceinline__ void scores_seg(const Ptrs& p, const int b, const int qt, const int klo, const int khi, const int lane) {
    const int r = lane & 15, q = lane >> 4;
    const bf16_t* PROJ = (const bf16_t*)(p.WS() + WS_PROJ); const float* SMALL = (const float*)(p.WS() + WS_SMALL); const bf16_t* KI = (const bf16_t*)(p.WS() + WS_KI) + (size_t)b * 2048 * 64; float* SC = (float*)(p.WS() + WS_SC);
    const size_t row = (size_t)b * 2048 + 16 * qt + r;
    bf16x8_t qa[8][2]; float w8[8];
#pragma unroll
    for (int j = 0; j < 8; ++j) { qa[j][0] = *(const bf16x8_t*)(PROJ + row * PROJ_LD + PC_QI + 64 * j + 8 * q); qa[j][1] = *(const bf16x8_t*)(PROJ + row * PROJ_LD + PC_QI + 64 * j + 32 + 8 * q); w8[j] = SMALL[row * SMALL_LD + 72 + j] * (0.35355339059327373f * 0.125f); }
    float* scrow = SC + row * 2048 + 4 * q;
#pragma unroll 2
    for (int kt = klo; kt < khi; ++kt) {
        const bf16_t* kp = KI + (size_t)(16 * kt + r) * 64 + 8 * q;
        const bf16x8_t k0 = *(const bf16x8_t*)kp, k1 = *(const bf16x8_t*)(kp + 32);
        f32x4 sc = (f32x4){0.f, 0.f, 0.f, 0.f};
#pragma unroll
        for (int j = 0; j < 8; ++j) { f32x4 S = __builtin_amdgcn_mfma_f32_16x16x32_bf16(k0, qa[j][0], (f32x4){0.f, 0.f, 0.f, 0.f}, 0, 0, 0); S = __builtin_amdgcn_mfma_f32_16x16x32_bf16(k1, qa[j][1], S, 0, 0, 0);
#pragma unroll
            for (int i = 0; i < 4; ++i) sc[i] += w8[j] * fmaxf(S[i], 0.f); }
        *(f32x4*)(scrow + 16 * kt) = sc;
    }
}
__device__ __forceinline__ void scores_mfma_prompt(const Ptrs& p, const int u, const int lane) {
    const int b = u >> 8, rem = u & 255, pair = rem >> 2, part = rem & 3;
    const int qtA = pair, qtB = 127 - pair, nA = qtA + 1, ntot = 129;
    const int j0 = part * 33, j1 = (j0 + 33 < ntot) ? j0 + 33 : ntot;
    if (j0 < nA) scores_seg(p, b, qtA, j0, j1 < nA ? j1 : nA, lane);
    if (j1 > nA) scores_seg(p, b, qtB, (j0 > nA ? j0 : nA) - nA, j1 - nA, lane);
}

constexpr int SS_PITCH = 8208;
__device__ __forceinline__ void scores_select_unit(const Ptrs& p, LAS unsigned char* lds, const int b, const int qt, const int tid) {
    const int lane = tid & 63, wv = __builtin_amdgcn_readfirstlane(tid >> 6), r = lane & 15, q = lane >> 4;
    const bf16_t* PROJ = (const bf16_t*)(p.WS() + WS_PROJ); const float* SMALL = (const float*)(p.WS() + WS_SMALL); const bf16_t* KI = (const bf16_t*)(p.WS() + WS_KI) + (size_t)b * 2048 * 64;
    const size_t row = (size_t)b * 2048 + 16 * qt + r;
    bf16x8_t qa[8][2]; float w8[8];
#pragma unroll
    for (int j = 0; j < 8; ++j) { qa[j][0] = *(const bf16x8_t*)(PROJ + row * PROJ_LD + PC_QI + 64 * j + 8 * q); qa[j][1] = *(const bf16x8_t*)(PROJ + row * PROJ_LD + PC_QI + 64 * j + 32 + 8 * q); w8[j] = SMALL[row * SMALL_LD + 72 + j] * (0.35355339059327373f * 0.125f); }
    __syncthreads();
#pragma unroll 2
    for (int kt = wv; kt <= qt; kt += 8) {
        const bf16_t* kp = KI + (size_t)(16 * kt + r) * 64 + 8 * q;
        const bf16x8_t k0 = *(const bf16x8_t*)kp, k1 = *(const bf16x8_t*)(kp + 32);
        f32x4 sc = (f32x4){0.f, 0.f, 0.f, 0.f};
#pragma unroll
        for (int j = 0; j < 8; ++j) { f32x4 S = __builtin_amdgcn_mfma_f32_16x16x32_bf16(k0, qa[j][0], (f32x4){0.f, 0.f, 0.f, 0.f}, 0, 0, 0); S = __builtin_amdgcn_mfma_f32_16x16x32_bf16(k1, qa[j][1], S, 0, 0, 0);
#pragma unroll
            for (int i = 0; i < 4; ++i) sc[i] += w8[j] * fmaxf(S[i], 0.f); }
        *(LAS f32x4*)(lds + r * SS_PITCH + (16 * kt + 4 * q) * 4) = sc;
    }
    __syncthreads();
#pragma unroll
    for (int rr = 0; rr < 2; ++rr) { const int tl = 2 * wv + rr, nvalid = 16 * qt + tl + 1; float raw[32];
#pragma unroll
        for (int i = 0; i < 32; ++i) raw[i] = *(LAS const float*)(lds + tl * SS_PITCH + (64 * i + lane) * 4);
        select_compute<32>(raw, nvalid, (u64*)(p.WS() + WS_MASK) + ((size_t)b * 2048 + 16 * qt + tl) * 32, lane); }
}

template <int DT0> __device__ __forceinline__ void v_tr_read8(u32x2 (&o)[2][2][2]  , const unsigned addr) {
    asm volatile("ds_read_b64_tr_b16 %0, %8 offset:%9\n\tds_read_b64_tr_b16 %1, %8 offset:%10\n\tds_read_b64_tr_b16 %2, %8 offset:%11\n\tds_read_b64_tr_b16 %3, %8 offset:%12\n\t"
                 "ds_read_b64_tr_b16 %4, %8 offset:%13\n\tds_read_b64_tr_b16 %5, %8 offset:%14\n\tds_read_b64_tr_b16 %6, %8 offset:%15\n\tds_read_b64_tr_b16 %7, %8 offset:%16\n\ts_waitcnt lgkmcnt(0)"
                 : "=&v"(o[0][0][0]), "=&v"(o[0][0][1]), "=&v"(o[0][1][0]), "=&v"(o[0][1][1]), "=&v"(o[1][0][0]), "=&v"(o[1][0][1]), "=&v"(o[1][1][0]), "=&v"(o[1][1][1])
                 : "v"(addr), "n"(DT0 * 32), "n"(DT0 * 32 + 16 * 288), "n"(DT0 * 32 + 32 * 288), "n"(DT0 * 32 + 48 * 288),
                   "n"(DT0 * 32 + 32), "n"(DT0 * 32 + 32 + 16 * 288), "n"(DT0 * 32 + 32 + 32 * 288), "n"(DT0 * 32 + 32 + 48 * 288) : "memory");
}
constexpr int AT_BUF = 35840, AT_KC = 0, AT_VT = 17408, AT_MASK = 71680, AT_BIAS = 88064, AT_END = 96256;
__device__ __forceinline__ void attn_mfma_block(const Ptrs& p, LAS unsigned char* lds, const int b, const int qb, const int g, const int tid) {
    const int lane = tid & 63, wv = __builtin_amdgcn_readfirstlane(tid >> 6), r = lane & 15, q = lane >> 4, hh = 4 * g + (wv & 3), mh = wv >> 2;
    const int t0 = 64 * qb, ntile = qb + 1; const size_t row0 = (size_t)b * 2048 + t0;
    const bf16_t* QA = (const bf16_t*)(p.WS() + WS_QA); const bf16_t* KA = (const bf16_t*)(p.WS() + WS_KA); const bf16_t* PROJ = (const bf16_t*)(p.WS() + WS_PROJ); const u64* MASK = (const u64*)(p.WS() + WS_MASK);
    LAS u64* maskL = (LAS u64*)(lds + AT_MASK); LAS const float* biasn = (LAS const float*)(lds + AT_BIAS);
    __syncthreads();
    for (int i = tid; i < 2048; i += 512) maskL[i] = MASK[(row0 + (i >> 5)) * 32 + (i & 31)];
    bf16x8_t qf[2][4];
#pragma unroll
    for (int m2 = 0; m2 < 2; ++m2)
#pragma unroll
        for (int kk = 0; kk < 4; ++kk) qf[m2][kk] = *(const bf16x8_t*)(QA + (row0 + 16 * (2 * mh + m2) + r) * 1024 + hh * 128 + 32 * kk + 8 * q);
    f32x4 O[2][8]; float mrun[2], lrun[2];
#pragma unroll
    for (int m2 = 0; m2 < 2; ++m2) { mrun[m2] = -INFINITY; lrun[m2] = 0.f;
#pragma unroll
        for (int dt = 0; dt < 8; ++dt) O[m2][dt] = (f32x4){0.f, 0.f, 0.f, 0.f}; }
    const float bfar = p.t5[31 * 8 + hh];
    const int srow = tid >> 3, sp = tid & 7;
    u32x4 pk[2], pv[2];
#define AT_PREFETCH(kt_) do { const size_t kr_ = (size_t)b * 2048 + 64 * (kt_) + srow; const bf16_t* kp_ = KA + kr_ * 256 + g * 128 + sp * 16; const bf16_t* vp_ = PROJ + kr_ * PROJ_LD + PC_VA + g * 128 + sp * 16; \
        pk[0] = *(const u32x4*)kp_; pk[1] = *(const u32x4*)(kp_ + 8); pv[0] = *(const u32x4*)vp_; pv[1] = *(const u32x4*)(vp_ + 8); } while (0)
#define AT_STAGE(buf_) do { LAS unsigned char* bb_ = lds + (buf_) * AT_BUF; \
        *(LAS u32x4*)(bb_ + AT_KC + srow * 272 + sp * 32) = pk[0]; *(LAS u32x4*)(bb_ + AT_KC + srow * 272 + sp * 32 + 16) = pk[1]; \
        *(LAS u32x4*)(bb_ + AT_VT + srow * 288 + sp * 32) = pv[0]; *(LAS u32x4*)(bb_ + AT_VT + srow * 288 + sp * 32 + 16) = pv[1]; } while (0)
    AT_PREFETCH(0); AT_STAGE(0); if (ntile > 1) AT_PREFETCH(1);
    __syncthreads();
    for (int kt = 0; kt < ntile; ++kt) {
        const int buf = kt & 1; LAS const unsigned char* bb = lds + buf * AT_BUF;
        f32x4 S[2][4];
#pragma unroll
        for (int a = 0; a < 4; ++a) { bf16x8_t kf[4];
#pragma unroll
            for (int kk = 0; kk < 4; ++kk) kf[kk] = *(LAS const bf16x8_t*)(bb + AT_KC + (16 * a + r) * 272 + kk * 64 + q * 16);
            LDS_WAIT();
            S[0][a] = (f32x4){0.f, 0.f, 0.f, 0.f}; S[1][a] = (f32x4){0.f, 0.f, 0.f, 0.f};
#pragma unroll
            for (int kk = 0; kk < 4; ++kk) { S[0][a] = __builtin_amdgcn_mfma_f32_16x16x32_bf16(kf[kk], qf[0][kk], S[0][a], 0, 0, 0); S[1][a] = __builtin_amdgcn_mfma_f32_16x16x32_bf16(kf[kk], qf[1][kk], S[1][a], 0, 0, 0); } }
        u32x4 pf[2][2];
#pragma unroll
        for (int m2 = 0; m2 < 2; ++m2) {
            const int mt = 2 * mh + m2, t = t0 + 16 * mt + r; const u64 mwq = maskL[(16 * mt + r) * 32 + kt] >> (4 * q);
            const unsigned mlo = (unsigned)mwq, mhi = (unsigned)(mwq >> 32);
            const bool far = (t0 + 16 * mt - 64 * kt - 63) >= 128;
            float bia[4][4];
            if (far) {
#pragma unroll
                for (int a = 0; a < 4; ++a)
#pragma unroll
                    for (int i = 0; i < 4; ++i) bia[a][i] = bfar;
            } else {
                const int dbase = t - 64 * kt - 4 * q;
#pragma unroll
                for (int a = 0; a < 4; ++a)
#pragma unroll
                    for (int i = 0; i < 4; ++i) { int dist = dbase - (16 * a + i); dist = dist < 0 ? 0 : (dist > 255 ? 255 : dist); bia[a][i] = biasn[dist * 8 + hh]; }
                LDS_WAIT();
            }
            float mx = -INFINITY;
#pragma unroll
            for (int a = 0; a < 4; ++a)
#pragma unroll
                for (int i = 0; i < 4; ++i) { const bool on = (((a < 2) ? mlo : mhi) >> (16 * (a & 1) + i)) & 1u; const float lg = on ? S[m2][a][i] + bia[a][i] : -INFINITY; S[m2][a][i] = lg; mx = fmaxf(mx, lg); }
            mx = x32_max(x16_max(mx));
            const float mnew = fmaxf(mrun[m2], mx), muse = (mnew == -INFINITY) ? 0.f : mnew; const float alpha = __expf(mrun[m2] - muse); mrun[m2] = mnew;
            float psum = 0.f; unsigned pw[4][2];
#pragma unroll
            for (int a = 0; a < 4; ++a) { float pe[4];
#pragma unroll
                for (int i = 0; i < 4; ++i) { pe[i] = __expf(S[m2][a][i] - muse); psum += pe[i]; }
                pw[a][0] = cvt_pk_bf16(pe[0], pe[1]); pw[a][1] = cvt_pk_bf16(pe[2], pe[3]); }
            psum = x32_sum(x16_sum(psum));
            lrun[m2] = lrun[m2] * alpha + psum;
            pf[m2][0].x = pw[0][0]; pf[m2][0].y = pw[0][1]; pf[m2][0].z = pw[1][0]; pf[m2][0].w = pw[1][1]; pf[m2][1].x = pw[2][0]; pf[m2][1].y = pw[2][1]; pf[m2][1].z = pw[3][0]; pf[m2][1].w = pw[3][1];
#pragma unroll
            for (int i = 0; i < 4; ++i) { const float al = __shfl(alpha, 4 * q + i);
#pragma unroll
                for (int dt = 0; dt < 8; ++dt) O[m2][dt][i] *= al; }
        }
        {
            const unsigned vaddr = (unsigned)(size_t)(bb + AT_VT) + (unsigned)((4 * q + (r >> 2)) * 288 + 8 * (r & 3));
#define AT_PV2(DT0_) do { u32x2 vt_[2][2][2]; v_tr_read8<DT0_>(vt_, vaddr); \
            _Pragma("unroll") for (int a2 = 0; a2 < 2; ++a2) _Pragma("unroll") for (int d2 = 0; d2 < 2; ++d2) { u32x4 vf; vf.x = vt_[d2][a2][0].x; vf.y = vt_[d2][a2][0].y; vf.z = vt_[d2][a2][1].x; vf.w = vt_[d2][a2][1].y; \
                O[0][(DT0_) + d2] = __builtin_amdgcn_mfma_f32_16x16x32_bf16(__builtin_bit_cast(bf16x8_t, pf[0][a2]), __builtin_bit_cast(bf16x8_t, vf), O[0][(DT0_) + d2], 0, 0, 0); \
                O[1][(DT0_) + d2] = __builtin_amdgcn_mfma_f32_16x16x32_bf16(__builtin_bit_cast(bf16x8_t, pf[1][a2]), __builtin_bit_cast(bf16x8_t, vf), O[1][(DT0_) + d2], 0, 0, 0); } } while (0)
            AT_PV2(0); AT_PV2(2); AT_PV2(4); AT_PV2(6);
#undef AT_PV2
        }
        if (kt + 1 < ntile) { AT_STAGE(buf ^ 1); if (kt + 2 < ntile) AT_PREFETCH(kt + 2); }
        __syncthreads();
    }
#undef AT_PREFETCH
#undef AT_STAGE
    bf16_t* CAT = (bf16_t*)(p.WS() + WS_CAT);
#pragma unroll
    for (int m2 = 0; m2 < 2; ++m2) { const float invl = 1.0f / lrun[m2];
#pragma unroll
        for (int i = 0; i < 4; ++i) { const float iv = __shfl(invl, 4 * q + i); bf16_t* cp = CAT + (row0 + 16 * (2 * mh + m2) + 4 * q + i) * D + 1024 + hh * 128 + r;
#pragma unroll
            for (int dt = 0; dt < 8; ++dt) cp[16 * dt] = f2bf(O[m2][dt][i] * iv); } }
}

__device__ __forceinline__ void scores_mfma_sample(const Ptrs& p, const int u, const int lane) {
    const int r = lane & 15, q = lane >> 4, b = u >> 4, part = u & 15;
    const bf16_t* PROJ = (const bf16_t*)(p.WS() + WS_PROJ); const float* SMALL = (const float*)(p.WS() + WS_SMALL); float* SCS = (float*)(p.WS() + WS_SCS);
    bf16x8_t qa[2][2]; float w4[2][4];
#pragma unroll
    for (int mtl = 0; mtl < 2; ++mtl) { const size_t row = (size_t)MP + 4 * b + 2 * mtl + (r >> 3);
        qa[mtl][0] = *(const bf16x8_t*)(PROJ + row * PROJ_LD + PC_QI + 64 * (r & 7) + 8 * q); qa[mtl][1] = *(const bf16x8_t*)(PROJ + row * PROJ_LD + PC_QI + 64 * (r & 7) + 32 + 8 * q);
        const size_t wrow = (size_t)MP + 4 * b + 2 * mtl + (q >> 1);
#pragma unroll
        for (int i = 0; i < 4; ++i) w4[mtl][i] = SMALL[wrow * SMALL_LD + 72 + 4 * (q & 1) + i] * (0.35355339059327373f * 0.125f); }
    const int tlo = 8 * part, thi = (part == 15) ? 129 : 8 * part + 8;
    for (int kt = tlo; kt < thi; ++kt) {
        const int s = 16 * kt + r; f32x4 k0a, k0b, k1a, k1b;
        if (s < 2052) { const float* kr = s < 2048 ? p.cache_ik + ((size_t)p.page_table[b * 16 + (s >> 7)] * 128 + (s & 127)) * 64 : SMALL + (size_t)(MP + 4 * b + (s - 2048)) * SMALL_LD;
            k0a = *(const f32x4*)(kr + 8 * q); k0b = *(const f32x4*)(kr + 8 * q + 4); k1a = *(const f32x4*)(kr + 32 + 8 * q); k1b = *(const f32x4*)(kr + 32 + 8 * q + 4); }
        else { k0a = (f32x4){0.f, 0.f, 0.f, 0.f}; k0b = k0a; k1a = k0a; k1b = k0a; }
        u32x4 w0, w1; w0.x = cvt_pk_bf16(k0a[0], k0a[1]); w0.y = cvt_pk_bf16(k0a[2], k0a[3]); w0.z = cvt_pk_bf16(k0b[0], k0b[1]); w0.w = cvt_pk_bf16(k0b[2], k0b[3]);
        w1.x = cvt_pk_bf16(k1a[0], k1a[1]); w1.y = cvt_pk_bf16(k1a[2], k1a[3]); w1.z = cvt_pk_bf16(k1b[0], k1b[1]); w1.w = cvt_pk_bf16(k1b[2], k1b[3]);
        const bf16x8_t kb0 = __builtin_bit_cast(bf16x8_t, w0), kb1 = __builtin_bit_cast(bf16x8_t, w1);
#pragma unroll
        for (int mtl = 0; mtl < 2; ++mtl) {
            f32x4 S = __builtin_amdgcn_mfma_f32_16x16x32_bf16(qa[mtl][0], kb0, (f32x4){0.f, 0.f, 0.f, 0.f}, 0, 0, 0); S = __builtin_amdgcn_mfma_f32_16x16x32_bf16(qa[mtl][1], kb1, S, 0, 0, 0);
            float sc = (w4[mtl][0] * fmaxf(S[0], 0.f) + w4[mtl][1] * fmaxf(S[1], 0.f)) + (w4[mtl][2] * fmaxf(S[2], 0.f) + w4[mtl][3] * fmaxf(S[3], 0.f));
            sc = x16_sum(sc);
            if ((q & 1) == 0) SCS[(size_t)(4 * b + 2 * mtl + (q >> 1)) * SCS_LD + s] = sc;
        }
    }
}

constexpr int SA_LS = 96256, SA_LP = 104960, SA_SEL = 113664, SA_N = 115840;
__device__ __forceinline__ void attn_mfma_sample(const Ptrs& p, LAS unsigned char* lds, const int b, const int g, const int tid) {
    const int lane = tid & 63, wv = __builtin_amdgcn_readfirstlane(tid >> 6), r = lane & 15, q = lane >> 4;
    const bf16_t* QA = (const bf16_t*)(p.WS() + WS_QA); const bf16_t* KA = (const bf16_t*)(p.WS() + WS_KA); const bf16_t* PROJ = (const bf16_t*)(p.WS() + WS_PROJ); const u64* MASKS = (const u64*)(p.WS() + WS_MASKS);
    LAS int* listS = (LAS int*)(lds + SA_LS); LAS int* listP = (LAS int*)(lds + SA_LP); LAS unsigned char* sel = lds + SA_SEL; LAS int* nk = (LAS int*)(lds + SA_N); LAS const float* biasn = (LAS const float*)(lds + AT_BIAS);
    __syncthreads();
    LAS u64* mk4 = (LAS u64*)(lds + SA_N + 64);
    if (wv < 4) {
        float raw[33]; select_load<33>(raw, (const float*)(p.WS() + WS_SCS) + (size_t)(4 * b + wv) * SCS_LD, lane);
        select_compute<33>(raw, 2049 + wv, (u64*)(mk4 + wv * 33), lane);
    }
    __syncthreads();
    if (wv == 0) {
        int base = 0;
        for (int w = 0; w < 33; ++w) {
            const u64 m0 = mk4[w], m1 = mk4[33 + w], m2 = mk4[66 + w], m3 = mk4[99 + w];
            const unsigned s4 = (unsigned)((m0 >> lane) & 1ull) | ((unsigned)((m1 >> lane) & 1ull) << 1) | ((unsigned)((m2 >> lane) & 1ull) << 2) | ((unsigned)((m3 >> lane) & 1ull) << 3);
            const bool on = s4 != 0u; const u64 bal = __ballot(on);
            if (on) { const int pos = base + __popcll(bal & ((1ull << lane) - 1ull)); listS[pos] = 64 * w + lane; sel[pos] = (unsigned char)s4; }
            base += __popcll(bal);
        }
        const int npad = (base + 63) & ~63;
        for (int i = base + lane; i < npad; i += 64) { listS[i] = 0; sel[i] = 0; }
        if (lane == 0) { nk[0] = base; nk[1] = npad; }
    }
    __syncthreads();
    const int npad = nk[1], ntile = npad >> 6;
    for (int i = tid; i < npad; i += 512) { const int s = listS[i]; listP[i] = s < 2048 ? p.page_table[b * 16 + (s >> 7)] * 128 + (s & 127) : -(1 + (s - 2048)); }
    bf16x8_t qf[4];
    { const size_t qrow = (size_t)MP + 4 * b + (r >> 2); const int hh = 4 * g + (r & 3);
#pragma unroll
      for (int kk = 0; kk < 4; ++kk) qf[kk] = *(const bf16x8_t*)(QA + qrow * 1024 + hh * 128 + 32 * kk + 8 * q); }
    const int trow = r >> 2, hrow = 4 * g + (r & 3), qpos = 2048 + trow;
    f32x4 O = (f32x4){0.f, 0.f, 0.f, 0.f}; float mrun = -INFINITY, lrun = 0.f;
    const int srow = tid >> 3, sp = tid & 7;
    f32x4 pkf[4], pvf[4];
    __syncthreads();
#define SA_PREFETCH(kt_) do { const int e_ = listP[64 * (kt_) + srow]; \
        const size_t ro_ = e_ >= 0 ? (size_t)e_ : (size_t)(4 * b + (-e_ - 1)); \
        const float* kp_ = (e_ >= 0 ? p.cache_k : (const float*)(p.out + O_KS)) + (ro_ * 2 + g) * 128 + sp * 16; const float* vp_ = (e_ >= 0 ? p.cache_v : (const float*)(p.out + O_VS)) + (ro_ * 2 + g) * 128 + sp * 16; \
        _Pragma("unroll") for (int j_ = 0; j_ < 4; ++j_) { pkf[j_] = *(const f32x4*)(kp_ + 4 * j_); pvf[j_] = *(const f32x4*)(vp_ + 4 * j_); } } while (0)
#define SA_STAGE(buf_) do { LAS unsigned char* bb_ = lds + (buf_) * AT_BUF; u32x4 w0_, w1_; \
        w0_.x = cvt_pk_bf16(pkf[0][0], pkf[0][1]); w0_.y = cvt_pk_bf16(pkf[0][2], pkf[0][3]); w0_.z = cvt_pk_bf16(pkf[1][0], pkf[1][1]); w0_.w = cvt_pk_bf16(pkf[1][2], pkf[1][3]); \
        w1_.x = cvt_pk_bf16(pkf[2][0], pkf[2][1]); w1_.y = cvt_pk_bf16(pkf[2][2], pkf[2][3]); w1_.z = cvt_pk_bf16(pkf[3][0], pkf[3][1]); w1_.w = cvt_pk_bf16(pkf[3][2], pkf[3][3]); \
        *(LAS u32x4*)(bb_ + AT_KC + srow * 272 + sp * 32) = w0_; *(LAS u32x4*)(bb_ + AT_KC + srow * 272 + sp * 32 + 16) = w1_; \
        _Pragma("unroll") for (int j_ = 0; j_ < 4; ++j_) _Pragma("unroll") for (int e_ = 0; e_ < 4; e_ += 2) { const unsigned w_ = cvt_pk_bf16(pvf[j_][e_], pvf[j_][e_ + 1]); const int d_ = sp * 16 + 4 * j_ + e_; \
            *(LAS bf16_t*)(bb_ + AT_VT + d_ * 144 + srow * 2) = (bf16_t)(w_ & 0xffffu); *(LAS bf16_t*)(bb_ + AT_VT + (d_ + 1) * 144 + srow * 2) = (bf16_t)(w_ >> 16); } } while (0)
    SA_PREFETCH(0); SA_STAGE(0); if (ntile > 1) SA_PREFETCH(1);
    __syncthreads();
    for (int kt = 0; kt < ntile; ++kt) {
        const int buf = kt & 1; LAS const unsigned char* bb = lds + buf * AT_BUF;
        if (kt + 1 < ntile) { SA_STAGE(buf ^ 1); if (kt + 2 < ntile) SA_PREFETCH(kt + 2); }
        f32x4 S[4];
#pragma unroll
        for (int a = 0; a < 4; ++a) { S[a] = (f32x4){0.f, 0.f, 0.f, 0.f};
#pragma unroll
            for (int kk = 0; kk < 4; ++kk) S[a] = __builtin_amdgcn_mfma_f32_16x16x32_bf16(*(LAS const bf16x8_t*)(bb + AT_KC + (16 * a + r) * 272 + kk * 64 + q * 16), qf[kk], S[a], 0, 0, 0); }
        float mx = -INFINITY;
#pragma unroll
        for (int a = 0; a < 4; ++a) { const int i0 = 64 * kt + 16 * a + 4 * q; const unsigned s4w = *(LAS const unsigned*)(sel + i0);
            const int ks0 = listS[i0], ks1 = listS[i0 + 1], ks2 = listS[i0 + 2], ks3 = listS[i0 + 3]; const int ksv[4] = {ks0, ks1, ks2, ks3};
#pragma unroll
            for (int i = 0; i < 4; ++i) { const bool on = (s4w >> (8 * i + trow)) & 1u; int dist = qpos - ksv[i]; dist = dist < 0 ? 0 : (dist > 255 ? 255 : dist);
                const float lg = on ? S[a][i] + biasn[dist * 8 + hrow] : -INFINITY; S[a][i] = lg; mx = fmaxf(mx, lg); } }
        mx = x32_max(x16_max(mx));
        const float mnew = fmaxf(mrun, mx), muse = (mnew == -INFINITY) ? 0.f : mnew; const float alpha = __expf(mrun - muse); mrun = mnew;
        float psum = 0.f; unsigned pw[4][2];
#pragma unroll
        for (int a = 0; a < 4; ++a) { float pe[4];
#pragma unroll
            for (int i = 0; i < 4; ++i) { pe[i] = __expf(S[a][i] - muse); psum += pe[i]; }
            pw[a][0] = cvt_pk_bf16(pe[0], pe[1]); pw[a][1] = cvt_pk_bf16(pe[2], pe[3]); }
        psum = x32_sum(x16_sum(psum));
        lrun = lrun * alpha + psum;
        u32x4 pf[2]; pf[0].x = pw[0][0]; pf[0].y = pw[0][1]; pf[0].z = pw[1][0]; pf[0].w = pw[1][1]; pf[1].x = pw[2][0]; pf[1].y = pw[2][1]; pf[1].z = pw[3][0]; pf[1].w = pw[3][1];
#pragma unroll
        for (int i = 0; i < 4; ++i) O[i] *= __shfl(alpha, 4 * q + i);
        { LAS const unsigned char* vrow = bb + AT_VT + (16 * wv + r) * 144;
#pragma unroll
          for (int a2 = 0; a2 < 2; ++a2) { const u32x2 lo = *(LAS const u32x2*)(vrow + (32 * a2 + 4 * q) * 2), hi = *(LAS const u32x2*)(vrow + (32 * a2 + 16 + 4 * q) * 2); u32x4 vf; vf.x = lo.x; vf.y = lo.y; vf.z = hi.x; vf.w = hi.y;
              O = __builtin_amdgcn_mfma_f32_16x16x32_bf16(__builtin_bit_cast(bf16x8_t, pf[a2]), __builtin_bit_cast(bf16x8_t, vf), O, 0, 0, 0); } }
        __syncthreads();
    }
#undef SA_PREFETCH
#undef SA_STAGE
    bf16_t* CAT = (bf16_t*)(p.WS() + WS_CAT); const float invl = 1.0f / lrun;
#pragma unroll
    for (int i = 0; i < 4; ++i) { const float iv = __shfl(invl, 4 * q + i); CAT[((size_t)MP + 4 * b + q) * D + 1024 + (4 * g + i) * 128 + 16 * wv + r] = f2bf(O[i] * iv); }
}

struct MkArgs { Ptrs p; int ph_lo, ph_hi, sub, pad; };
__global__ void __launch_bounds__(512, 2) mk_fwd(MkArgs a) {
    extern __shared__ __attribute__((aligned(16))) unsigned char lds_raw[];
    LAS unsigned char* lds = (LAS unsigned char*)lds_raw;
    const int lo_ = a.ph_lo, hi_ = a.ph_hi;
    const Ptrs& p = a.p;
    { unsigned char* w = p.ws_; asm volatile("" :: "s"(w), "s"(lo_), "s"(hi_)); }
    const int tid0 = threadIdx.x;
#define PART_ENV int tid = tid0; asm volatile("" : "+v"(tid)); const int lane = tid & 63, wave = __builtin_amdgcn_readfirstlane(tid >> 6), gw = vcu * 8 + wave; (void)lane; (void)wave; (void)gw;
    const int tid = tid0, lane = tid & 63, wave = __builtin_amdgcn_readfirstlane(tid >> 6);
    const int G = gridDim.x; const int bx = blockIdx.x; const int vcu = (G % 8 == 0) ? (bx % 8) * (G / 8) + bx / 8 : bx;
    const int gw = vcu * 8 + wave, NGW = G * 8;
    for (int u = tid; u < (LDS_BYTES - LDSCTL_OFF) / 4; u += 512) ((LAS unsigned*)(lds + LDSCTL_OFF))[u] = 0u;
    __syncthreads();
    const bool one_launch = (hi_ - lo_) > 1;
    XcdBarrier bar; bar.bar = (unsigned*)(p.WS() + WS_CTL) + CW_BAR; bar.x = 0; bar.st = nullptr;
    if (one_launch) bar = xcd_barrier_post((unsigned*)(p.WS() + WS_CTL) + CW_BAR, (volatile LAS unsigned*)(lds + MISC_OFF) + 8);
    const int lo = lo_, hi = hi_;
#define IN(k) (lo <= (k) && (k) < hi)
#define SEAM(k) do { if (IN(k) && IN((k) + 1)) xcd_barrier(bar); } while (0)
    const float* mods = (const float*)(p.WS() + WS_MODS);
    bf16_t* Hb = (bf16_t*)(p.WS() + WS_H); bf16_t* ACT = (bf16_t*)(p.WS() + WS_ACT); bf16_t* CAT = (bf16_t*)(p.WS() + WS_CAT);
    float* X = p.out + O_Y;

    if (IN(0)) {
        if (G == 256) {
            if (vcu < 144) { PART_ENV const int wi = 8 * vcu + wave; if (wi & 1) mods_wg_body<5, 4>(p, lds, wi >> 1, tid); else mods_wg_body<0, 5>(p, lds, wi >> 1, tid); }
            { PART_ENV LAS float* scr = (LAS float*)(lds + RING_OFF + wave * 16384);
              constexpr int NM = 12, NMW = 1152, IT_M = NM * NMW;
              if (vcu < 144) { const int mw = vcu * 8 + wave; for (int k = 0; k < NM; ++k) convert_item(p, mw + k * NMW, scr, lane); }
              else { const int ow = (vcu - 144) * 8 + wave; for (int it = IT_M + ow; it < IT_ALL; it += 896) convert_item(p, it, scr, lane); } }
        } else {
            { PART_ENV if ((gw & 15) < 9) { const int it = (gw >> 4) * 9 + (gw & 15); if (it < 2 * (NMOD / 32)) { if (it & 1) mods_item_t<5, 4>(p, it >> 1, lane); else mods_item_t<0, 5>(p, it >> 1, lane); } } }
            { PART_ENV LAS float* scr = (LAS float*)(lds + RING_OFF + wave * 16384); for (int it = gw; it < IT_ALL; it += NGW) convert_item(p, it, scr, lane); }
        }
    }
    SEAM(0);
    if (IN(1)) { PART_ENV for (int row = gw; row < M; row += NGW) { const float* mr = mods + (size_t)row_bm(row) * NMOD;
        normmod_q8(row < MP ? p.x_p + (size_t)row * D : p.x_s + (size_t)(row - MP) * D, p.f1_g, mr + D, mr, p.WS() + WS_H8 + (size_t)row * D, (float*)(p.WS() + WS_SA) + row, lane); }
        for (int n = gw; n < 4 * FF; n += NGW) { const int which = n >= 2 * FF, nn = which ? n - 2 * FF : n;
            quant_wrow<D>((const bf16_t*)(p.WS() + (which ? WS_W2GU : WS_W1GU)) + (size_t)nn * D, p.WS() + (which ? WS_W2GU8 : WS_W1GU8) + (size_t)nn * D, (unsigned*)(p.WS() + WS_CTL + CTL_CMAX) + n, lane); }
        for (int n = gw; n < 2 * D; n += NGW) { const int which = n >= D, nn = which ? n - D : n;
            quant_wrow<FF>((const bf16_t*)(p.WS() + (which ? WS_W2D : WS_W1D)) + (size_t)nn * FF, p.WS() + (which ? WS_W2D8 : WS_W1D8) + (size_t)nn * FF, (unsigned*)(p.WS() + WS_CTL + CTL_CMAX) + 4 * FF + n, lane); } }
    SEAM(1);
    if (IN(2)) { PART_ENV pg8::Gemm g{(const bf16_t*)(p.WS() + WS_H8), (const bf16_t*)(p.WS() + WS_W1GU8), M, 2 * FF, D / 2, D / 2}; pg8::StaticOrder S; S.init(MP, 2 * FF, G, bx);
        pg8::EpiSwigluI8 E{ACT, (const float*)(p.WS() + WS_SA), (const float*)(p.WS() + WS_CTL + CTL_CMAX), (float*)(p.WS() + WS_RMAXP), p.WS() + WS_ACT8};
        pg8::gemm_phase<pg8::EpiSwigluI8, pg8::StaticOrder, PG8_ALIGN, PG8_SP2>(lds + RING_OFF, g, S, E); }
    if (IN(2) && IN(15)) xcd_barrier(bar);
    if (IN(15)) { PART_ENV
        const int ngemm = G > 88 ? 88 : G, nreq = G > 88 ? G - 88 : G, creq = G > 88 ? bx - 88 : bx;
        if (bx < ngemm) { pg8::Gemm g{(const bf16_t*)(p.WS() + WS_H8), (const bf16_t*)(p.WS() + WS_W1GU8), M, 2 * FF, D / 2, D / 2}; pg8::SampleOrder S; S.init(2 * FF, ngemm, bx);
            pg8::EpiSwigluI8 E{ACT, (const float*)(p.WS() + WS_SA), (const float*)(p.WS() + WS_CTL + CTL_CMAX), (float*)(p.WS() + WS_RMAXP), p.WS() + WS_ACT8};
            pg8::gemm_phase<pg8::EpiSwigluI8, pg8::SampleOrder, PG8_ALIGN, PG8_SP2>(lds + RING_OFF, g, S, E); }
        if (creq >= 0) for (int row = creq * 8 + wave; row < MP; row += nreq * 8) requant_act_row(p.WS() + WS_ACT8 + (size_t)row * FF, (const float*)(p.WS() + WS_RMAXP) + (size_t)row * 176, (float*)(p.WS() + WS_SA2) + row, lane); }
    if (IN(15) && IN(3)) xcd_barrier(bar);
    if (IN(3)) { PART_ENV
#pragma nounroll
      for (int s_ = 0; s_ < 2; ++s_) {
        if ((s_ == 0) != ((bx & 1) != 0)) { pg8::Gemm g{(const bf16_t*)(p.WS() + WS_ACT8), (const bf16_t*)(p.WS() + WS_W1D8), MP, D, FF / 2, FF / 2}; pg8::StaticOrder S; S.init(MP, D, G, bx, 4);
        pg8::EpiResidI8T<false, true> E{p.x_p, (bf16_t*)(p.WS() + WS_XB), mods + 2 * D, 0.5f, (const float*)(p.WS() + WS_SA2), (const float*)(p.WS() + WS_CTL + CTL_CMAX) + 4 * FF};
        pg8::gemm_phase<pg8::EpiResidI8T<false, true>, pg8::StaticOrder, PG8_ALIGN, PG8_SP2>(lds + RING_OFF, g, S, E); }
        else { pg8::Gemm g{ACT, (const bf16_t*)(p.WS() + WS_W1D), M, D, FF, 512}; pg8::SplitOrder S{11, G, (bx & 1) ? (bx >> 1) : (G >> 1) + (bx >> 1)}; pg8::EpiSlab E{(float*)(p.WS() + WS_SLAB)};
        pg8::gemm_phase<pg8::EpiSlab, pg8::SplitOrder, PG8_ALIGN, PG8_SP2>(lds + RING_OFF, g, S, E); }
        __syncthreads(); } }
    SEAM(3);
    if (IN(4)) { PART_ENV const int nit = fix_rows_n(gw, NGW); for (int it = 0; it < nit; ++it) { const int row = fix_row_at(gw, NGW, it); const float* mr = mods + (size_t)row_bm(row) * NMOD + 3 * D;
        bf16_t* xb = (bf16_t*)(p.WS() + WS_XB) + (size_t)row * D; f32x4 v[8];
        if (row < MP) row_load_b(v, xb, lane);
        else { row_load(v, p.x_s + (size_t)(row - MP) * D, lane); fix_add<11>(v, (const float*)(p.WS() + WS_SLAB) + (size_t)(row - MP) * D, mr - D, 0.5f, lane); row_store_b(v, xb, lane); }
        normmod_vals(v, p.mix_g, mr + D, mr, Hb + (size_t)row * D, lane); } }
    SEAM(4);
    if (IN(5)) { PART_ENV pg8::Gemm g{Hb, (const bf16_t*)(p.WS() + WS_WIN), M, 6400, D, D}; pg8::StaticOrder S; S.init(M, 6400, G, bx); pg8::EpiProj E{(bf16_t*)(p.WS() + WS_PROJ), (float*)(p.WS() + WS_SMALL)};
        pg8::gemm_phase<pg8::EpiProj, pg8::StaticOrder, PG8_ALIGN, PG8_SP2>(lds + RING_OFF, g, S, E); }
    SEAM(5);
    if (IN(6)) { const bool spread = G >= 64; const int NGI = spread ? NGW - 32 : NGW;
        { PART_ENV const bool scanw = spread ? (wave == 7 && vcu < 32) : (gw < 32); const int gi = !spread ? gw : (vcu < 32 ? vcu * 7 + wave : 224 + (vcu - 32) * 8 + wave);
          if (scanw) scan_bh(p, spread ? vcu : gw, lane);
          if (!(spread && scanw)) for (int row = gi; row < M; row += NGI) post_row(p, row, lane); }
        { PART_ENV constexpr int NU = (MP / 8) * 8; const bool scanw = spread && wave == 7 && vcu < 32; const int gi = !spread ? gw : (vcu < 32 ? vcu * 7 + wave : 224 + (vcu - 32) * 8 + wave);
          if (scanw) {}
          else if ((NGI & 7) == 0 && gi < NU) { f32x4 w[4];
#pragma unroll
              for (int k = 0; k < 4; ++k) w[k] = *(const f32x4*)(p.conv_w + (size_t)k * 2048 + 256 * (gi & 7) + 4 * lane);
              u32x2 cur[11], nxt[11]; conv_load(cur, p, gi, lane);
              for (int u = gi; u < NU; u += NGI) { const bool more = u + NGI < NU; if (more) conv_load(nxt, p, u + NGI, lane); conv_compute(cur, w, p, u, lane);
                  if (more) {
#pragma unroll
                      for (int i = 0; i < 11; ++i) cur[i] = nxt[i]; } } }
          else if ((NGI & 7) != 0) { for (int u = gi; u < NU; u += NGI) { f32x4 w[4];
#pragma unroll
              for (int k = 0; k < 4; ++k) w[k] = *(const f32x4*)(p.conv_w + (size_t)k * 2048 + 256 * (u & 7) + 4 * lane);
              u32x2 cur[11]; conv_load(cur, p, u, lane); conv_compute(cur, w, p, u, lane); } } } }
    SEAM(6);
    if (IN(7)) {
        if (a.sub & 1) { PART_ENV for (int u = vcu; u < 256; u += G) { const int b = u >> 5;
            for (int k = 0; k < 2; ++k) { const int pi = 2 * (u & 31) + k; scores_select_unit(p, lds, b, pi, tid); scores_select_unit(p, lds, b, 127 - pi, tid); } }
          __syncthreads(); }
        if (a.sub & 2) { PART_ENV for (int u = gw; u < 2048; u += NGW) scores_mfma_sample(p, u, lane); }
        if (a.sub & 4) { PART_ENV for (int unit = vcu; unit < 256; unit += G) mlstm_mfma_unit(p, lds, unit, tid); }
        if (a.sub & 8) { PART_ENV mlstm_sample_items(p, lds_raw, vcu, G, tid); }
    }
    SEAM(7);
    if (IN(9)) {
        { PART_ENV for (int i = tid; i < 2048; i += 512) ((LAS float*)(lds + AT_BIAS))[i] = p.t5[t5_bucket(i >> 3) * 8 + (i & 7)];
          if (a.sub & 16) for (int u = vcu; u < 256; u += G) { const int b = u >> 5, g = (u >> 4) & 1, qb = u & 15; attn_mfma_block(p, lds, b, qb, g, tid); attn_mfma_block(p, lds, b, 31 - qb, g, tid); }
          __syncthreads(); }
        if (a.sub & 32) { PART_ENV for (int u = vcu; u < 256; u += G) attn_mfma_sample(p, lds, u >> 1, u & 1, tid);
          __syncthreads(); }
        if (a.sub & 64) { PART_ENV for (int row = gw; row < M; row += 2 * NGW) { mlstm_out_row(p, row, lane); if (row + NGW < M) mlstm_out_row(p, row + NGW, lane); } }
    }
    SEAM(9);
    if (IN(10)) { PART_ENV { pg8::Gemm g{CAT, (const bf16_t*)(p.WS() + WS_WOUT), MP, D, D, D}; pg8::StaticOrder S; S.init(MP, D, G, bx, 4); pg8::EpiResidT<true, true> E{(bf16_t*)(p.WS() + WS_XB), (bf16_t*)(p.WS() + WS_XB), mods + 5 * D, 1.0f};
        pg8::gemm_phase<pg8::EpiResidT<true, true>, pg8::StaticOrder, PG8_ALIGN, PG8_SP2>(lds + RING_OFF, g, S, E); }
        __syncthreads();
        { pg8::Gemm g{CAT, (const bf16_t*)(p.WS() + WS_WOUT), M, D, D, 256}; pg8::SplitOrder S{8, G, bx}; pg8::EpiSlab E{(float*)(p.WS() + WS_SLAB)};
        pg8::gemm_phase<pg8::EpiSlab, pg8::SplitOrder, PG8_ALIGN, PG8_SP2>(lds + RING_OFF, g, S, E); } }
    SEAM(10);
    if (IN(11)) { PART_ENV const int nit = fix_rows_n(gw, NGW); for (int it = 0; it < nit; ++it) { const int row = fix_row_at(gw, NGW, it); const float* mr = mods + (size_t)row_bm(row) * NMOD + 6 * D;
        bf16_t* xb = (bf16_t*)(p.WS() + WS_XB) + (size_t)row * D; f32x4 v[8]; row_load_b(v, xb, lane);
        if (row >= MP) { fix_add<8>(v, (const float*)(p.WS() + WS_SLAB) + (size_t)(row - MP) * D, mr - D, 1.0f, lane); row_store_b(v, xb, lane); }
        normmod_q8_vals(v, p.f2_g, mr + D, mr, p.WS() + WS_H8 + (size_t)row * D, (float*)(p.WS() + WS_SA) + row, lane); } }
    SEAM(11);
    if (IN(12)) { PART_ENV pg8::Gemm g{(const bf16_t*)(p.WS() + WS_H8), (const bf16_t*)(p.WS() + WS_W2GU8), M, 2 * FF, D / 2, D / 2}; pg8::StaticOrder S; S.init(MP, 2 * FF, G, bx);
        pg8::EpiSwigluI8 E{ACT, (const float*)(p.WS() + WS_SA), (const float*)(p.WS() + WS_CTL + CTL_CMAX) + 2 * FF, (float*)(p.WS() + WS_RMAXP), p.WS() + WS_ACT8};
        pg8::gemm_phase<pg8::EpiSwigluI8, pg8::StaticOrder, PG8_ALIGN, PG8_SP2>(lds + RING_OFF, g, S, E); }
    if (IN(12) && IN(16)) xcd_barrier(bar);
    if (IN(16)) { PART_ENV
        const int ngemm = G > 88 ? 88 : G, nreq = G > 88 ? G - 88 : G, creq = G > 88 ? bx - 88 : bx;
        if (bx < ngemm) { pg8::Gemm g{(const bf16_t*)(p.WS() + WS_H8), (const bf16_t*)(p.WS() + WS_W2GU8), M, 2 * FF, D / 2, D / 2}; pg8::SampleOrder S; S.init(2 * FF, ngemm, bx);
            pg8::EpiSwigluI8 E{ACT, (const float*)(p.WS() + WS_SA), (const float*)(p.WS() + WS_CTL + CTL_CMAX) + 2 * FF, (float*)(p.WS() + WS_RMAXP), p.WS() + WS_ACT8};
            pg8::gemm_phase<pg8::EpiSwigluI8, pg8::SampleOrder, PG8_ALIGN, PG8_SP2>(lds + RING_OFF, g, S, E); }
        if (creq >= 0) for (int row = creq * 8 + wave; row < MP; row += nreq * 8) requant_act_row(p.WS() + WS_ACT8 + (size_t)row * FF, (const float*)(p.WS() + WS_RMAXP) + (size_t)row * 176, (float*)(p.WS() + WS_SA2) + row, lane); }
    if (IN(16) && IN(13)) xcd_barrier(bar);
    if (IN(13)) { PART_ENV
#pragma nounroll
      for (int s_ = 0; s_ < 2; ++s_) {
        if ((s_ == 0) != ((bx & 1) != 0)) { pg8::Gemm g{(const bf16_t*)(p.WS() + WS_ACT8), (const bf16_t*)(p.WS() + WS_W2D8), MP, D, FF / 2, FF / 2}; pg8::StaticOrder S; S.init(MP, D, G, bx, 4);
        pg8::EpiResidI8T<true, false> E{(bf16_t*)(p.WS() + WS_XB), X, mods + 8 * D, 0.5f, (const float*)(p.WS() + WS_SA2), (const float*)(p.WS() + WS_CTL + CTL_CMAX) + 4 * FF + D};
        pg8::gemm_phase<pg8::EpiResidI8T<true, false>, pg8::StaticOrder, PG8_ALIGN, PG8_SP2>(lds + RING_OFF, g, S, E); }
        else { pg8::Gemm g{ACT, (const bf16_t*)(p.WS() + WS_W2D), M, D, FF, 512}; pg8::SplitOrder S{11, G, (bx & 1) ? (bx >> 1) : (G >> 1) + (bx >> 1)}; pg8::EpiSlab E{(float*)(p.WS() + WS_SLAB)};
        pg8::gemm_phase<pg8::EpiSlab, pg8::SplitOrder, PG8_ALIGN, PG8_SP2>(lds + RING_OFF, g, S, E); }
        __syncthreads(); } }
    SEAM(13);
    if (IN(14)) { PART_ENV for (int t = gw; t < 4 * MS; t += NGW) { int ln = lane; asm volatile("" : "+v"(ln)); const int row = MP + (t >> 2), j0 = 2 * (t & 3);
        const float* mr = mods + (size_t)row_bm(row) * NMOD + 8 * D; const bf16_t* xr = (const bf16_t*)(p.WS() + WS_XB) + (size_t)row * D; const float* slab = (const float*)(p.WS() + WS_SLAB) + (size_t)(row - MP) * D;
        f32x4 v[2], a[2];
#pragma unroll
        for (int jj = 0; jj < 2; ++jj) { const u32x2 w = *(const u32x2*)(xr + 256 * (j0 + jj) + 4 * ln); v[jj][0] = bflo(w.x); v[jj][1] = bfhi(w.x); v[jj][2] = bflo(w.y); v[jj][3] = bfhi(w.y); a[jj] = (f32x4){0.f, 0.f, 0.f, 0.f};
#pragma unroll
            for (int k = 0; k < 11; ++k) a[jj] += ((const f32x4*)(slab + (size_t)k * MS * D))[64 * (j0 + jj) + ln]; }
#pragma unroll
        for (int jj = 0; jj < 2; ++jj) ((f32x4*)(X + (size_t)row * D))[64 * (j0 + jj) + ln] = v[jj] + (((const f32x4*)mr)[64 * (j0 + jj) + ln] * 0.5f) * a[jj]; } }
#undef IN
#undef SEAM
}

extern "C" void kernel_launch(void* const* d_in, const int* in_sizes, int n_in, void* d_out, int out_size, void* d_ws, size_t ws_size, hipStream_t stream) {
    static int ok = 0, grid = 0;
    if (ok == 0) {
        if (n_in != 31 || out_size != (int)O_END || ws_size < WS_END) { fprintf(stderr, "kernel_launch: unexpected shapes: n_in %d out %d ws %zu (need %zu)\n", n_in, out_size, ws_size, (size_t)WS_END); ok = -1; return; }
        if (hipFuncSetAttribute((const void*)mk_fwd, hipFuncAttributeMaxDynamicSharedMemorySize, LDS_BYTES) != hipSuccess) { fprintf(stderr, "kernel_launch: hipFuncSetAttribute(mk_fwd) failed\n"); ok = -1; return; }
        int dev = 0, cus = 0; if (hipGetDevice(&dev) != hipSuccess || hipDeviceGetAttribute(&cus, hipDeviceAttributeMultiprocessorCount, dev) != hipSuccess || cus < 8) { fprintf(stderr, "kernel_launch: device query failed\n"); ok = -1; return; }
        grid = cus;
        ok = 1;
    }
    if (ok < 0) return;
    Ptrs p{};
    const float* const* f = (const float* const*)d_in;
    p.x_p = f[0]; p.x_s = f[1]; p.c_p = f[2]; p.c_s = f[3]; p.cache_k = f[4]; p.cache_v = f[5]; p.cache_ik = f[6]; p.page_table = (const int*)d_in[7];
    p.state_C = f[8]; p.state_n = f[9]; p.state_m = f[10]; p.state_conv = f[11];
    p.f1_g = f[12]; p.f1_wg = f[13]; p.f1_wu = f[14]; p.f1_wd = f[15]; p.mix_g = f[16]; p.w_in = f[17]; p.conv_w = f[18]; p.gate_b = f[19]; p.out_g = f[20]; p.qn_g = f[21]; p.kn_g = f[22]; p.t5 = f[23];
    p.w_out = f[24]; p.f2_g = f[25]; p.f2_wg = f[26]; p.f2_wu = f[27]; p.f2_wd = f[28]; p.w_ada = f[29]; p.b_ada = f[30];
    p.out = (float*)d_out; p.ws_ = (unsigned char*)d_ws;
    if (hipMemsetAsync((char*)d_ws + WS_CTL, 0, CTL_ZERO_BYTES, stream) != hipSuccess) { fprintf(stderr, "kernel_launch: memset failed\n"); return; }
    MkArgs a{}; a.p = p;
    a.sub = 127; a.pad = 0;
#ifdef MK_SEQ
    { static const int seq[] = {MK_SEQ}; for (unsigned i = 0; i < sizeof(seq) / sizeof(seq[0]); ++i) { a.ph_lo = seq[i] & 255; a.ph_hi = a.ph_lo + 1; a.sub = (seq[i] >> 8) ? (seq[i] >> 8) : 127; hipLaunchKernelGGL(mk_fwd, dim3(grid), dim3(512), LDS_BYTES, stream, a); } }
#else
    a.ph_lo = 0; a.ph_hi = 17; hipLaunchKernelGGL(mk_fwd, dim3(grid), dim3(512), LDS_BYTES, stream, a);
#endif
}
```
